# Optimizing an MI355X kernel written in HIP

```python
import math
import jax, jax.numpy as jnp
from jax import lax
import numpy as np

D_MODEL = 2048
BATCH = 2
SEQ = 8192
DEPTH = 1

DN_H = 8
DN_DK = 128
DN_DV = 128
DN_CHUNK = 64
CONV_K = 5
SWA_HQ = 8
SWA_HKV = 2
SWA_HD = 128
WINDOW = 128
BLOCK = 128
ROPE_DIM = SWA_HD // 4
ROPE_THETA = 500000.0
D_FF = 4 * D_MODEL
EPS = 1e-6

DN_QK = DN_H * DN_DK
DN_V = DN_H * DN_DV
DN_CONV_CH = 2 * DN_QK + DN_V
IN_SIZES = (DN_CONV_CH, DN_V, 2 * DN_H, 2 * DN_H, SWA_HQ * SWA_HD, 2 * SWA_HKV * SWA_HD, 2 * D_MODEL)
IN_WIDTH = DN_CONV_CH + DN_V + 4 * DN_H + SWA_HQ * SWA_HD + 2 * SWA_HKV * SWA_HD + 2 * D_MODEL

kernel_name = "hybrid_deltanet_swa_adaln_block"


def split_last(t, sizes):
    idx = np.cumsum(np.array(sizes))[:-1].tolist()
    return jnp.split(t, idx, axis=-1)


def rms_norm(x, w):
    xf = x.astype(jnp.float32)
    y = xf * lax.rsqrt(jnp.mean(jnp.square(xf), axis=-1, keepdims=True) + EPS)
    return (y * w.astype(jnp.float32)).astype(x.dtype)


def l2_normalize(x):
    xf = x.astype(jnp.float32)
    return xf * lax.rsqrt(jnp.sum(jnp.square(xf), axis=-1, keepdims=True) + EPS)


def centred_depthwise_conv(x, w):
    k_size, ch = w.shape
    pad = (k_size - 1) // 2
    return lax.conv_general_dilated(x, w[:, None, :], window_strides=(1,), padding=((pad, pad),),
                                    dimension_numbers=('NWC', 'WIO', 'NWC'), feature_group_count=ch)


def gated_delta_chunked(q, k, v, g, beta):
    B, L, H, DK = q.shape
    DV = v.shape[-1]
    C = DN_CHUNK
    N = L // C
    f32 = jnp.float32

    def chunks(t):
        return t.astype(f32).reshape(B, N, C, H, -1).transpose(0, 3, 1, 2, 4)

    q, k, v = chunks(q), chunks(k), chunks(v)
    g = jnp.cumsum(chunks(g[..., None])[..., 0], axis=-1)
    beta = chunks(beta[..., None])[..., 0]
    k_beta = k * beta[..., None]
    v_beta = v * beta[..., None]
    incl = jnp.tril(jnp.ones((C, C), dtype=bool))
    strict = jnp.tril(jnp.ones((C, C), dtype=bool), -1)
    decay = jnp.exp(jnp.where(incl, g[..., :, None] - g[..., None, :], -jnp.inf))
    a_kk = jnp.where(strict, jnp.einsum('bhncd,bhnsd->bhncs', k_beta, k) * decay, 0.0)
    eye = jnp.eye(C, dtype=f32)
    t_inv = lax.linalg.triangular_solve(eye + a_kk, jnp.broadcast_to(eye, a_kk.shape),
                                        left_side=True, lower=True, unit_diagonal=True)
    u = jnp.einsum('bhncs,bhnse->bhnce', t_inv, v_beta)
    w = jnp.einsum('bhncs,bhnsd->bhncd', t_inv, k_beta * jnp.exp(g)[..., None])
    a_qk = jnp.einsum('bhncd,bhnsd->bhncs', q, k) * decay
    g_last = g[..., -1]
    q_dec = q * jnp.exp(g)[..., None]
    k_dec = k * jnp.exp(g_last[..., None] - g)[..., None]

    def step(state, inp):
        q_i, w_i, u_i, a_i, k_i, gl_i = inp
        v_new = u_i - jnp.einsum('bhcd,bhde->bhce', w_i, state)
        o_i = jnp.einsum('bhcd,bhde->bhce', q_i, state) + jnp.einsum('bhcs,bhse->bhce', a_i, v_new)
        state = state * jnp.exp(gl_i)[..., None, None] + jnp.einsum('bhcd,bhce->bhde', k_i, v_new)
        return state, o_i

    xs = tuple(jnp.moveaxis(t, 2, 0) for t in (q_dec, w, u, a_qk, k_dec, g_last))
    s0 = jnp.zeros((B, H, DK, DV), f32)
    _, o = lax.scan(step, s0, xs)
    return o.transpose(1, 0, 3, 2, 4).reshape(B, L, H, DV)


def reverse_seq(t):
    return jnp.flip(t, axis=1)


def deltanet_branch(qkv, z, beta_logits, a, conv_w, a_log, dt_bias, out_norm_w):
    B, L, _ = qkv.shape
    f32 = jnp.float32
    qkv = jax.nn.silu(centred_depthwise_conv(qkv, conv_w))
    q, k, v = split_last(qkv, (DN_QK, DN_QK, DN_V))
    q = l2_normalize(q.reshape(B, L, DN_H, DN_DK)) * (DN_DK ** -0.5)
    k = l2_normalize(k.reshape(B, L, DN_H, DN_DK))
    v = v.reshape(B, L, DN_H, DN_DV)
    beta = jax.nn.sigmoid(beta_logits.astype(f32))
    g = -jnp.exp(a_log.astype(f32).reshape(2 * DN_H)) * jax.nn.softplus(
        a.astype(f32) + dt_bias.astype(f32).reshape(2 * DN_H))
    o_fwd = gated_delta_chunked(q, k, v, g[..., :DN_H], beta[..., :DN_H])
    o_bwd = reverse_seq(gated_delta_chunked(reverse_seq(q), reverse_seq(k), reverse_seq(v),
                                            reverse_seq(g[..., DN_H:]), reverse_seq(beta[..., DN_H:])))
    o = rms_norm(o_fwd + o_bwd, out_norm_w) * jax.nn.silu(z.astype(f32).reshape(B, L, DN_H, DN_DV))
    return o.reshape(B, L, DN_V).astype(qkv.dtype)


def partial_rope(x):
    L = x.shape[1]
    half = ROPE_DIM // 2
    inv_freq = ROPE_THETA ** (-jnp.arange(half, dtype=jnp.float32) * 2.0 / ROPE_DIM)
    ang = jnp.arange(L, dtype=jnp.float32)[:, None] * inv_freq[None, :]
    cos = jnp.cos(ang)[None, :, None, :].astype(x.dtype)
    sin = jnp.sin(ang)[None, :, None, :].astype(x.dtype)
    x1 = x[..., :half]
    x2 = x[..., half:ROPE_DIM]
    return jnp.concatenate([x1 * cos - x2 * sin, x2 * cos + x1 * sin, x[..., ROPE_DIM:]], axis=-1)


def banded_window_attention(q, k, v, sink):
    B, L, _, _ = q.shape
    G = SWA_HQ // SWA_HKV
    NB = L // BLOCK
    f32 = jnp.float32
    qb = q.reshape(B, NB, BLOCK, SWA_HKV, G, SWA_HD)

    def key_windows(t):
        tp = jnp.pad(t, ((0, 0), (BLOCK, BLOCK), (0, 0), (0, 0))).reshape(B, NB + 2, BLOCK, SWA_HKV, SWA_HD)
        return jnp.concatenate([tp[:, :-2], tp[:, 1:-1], tp[:, 2:]], axis=2)

    kw, vw = key_windows(k), key_windows(v)
    s = jnp.einsum('bnqhgd,bnkhd->bnhgqk', qb, kw).astype(f32) * (SWA_HD ** -0.5)
    qi = jnp.arange(BLOCK)[:, None]
    kj = jnp.arange(3 * BLOCK)[None, :]
    band = jnp.abs(kj - BLOCK - qi) <= WINDOW
    kpos = jnp.arange(NB)[:, None] * BLOCK + jnp.arange(3 * BLOCK)[None, :] - BLOCK
    in_seq = (kpos >= 0) & (kpos < L)
    mask = band[None] & in_seq[:, None, :]
    s = jnp.where(mask[None, :, None, None], s, -jnp.inf)
    sink_logit = jnp.broadcast_to(sink.astype(f32).reshape(1, 1, SWA_HKV, G, 1, 1), s.shape[:-1] + (1,))
    p = jax.nn.softmax(jnp.concatenate([s, sink_logit], axis=-1), axis=-1)[..., :-1]
    o = jnp.einsum('bnhgqk,bnkhd->bnqhgd', p.astype(v.dtype), vw)
    return o.reshape(B, L, SWA_HQ, SWA_HD)


def window_gqa_branch(q, kv, q_norm_w, k_norm_w, sink):
    B, L, _ = q.shape
    q = q.reshape(B, L, SWA_HQ, SWA_HD)
    k, v = split_last(kv, (SWA_HKV * SWA_HD, SWA_HKV * SWA_HD))
    k = k.reshape(B, L, SWA_HKV, SWA_HD)
    v = v.reshape(B, L, SWA_HKV, SWA_HD)
    q = partial_rope(rms_norm(q, q_norm_w))
    k = partial_rope(rms_norm(k, k_norm_w))
    o = banded_window_attention(q, k, v, sink)
    return o.reshape(B, L, SWA_HQ * SWA_HD)


def hybrid_layer(x, c, w_ada, b_ada, norm1_w, w_in, conv_w, dn_a_log, dn_dt_bias, dn_out_norm_w,
                 w_dn_proj, q_norm_w, k_norm_w, sink, w_swa_proj, w_out, norm2_w, w_mlp_in, w_mlp_out):
    mod = jnp.dot(jax.nn.silu(c), w_ada) + b_ada
    shift1, scale1, gate1, shift2, scale2, gate2 = jnp.split(mod[:, None, :], 6, axis=-1)

    h = rms_norm(x, norm1_w) * (1.0 + scale1) + shift1
    proj = jnp.dot(h, w_in)
    qkv_dn, z_dn, beta_dn, a_dn, q_sw, kv_sw, gates = split_last(proj, IN_SIZES)
    y_dn = deltanet_branch(qkv_dn, z_dn, beta_dn, a_dn, conv_w, dn_a_log, dn_dt_bias, dn_out_norm_w)
    y_sw = window_gqa_branch(q_sw, kv_sw, q_norm_w, k_norm_w, sink)
    gate_dn, gate_sw = jnp.split(jax.nn.sigmoid(gates), 2, axis=-1)
    merged = gate_dn * jnp.dot(y_dn, w_dn_proj) + gate_sw * jnp.dot(y_sw, w_swa_proj)
    x = x + gate1 * jnp.dot(merged, w_out)

    h = rms_norm(x, norm2_w) * (1.0 + scale2) + shift2
    u = jnp.square(jax.nn.relu(jnp.dot(h, w_mlp_in)))
    x = x + gate2 * jnp.dot(u, w_mlp_out)
    return x


def setup_inputs(seed: int = 0) -> dict:
    key = jax.random.key(seed)
    ks = jax.random.split(key, 20)
    f32 = jnp.float32

    def dense(k, shape, fan_in):
        return jax.random.normal(k, shape, f32) * (fan_in ** -0.5)

    def gain(k, n):
        return 1.0 + 0.02 * jax.random.normal(k, (DEPTH, n), f32)

    x = jax.random.normal(ks[0], (BATCH, SEQ, D_MODEL), f32)
    c = jax.random.normal(ks[1], (BATCH, D_MODEL), f32)
    w_ada = dense(ks[2], (DEPTH, D_MODEL, 6 * D_MODEL), D_MODEL)
    b_ada = 0.02 * jax.random.normal(ks[3], (DEPTH, 6 * D_MODEL), f32)
    norm1_w = gain(ks[4], D_MODEL)
    w_in = dense(ks[5], (DEPTH, D_MODEL, IN_WIDTH), D_MODEL)
    conv_w = dense(ks[6], (DEPTH, CONV_K, DN_CONV_CH), CONV_K)
    dn_a_log = jnp.log(jax.random.uniform(ks[7], (DEPTH, 2, DN_H), f32, minval=1.0, maxval=16.0))
    dt = jnp.exp(jax.random.uniform(ks[8], (DEPTH, 2, DN_H), f32,
                                    minval=math.log(1e-3), maxval=math.log(1e-1)))
    dn_dt_bias = dt + jnp.log(-jnp.expm1(-dt))
    dn_out_norm_w = gain(ks[9], DN_DV)
    w_dn_proj = dense(ks[10], (DEPTH, DN_V, D_MODEL), DN_V)
    q_norm_w = gain(ks[11], SWA_HD)
    k_norm_w = gain(ks[12], SWA_HD)
    sink = jax.random.normal(ks[13], (DEPTH, SWA_HQ), f32)
    w_swa_proj = dense(ks[14], (DEPTH, SWA_HQ * SWA_HD, D_MODEL), SWA_HQ * SWA_HD)
    w_out = dense(ks[15], (DEPTH, D_MODEL, D_MODEL), D_MODEL)
    norm2_w = gain(ks[16], D_MODEL)
    w_mlp_in = dense(ks[17], (DEPTH, D_MODEL, D_FF), D_MODEL)
    w_mlp_out = dense(ks[18], (DEPTH, D_FF, D_MODEL), D_FF)
    return {"x": x, "c": c, "w_ada": w_ada, "b_ada": b_ada, "norm1_w": norm1_w, "w_in": w_in,
            "conv_w": conv_w, "dn_a_log": dn_a_log, "dn_dt_bias": dn_dt_bias,
            "dn_out_norm_w": dn_out_norm_w, "w_dn_proj": w_dn_proj, "q_norm_w": q_norm_w,
            "k_norm_w": k_norm_w, "sink": sink, "w_swa_proj": w_swa_proj, "w_out": w_out,
            "norm2_w": norm2_w, "w_mlp_in": w_mlp_in, "w_mlp_out": w_mlp_out}


def reference(x, c, w_ada, b_ada, norm1_w, w_in, conv_w, dn_a_log, dn_dt_bias, dn_out_norm_w,
              w_dn_proj, q_norm_w, k_norm_w, sink, w_swa_proj, w_out, norm2_w, w_mlp_in, w_mlp_out):
    for layer in range(DEPTH):
        x = hybrid_layer(x, c, w_ada[layer], b_ada[layer], norm1_w[layer], w_in[layer], conv_w[layer],
                         dn_a_log[layer], dn_dt_bias[layer], dn_out_norm_w[layer], w_dn_proj[layer],
                         q_norm_w[layer], k_norm_w[layer], sink[layer], w_swa_proj[layer],
                         w_out[layer], norm2_w[layer], w_mlp_in[layer], w_mlp_out[layer])
    return x
```

```cpp
#include <hip/hip_runtime.h>
#include <hip/hip_cooperative_groups.h>
#include <cstdio>
#include <cstdint>
namespace cg = cooperative_groups;

namespace pg8 {
#define PG8_LAS __attribute__((address_space(3)))
typedef unsigned short bf16_t;
typedef short bf16x8 __attribute__((ext_vector_type(8)));
typedef float f32x4 __attribute__((ext_vector_type(4)));
typedef unsigned u32x4 __attribute__((ext_vector_type(4)));
constexpr int BM = 256, BK = 64, HALF = 128, HTB = HALF * BK * 2  , STAGE_BYTES = 8 * HTB, NXCD = 8, WGM = 8;

__host__ __device__ __forceinline__ int lds_byte(int r, int c) { const int st = (r >> 4) * 2 + (c >> 5), rr = r & 15, cc = c & 31, ob = rr * 64 + cc * 2; return st * 1024 + (ob ^ (((ob >> 9) & 1) << 5)); }
__host__ __device__ __forceinline__ void stage_rc(int b, int& R, int& C) { const int st = b / 1024, sb = b % 1024, swz = sb ^ (((sb >> 9) & 1) << 5); R = (st >> 1) * 16 + swz / 64; C = (st & 1) * 32 + (swz % 64) / 2; }
__host__ __device__ __forceinline__ int perm32(int rho) { const int n = rho >> 4, i = rho & 15; return 8 * (i >> 2) + 4 * n + (i & 3); }

struct Unit { int pm, pn; };
struct Gemm { const bf16_t* A; const bf16_t* Bt; int M, N, K; };

struct StaticOrder {
    int nM, nN, nwg, G, c;
    __host__ __device__ void init(int M, int N, int G_, int c_) { nM = M / BM; nN = N / BM; nwg = nM * nN; G = G_; c = c_; }
    __host__ __device__ bool next(int i, Unit& u) const {
        const long L = (long)i * G + c; if (L >= nwg) return false;
        int wgid = (int)L; { const int q = nwg / NXCD, r = nwg % NXCD, xcd = wgid % NXCD, off = wgid / NXCD; wgid = (xcd < r ? xcd * (q + 1) : r * (q + 1) + (xcd - r) * q) + off; }
        const int nig = WGM * nN, gid = wgid / nig, fm = gid * WGM, gsz = (nM - fm) < WGM ? (nM - fm) : WGM;
        u.pm = fm + ((wgid % nig) % gsz); u.pn = (wgid % nig) / gsz; return true;
    }
    __device__ __forceinline__ void a_ready(const Unit&) const {}
    __device__ __forceinline__ void done(const Unit&) const {}
};
typedef float f32x2v __attribute__((ext_vector_type(2)));
typedef __bf16 bf16x2v __attribute__((ext_vector_type(2)));
__device__ __forceinline__ unsigned cvt_pk_bf16(float lo, float hi) { const f32x2v v = {lo, hi}; return __builtin_bit_cast(unsigned, __builtin_convertvector(v, bf16x2v)); }

template <class Epi, class Sched, bool ALIGN_EPI = false, bool SP2 = false>
__device__ __forceinline__ void gemm_phase(PG8_LAS unsigned char* lds, const Gemm g, const Sched& S, const Epi& E) {
    int tid_l = threadIdx.x; asm volatile("" : "+v"(tid_l));
    const int tid = tid_l, wid = __builtin_amdgcn_readfirstlane(tid >> 6), lane = tid & 63, wr = wid >> 2, wc = wid & 3, fr = lane & 15, fq = lane >> 4;
    const int K = g.K, nt = K / BK;
    unsigned voffA[2], voffB[2];
#pragma unroll
    for (int i = 0; i < 2; ++i) { int R, C; stage_rc(tid * 16 + i * 8192, R, C); const int Rb = Epi::PERM ? ((R & ~31) + perm32(R & 31)) : R;
        voffA[i] = (unsigned)(R * K + C) * 2u; voffB[i] = (unsigned)(Rb * K + C) * 2u; }
    const size_t kstep = (size_t)(BK * 2);
    const size_t hstep = (size_t)HALF * K * 2;
    const size_t tstep = 2 * hstep;
    const unsigned ldsw = (unsigned)wid * 1024u;
    const int aoff = lds_byte(wr * 64 + fr, fq * 8), boff = lds_byte(wc * 32 + fr, fq * 8);
#define PG8_SA(b, h) (((b) * 2 + (h)) * HTB)
#define PG8_SB(b, h) ((4 + (b) * 2 + (h)) * HTB)
#define PG8_STAGE(bufoff, gbase, voff) do { _Pragma("unroll") for (int _i = 0; _i < 2; ++_i) \
        __builtin_amdgcn_global_load_lds((const unsigned*)((const char*)(gbase) + (voff)[_i]), (PG8_LAS unsigned*)(lds + (bufoff) + ldsw + _i * 8192), 16, 0, 0); } while (0)
#define PG8_LDA(dst, b, h) do { _Pragma("unroll") for (int m = 0; m < 4; ++m) _Pragma("unroll") for (int k = 0; k < 2; ++k) dst[m][k] = *(const PG8_LAS bf16x8*)(lds + PG8_SA(b, h) + aoff + m * 2048 + k * 1024); } while (0)
#define PG8_LDB(dst, b, h) do { _Pragma("unroll") for (int n = 0; n < 2; ++n) _Pragma("unroll") for (int k = 0; k < 2; ++k) dst[n][k] = *(const PG8_LAS bf16x8*)(lds + PG8_SB(b, h) + boff + n * 2048 + k * 1024); } while (0)
#define PG8_MMA(ai, bj, At, Bt) do { __builtin_amdgcn_s_setprio(1); _Pragma("unroll") for (int m = 0; m < 4; ++m) _Pragma("unroll") for (int n = 0; n < 2; ++n) _Pragma("unroll") for (int k = 0; k < 2; ++k) \
        acc[ai][bj][m][n] = __builtin_amdgcn_mfma_f32_16x16x32_bf16(Bt[n][k], At[m][k], acc[ai][bj][m][n], 0, 0, 0); __builtin_amdgcn_s_setprio(0); } while (0)
#define PG8_WAIT_V(n) asm volatile("s_waitcnt vmcnt(" #n ")" ::: "memory")
#define PG8_WAIT_L(n) asm volatile("s_waitcnt lgkmcnt(" #n ")" ::: "memory")
#define PG8_BAR __builtin_amdgcn_s_barrier()
#define PG8_SCHED __builtin_amdgcn_sched_barrier(0)
    Unit cur, nxt; int ui = 0;
    if (!S.next(0, cur)) return;
    f32x4 acc[2][2][4][2];
#pragma unroll
    for (int a = 0; a < 2; ++a)
#pragma unroll
        for (int b = 0; b < 2; ++b)
#pragma unroll
            for (int m = 0; m < 4; ++m)
#pragma unroll
                for (int n = 0; n < 2; ++n) acc[a][b][m][n] = (f32x4){0.f, 0.f, 0.f, 0.f};
    bf16x8 At[4][2], B0[2][2], B1[2][2];
    const char* cA = (const char*)g.A + (size_t)cur.pm * tstep; const char* cB = (const char*)g.Bt + (size_t)cur.pn * tstep;
    S.a_ready(cur);
    if constexpr (SP2) {
        PG8_STAGE(PG8_SB(0, 0), cB, voffB); PG8_STAGE(PG8_SB(0, 1), cB + hstep, voffB); PG8_STAGE(PG8_SA(0, 0), cA, voffA); PG8_STAGE(PG8_SA(0, 1), cA + hstep, voffA);
        if (wr == 1) PG8_BAR;
        PG8_WAIT_V(2); PG8_BAR;
        PG8_STAGE(PG8_SB(1, 0), cB + kstep, voffB); PG8_STAGE(PG8_SA(1, 0), cA + kstep, voffA); PG8_STAGE(PG8_SB(1, 1), cB + hstep + kstep, voffB);
        PG8_WAIT_V(6); PG8_BAR;
    } else {
        PG8_STAGE(PG8_SB(0, 0), cB, voffB); PG8_STAGE(PG8_SA(0, 0), cA, voffA); PG8_STAGE(PG8_SB(0, 1), cB + hstep, voffB); PG8_STAGE(PG8_SA(0, 1), cA + hstep, voffA);
        if (wr == 1) PG8_BAR;
        PG8_WAIT_V(4); PG8_BAR;
        PG8_STAGE(PG8_SB(1, 0), cB + kstep, voffB); PG8_STAGE(PG8_SA(1, 0), cA + kstep, voffA); PG8_STAGE(PG8_SB(1, 1), cB + hstep + kstep, voffB);
        PG8_WAIT_V(6); PG8_BAR;
    }
    for (;;) {
        const bool has_next = S.next(ui + 1, nxt);
        const char* nA = has_next ? (const char*)g.A + (size_t)nxt.pm * tstep : cA; const char* nB = has_next ? (const char*)g.Bt + (size_t)nxt.pn * tstep : cB;
        for (int t = 0; t < nt; t += 2) {
            const bool last = (t == nt - 2);
            const char* a1 = cA + (size_t)(t + 1) * kstep;
            const char* a2 = last ? nA : cA + (size_t)(t + 2) * kstep; const char* b2 = last ? nB : cB + (size_t)(t + 2) * kstep;
            const char* a3 = a2 + kstep; const char* b3 = b2 + kstep;
            if (last && has_next) S.a_ready(nxt);
            if constexpr (SP2) {
            PG8_LDB(B0, 0, 0); PG8_LDB(B1, 0, 1); PG8_SCHED; PG8_LDA(At, 0, 0); PG8_STAGE(PG8_SA(1, 1), a1 + hstep, voffA);
            PG8_WAIT_V(8); PG8_WAIT_L(0); PG8_BAR; PG8_MMA(0, 0, At, B0); PG8_MMA(0, 1, At, B1); PG8_BAR; PG8_SCHED;
            PG8_LDA(At, 0, 1); PG8_STAGE(PG8_SB(0, 0), b2, voffB); PG8_STAGE(PG8_SB(0, 1), b2 + hstep, voffB); PG8_STAGE(PG8_SA(0, 0), a2, voffA);
            PG8_WAIT_V(8); PG8_WAIT_L(0); PG8_BAR; PG8_MMA(1, 0, At, B0); PG8_MMA(1, 1, At, B1); PG8_BAR; PG8_SCHED;
            PG8_LDB(B0, 1, 0); PG8_LDB(B1, 1, 1); PG8_SCHED; PG8_LDA(At, 1, 0); PG8_STAGE(PG8_SA(0, 1), a2 + hstep, voffA);
            PG8_WAIT_V(8); PG8_WAIT_L(0); PG8_BAR; PG8_MMA(0, 0, At, B0); PG8_MMA(0, 1, At, B1); PG8_BAR; PG8_SCHED;
            PG8_LDA(At, 1, 1); PG8_STAGE(PG8_SB(1, 0), b3, voffB); PG8_STAGE(PG8_SB(1, 1), b3 + hstep, voffB); PG8_STAGE(PG8_SA(1, 0), a3, voffA);
            PG8_WAIT_V(8); PG8_WAIT_L(0); PG8_BAR; PG8_MMA(1, 0, At, B0); PG8_MMA(1, 1, At, B1); PG8_BAR; PG8_SCHED;
            } else {
            PG8_LDB(B0, 0, 0); PG8_SCHED; PG8_LDA(At, 0, 0); PG8_STAGE(PG8_SA(1, 1), a1 + hstep, voffA);
            PG8_WAIT_L(8); PG8_BAR; PG8_WAIT_L(0); PG8_MMA(0, 0, At, B0); PG8_BAR; PG8_SCHED;
            PG8_LDB(B1, 0, 1); PG8_STAGE(PG8_SB(0, 0), b2, voffB);
            PG8_BAR; PG8_WAIT_L(0); PG8_MMA(0, 1, At, B1); PG8_BAR;
            PG8_LDA(At, 0, 1); PG8_STAGE(PG8_SA(0, 0), a2, voffA);
            PG8_BAR; PG8_WAIT_L(0); PG8_MMA(1, 0, At, B0); PG8_BAR; PG8_SCHED;
            PG8_STAGE(PG8_SB(0, 1), b2 + hstep, voffB);
            PG8_WAIT_V(6); PG8_BAR; PG8_MMA(1, 1, At, B1); PG8_BAR;
            PG8_LDB(B0, 1, 0); PG8_SCHED; PG8_LDA(At, 1, 0); PG8_STAGE(PG8_SA(0, 1), a2 + hstep, voffA);
            PG8_WAIT_L(8); PG8_BAR; PG8_WAIT_L(0); PG8_MMA(0, 0, At, B0); PG8_BAR; PG8_SCHED;
            PG8_LDB(B1, 1, 1); PG8_STAGE(PG8_SB(1, 0), b3, voffB);
            PG8_BAR; PG8_WAIT_L(0); PG8_MMA(0, 1, At, B1); PG8_BAR;
            PG8_LDA(At, 1, 1); PG8_STAGE(PG8_SA(1, 0), a3, voffA);
            PG8_BAR; PG8_WAIT_L(0); PG8_MMA(1, 0, At, B0); PG8_BAR; PG8_SCHED;
            PG8_STAGE(PG8_SB(1, 1), b3 + hstep, voffB);
            PG8_WAIT_V(6); PG8_BAR; PG8_MMA(1, 1, At, B1); PG8_BAR;
            }
        }
        if constexpr (ALIGN_EPI) { if (wr == 0) PG8_BAR; }
        if constexpr (!Epi::AFTER_DRAIN) { E(acc, cur, wr, wc, fr, fq); S.done(cur); }
        if (!has_next) break;
#pragma unroll
        for (int a = 0; a < 2; ++a)
#pragma unroll
            for (int b = 0; b < 2; ++b)
#pragma unroll
                for (int m = 0; m < 4; ++m)
#pragma unroll
                    for (int n = 0; n < 2; ++n) acc[a][b][m][n] = (f32x4){0.f, 0.f, 0.f, 0.f};
        cur = nxt; cA = nA; cB = nB; ++ui;
        if constexpr (ALIGN_EPI) { if (wr == 1) PG8_BAR; }
    }
    PG8_WAIT_V(0);
    if constexpr (!ALIGN_EPI) { if (wr == 0) PG8_BAR; }
    PG8_BAR;
    if constexpr (Epi::AFTER_DRAIN) { E.fused(acc, cur, wr, wc, fr, fq, lds, wid, lane); S.done(cur); }
#undef PG8_SA
#undef PG8_SB
#undef PG8_STAGE
#undef PG8_LDA
#undef PG8_LDB
#undef PG8_MMA
#undef PG8_WAIT_V
#undef PG8_WAIT_L
#undef PG8_BAR
#undef PG8_SCHED
}
}

#define DI __device__ __forceinline__
#define LAS __attribute__((address_space(3)))
using pg8::bf16_t; using pg8::bf16x8; using pg8::f32x4; using pg8::u32x4;
typedef unsigned u32x2 __attribute__((ext_vector_type(2)));
typedef short s16x4 __attribute__((ext_vector_type(4)));
typedef float f32x2 __attribute__((ext_vector_type(2)));

constexpr int T = 16384, L = 8192, D = 2048;
constexpr float EPS = 1e-6f;
constexpr size_t MiB = 1u << 20;
constexpr size_t OFF_MOD = 65536, OFF_BA = 1 * MiB, OFF_GC = 3 * MiB, OFF_EGL = 5 * MiB,
    OFF_WDN = 8 * MiB, OFF_WSW = 12 * MiB, OFF_WOUT = 16 * MiB, OFF_WIN = 24 * MiB, OFF_H = 64 * MiB, OFF_Z = 128 * MiB, OFF_QSW = 160 * MiB, OFF_KVSW = 192 * MiB,
    OFF_QKV = 208 * MiB, OFF_QC = 304 * MiB, OFF_KC = 336 * MiB, OFF_VC = 368 * MiB, OFF_YSW = 400 * MiB,
    OFF_W = 208 * MiB, OFF_A = 272 * MiB, OFF_U = 432 * MiB, OFF_OF = 368 * MiB, OFF_OB = 160 * MiB, OFF_YDN = 208 * MiB, OFF_TG = 240 * MiB, OFF_MRG = 304 * MiB,
    OFF_WMI = 128 * MiB, OFF_WMO = 160 * MiB, OFF_UU = 208 * MiB, WS_END = 496 * MiB;
constexpr int LDS_BYTES = 160 * 1024;

struct Params {
    const float *x, *c, *w_ada, *b_ada, *norm1_w, *w_in, *conv_w, *a_log, *dt_bias, *dn_norm_w, *w_dn, *qn_w, *kn_w, *sink, *w_sw, *w_out, *norm2_w, *w_mi, *w_mo;
    float* out; unsigned char* ws;
};

DI float bflo(unsigned u) { return __uint_as_float(u << 16); }
DI float bfhi(unsigned u) { return __uint_as_float(u & 0xffff0000u); }
DI float bf2f(unsigned short u) { return __uint_as_float(((unsigned)u) << 16); }
DI unsigned short f2bf(float f) { unsigned u = __float_as_uint(f); return (unsigned short)((u + 0x7fffu + ((u >> 16) & 1u)) >> 16); }
DI unsigned pk2(float lo, float hi) { return pg8::cvt_pk_bf16(lo, hi); }
DI float wave_sum(float v) {
#pragma unroll
    for (int o = 1; o < 64; o <<= 1) v += __shfl_xor(v, o);
    return v;
}
DI float sigmoidf_(float x) { return 1.f / (1.f + __expf(-x)); }
DI float siluf_(float x) { return x / (1.f + __expf(-x)); }
DI f32x4 mfma16(bf16x8 a, bf16x8 b, f32x4 c) { return __builtin_amdgcn_mfma_f32_16x16x32_bf16(a, b, c, 0, 0, 0); }
DI bf16x8 pack8(f32x4 a, f32x4 b) { u32x4 p; p.x = pk2(a[0], a[1]); p.y = pk2(a[2], a[3]); p.z = pk2(b[0], b[1]); p.w = pk2(b[2], b[3]); return __builtin_bit_cast(bf16x8, p); }
DI bf16x8 cat4(s16x4 lo, s16x4 hi) { return __builtin_shufflevector(lo, hi, 0, 1, 2, 3, 4, 5, 6, 7); }
#define LDS_WAIT() asm volatile("s_waitcnt lgkmcnt(0)" ::: "memory")
DI void fpma(float& acc, float a, float t) { asm("v_fma_f32 %0, %1, %2, %0" : "+v"(acc) : "v"(a), "v"(t)); }
DI void fnma(float& acc, float a, float t) { asm("v_fma_f32 %0, -%1, %2, %0" : "+v"(acc) : "v"(a), "v"(t)); }
DI s16x4 tr_read(const LAS bf16_t* p) { return __builtin_amdgcn_ds_read_tr16_b64_v4i16((LAS s16x4*)p); }

DI void transpose_item(const float* W, int K, int N, bf16_t* WT, int k0, int n0, int dst_row0, int ncols, LAS float* scr, int lane) {
    const int sub = lane >> 4, c4 = lane & 15;
    f32x4 v[16];
    if (4 * c4 < ncols) {
#pragma unroll
        for (int i = 0; i < 16; ++i) v[i] = *(const f32x4*)(W + (size_t)(k0 + 4 * i + sub) * N + n0 + 4 * c4);
#pragma unroll
        for (int i = 0; i < 16; ++i) { LAS float* d = scr + (4 * i + sub) * 65 + 4 * c4; d[0] = v[i][0]; d[1] = v[i][1]; d[2] = v[i][2]; d[3] = v[i][3]; }
    }
    LDS_WAIT();
    const int c = lane & 7;
#pragma unroll
    for (int j = 0; j < 8; ++j) { const int n = (lane >> 3) + 8 * j; const LAS float* s = scr + (8 * c) * 65 + n;
        if (n < ncols) { u32x4 o; o.x = pk2(s[0 * 65], s[1 * 65]); o.y = pk2(s[2 * 65], s[3 * 65]); o.z = pk2(s[4 * 65], s[5 * 65]); o.w = pk2(s[6 * 65], s[7 * 65]);
            *(u32x4*)(WT + (size_t)(dst_row0 + n) * K + k0 + 8 * c) = o; } }
    LDS_WAIT();
}
DI void win_tile(int t, int& n0, int& dst, int& ncols) {
    if (t < 64) { n0 = 64 * t; dst = 4096 + n0; ncols = 64; }
    else if (t < 88) { n0 = 4128 + 64 * (t - 64); dst = 8192 + 64 * (t - 64); ncols = 64; }
    else if (t < 152) { n0 = 5664 + 64 * (t - 88); dst = 64 * (t - 88); ncols = 64; }
    else { n0 = 4096; dst = 9728; ncols = 32; }
}

DI void phase0(const Params& p, LAS unsigned char* lds, int tid, int wave, int lane) {
    unsigned char* ws = p.ws;
    if (blockIdx.x < 192) {
        LAS float* sc = (LAS float*)lds; LAS float* red = sc + 4096;
        for (int i = tid; i < 4096; i += 512) sc[i] = siluf_(p.c[i]);
        __syncthreads();
        const int col = blockIdx.x * 64 + lane; float a0 = 0.f, a1 = 0.f;
        const float* wp = p.w_ada + (size_t)(wave * 256) * 12288 + col;
#pragma unroll 32
        for (int k = 0; k < 256; ++k) { const float w = wp[(size_t)k * 12288]; a0 += sc[wave * 256 + k] * w; a1 += sc[2048 + wave * 256 + k] * w; }
        red[(wave * 2 + 0) * 64 + lane] = a0; red[(wave * 2 + 1) * 64 + lane] = a1;
        __syncthreads();
        if (wave < 2) { float s = 0.f;
#pragma unroll
            for (int w = 0; w < 8; ++w) s += red[(w * 2 + wave) * 64 + lane];
            ((float*)(ws + OFF_MOD))[wave * 12288 + col] = s + p.b_ada[col]; }
        __syncthreads();
    }
    LAS float* scr = (LAS float*)(lds + wave * 16640);
    const int gw = blockIdx.x * 8 + wave, NGW = gridDim.x * 8;
    constexpr int I_IN = 32 * 153, I_DN = 16 * 32, I_OUT = 32 * 32;
    for (int it = gw; it < I_IN + 2 * I_DN + I_OUT; it += NGW) {
        int r = it;
        if (r < I_IN) { int n0, dst, nc; win_tile(r % 153, n0, dst, nc); transpose_item(p.w_in, 2048, 9760, (bf16_t*)(ws + OFF_WIN), 64 * (r / 153), n0, dst, nc, scr, lane); continue; } r -= I_IN;
        if (r < I_DN) { transpose_item(p.w_dn, 1024, 2048, (bf16_t*)(ws + OFF_WDN), 64 * (r / 32), 64 * (r % 32), 64 * (r % 32), 64, scr, lane); continue; } r -= I_DN;
        if (r < I_DN) { transpose_item(p.w_sw, 1024, 2048, (bf16_t*)(ws + OFF_WSW), 64 * (r / 32), 64 * (r % 32), 64 * (r % 32), 64, scr, lane); continue; } r -= I_DN;
        transpose_item(p.w_out, 2048, 2048, (bf16_t*)(ws + OFF_WOUT), 64 * (r / 32), 64 * (r % 32), 64 * (r % 32), 64, scr, lane);
    }
    { u32x4* z = (u32x4*)((bf16_t*)(ws + OFF_WIN) + (size_t)9760 * 2048); const u32x4 zero = {0u, 0u, 0u, 0u};
      for (int i = blockIdx.x * 512 + tid; i < 57344; i += gridDim.x * 512) z[i] = zero; }
}
DI void phase_mlp_weights(const Params& p, LAS unsigned char* lds, int wave, int lane) {
    LAS float* scr = (LAS float*)(lds + wave * 16640);
    const int gw = blockIdx.x * 8 + wave, NGW = gridDim.x * 8;
    constexpr int I_MI = 32 * 128, I_MO = 128 * 32;
    for (int it = gw; it < I_MI + I_MO; it += NGW) {
        int r = it;
        if (r < I_MI) { transpose_item(p.w_mi, 2048, 8192, (bf16_t*)(p.ws + OFF_WMI), 64 * (r / 128), 64 * (r % 128), 64 * (r % 128), 64, scr, lane); continue; } r -= I_MI;
        transpose_item(p.w_mo, 8192, 2048, (bf16_t*)(p.ws + OFF_WMO), 64 * (r / 32), 64 * (r % 32), 64 * (r % 32), 64, scr, lane);
    }
}

DI void phase_modnorm(const float* x, const float* normw, const float* mod, int shift_off, int scale_off, bf16_t* H, int wave, int lane) {
    const int gw = blockIdx.x * 8 + wave, NGW = gridDim.x * 8;
    for (int m0 = 2 * gw; m0 < T; m0 += 2 * NGW) {
        const int b = m0 >> 13;
        const f32x4* xr = (const f32x4*)(x + (size_t)m0 * D) + lane;
        f32x4 v[2][8]; float s[2] = {0.f, 0.f};
#pragma unroll
        for (int r = 0; r < 2; ++r)
#pragma unroll
            for (int j = 0; j < 8; ++j) v[r][j] = xr[r * (D / 4) + 64 * j];
#pragma unroll
        for (int r = 0; r < 2; ++r)
#pragma unroll
            for (int j = 0; j < 8; ++j) s[r] += (v[r][j][0] * v[r][j][0] + v[r][j][1] * v[r][j][1]) + (v[r][j][2] * v[r][j][2] + v[r][j][3] * v[r][j][3]);
        const float rstd0 = rsqrtf(wave_sum(s[0]) * (1.f / D) + EPS), rstd1 = rsqrtf(wave_sum(s[1]) * (1.f / D) + EPS);
        u32x2* o = (u32x2*)(H + (size_t)m0 * D) + lane;
#pragma unroll
        for (int j = 0; j < 8; ++j) { const int col = 256 * j + 4 * lane;
            const f32x4 nw = *(const f32x4*)(normw + col), sc = *(const f32x4*)(mod + b * 12288 + scale_off + col), sh = *(const f32x4*)(mod + b * 12288 + shift_off + col);
            f32x4 a;
#pragma unroll
            for (int i = 0; i < 4; ++i) a[i] = nw[i] * (1.f + sc[i]);
            u32x2 w0, w1;
            w0.x = pk2(v[0][j][0] * rstd0 * a[0] + sh[0], v[0][j][1] * rstd0 * a[1] + sh[1]); w0.y = pk2(v[0][j][2] * rstd0 * a[2] + sh[2], v[0][j][3] * rstd0 * a[3] + sh[3]);
            w1.x = pk2(v[1][j][0] * rstd1 * a[0] + sh[0], v[1][j][1] * rstd1 * a[1] + sh[1]); w1.y = pk2(v[1][j][2] * rstd1 * a[2] + sh[2], v[1][j][3] * rstd1 * a[3] + sh[3]);
            o[64 * j] = w0; o[D / 4 + 64 * j] = w1; }
    }
}

#define EPI_ARGS const f32x4 (&acc)[2][2][4][2], const pg8::Unit& u, int wr, int wc, int fr, int fq
#define EPI_BEGIN _Pragma("unroll") for (int ai = 0; ai < 2; ++ai) _Pragma("unroll") for (int m = 0; m < 4; ++m) { const int r = u.pm * 256 + ai * 128 + wr * 64 + m * 16 + fr; \
    _Pragma("unroll") for (int bj = 0; bj < 2; ++bj) { const int cl = bj * 128 + wc * 32 + 8 * fq; f32x4 v0 = acc[ai][bj][m][0], v1 = acc[ai][bj][m][1];
#define EPI_END } }
DI u32x4 pack_row8(f32x4 a, f32x4 b) { u32x4 o; o.x = pk2(a[0], a[1]); o.y = pk2(a[2], a[3]); o.z = pk2(b[0], b[1]); o.w = pk2(b[2], b[3]); return o; }

struct EpiIn {
    static constexpr bool PERM = true, AFTER_DRAIN = false;
    bf16_t *qkv, *z, *qsw, *kvsw; float* ba; const float* a_log; const float* dt_bias;
    DI void operator()(EPI_ARGS) const {
        const int pn = u.pn;
        if (pn < 22) {
            bf16_t* base; int ldc, c0; bool act = false;
            if (pn < 12) { base = qkv; ldc = 3072; c0 = pn * 256; }
            else if (pn < 16) { base = z; ldc = 1024; c0 = (pn - 12) * 256; act = true; }
            else if (pn < 20) { base = qsw; ldc = 1024; c0 = (pn - 16) * 256; }
            else { base = kvsw; ldc = 512; c0 = (pn - 20) * 256; }
            EPI_BEGIN
                if (act) {
#pragma unroll
                    for (int i = 0; i < 4; ++i) { v0[i] = siluf_(v0[i]); v1[i] = siluf_(v1[i]); } }
                *(u32x4*)(base + (size_t)r * ldc + c0 + cl) = pack_row8(v0, v1);
            EPI_END
        } else if (wc == 0) {
            const int j0 = (fq & 1) * 8;
            f32x4 al0 = {0, 0, 0, 0}, al1 = al0, db0 = al0, db1 = al0;
            if (fq >= 2) { al0 = *(const f32x4*)(a_log + j0); al1 = *(const f32x4*)(a_log + j0 + 4); db0 = *(const f32x4*)(dt_bias + j0); db1 = *(const f32x4*)(dt_bias + j0 + 4); }
#pragma unroll
            for (int ai = 0; ai < 2; ++ai)
#pragma unroll
                for (int m = 0; m < 4; ++m) { const int r = u.pm * 256 + ai * 128 + wr * 64 + m * 16 + fr;
                    f32x4 v0 = acc[ai][0][m][0], v1 = acc[ai][0][m][1];
                    if (fq < 2) {
#pragma unroll
                        for (int i = 0; i < 4; ++i) { v0[i] = sigmoidf_(v0[i]); v1[i] = sigmoidf_(v1[i]); }
                    } else {
#pragma unroll
                        for (int i = 0; i < 4; ++i) {
                            float a = v0[i] + db0[i]; float sp = fmaxf(a, 0.f) + log1pf(__expf(-fabsf(a))); v0[i] = -__expf(al0[i]) * sp;
                            a = v1[i] + db1[i]; sp = fmaxf(a, 0.f) + log1pf(__expf(-fabsf(a))); v1[i] = -__expf(al1[i]) * sp; }
                    }
                    *(f32x4*)(ba + (size_t)r * 32 + 8 * fq) = v0; *(f32x4*)(ba + (size_t)r * 32 + 8 * fq + 4) = v1; }
        }
    }
};
struct EpiSig {
    static constexpr bool PERM = true, AFTER_DRAIN = false;
    bf16_t* O; int ldc;
    DI void operator()(EPI_ARGS) const {
        EPI_BEGIN
#pragma unroll
            for (int i = 0; i < 4; ++i) { v0[i] = sigmoidf_(v0[i]); v1[i] = sigmoidf_(v1[i]); }
            *(u32x4*)(O + (size_t)r * ldc + u.pn * 256 + cl) = pack_row8(v0, v1);
        EPI_END
    }
};
template <bool ADD> struct EpiMerge {
    static constexpr bool PERM = true, AFTER_DRAIN = false;
    const bf16_t* TG; const bf16_t* ADDEND; bf16_t* OUT;
    DI void operator()(EPI_ARGS) const {
        EPI_BEGIN
            const size_t off = (size_t)r * 2048 + u.pn * 256 + cl;
            const u32x4 g = *(const u32x4*)(TG + off);
            v0[0] *= bflo(g.x); v0[1] *= bfhi(g.x); v0[2] *= bflo(g.y); v0[3] *= bfhi(g.y); v1[0] *= bflo(g.z); v1[1] *= bfhi(g.z); v1[2] *= bflo(g.w); v1[3] *= bfhi(g.w);
            if (ADD) { const u32x4 o = *(const u32x4*)(ADDEND + off);
                v0[0] += bflo(o.x); v0[1] += bfhi(o.x); v0[2] += bflo(o.y); v0[3] += bfhi(o.y); v1[0] += bflo(o.z); v1[1] += bfhi(o.z); v1[2] += bflo(o.w); v1[3] += bfhi(o.w); }
            *(u32x4*)(OUT + off) = pack_row8(v0, v1);
        EPI_END
    }
};
struct EpiRes {
    static constexpr bool PERM = true, AFTER_DRAIN = false;
    const float* res; const float* gate; float* out;
    DI void operator()(EPI_ARGS) const {
        const float* gp = gate + (u.pm >> 5) * 12288 + u.pn * 256;
        EPI_BEGIN
            const size_t off = (size_t)r * 2048 + u.pn * 256 + cl;
            const f32x4 g0 = *(const f32x4*)(gp + cl), g1 = *(const f32x4*)(gp + cl + 4);
            const f32x4 x0 = *(const f32x4*)(res + off), x1 = *(const f32x4*)(res + off + 4);
            *(f32x4*)(out + off) = x0 + g0 * v0; *(f32x4*)(out + off + 4) = x1 + g1 * v1;
        EPI_END
    }
};
struct EpiRelu2 {
    static constexpr bool PERM = true, AFTER_DRAIN = false;
    bf16_t* O; int ldc;
    DI void operator()(EPI_ARGS) const {
        EPI_BEGIN
#pragma unroll
            for (int i = 0; i < 4; ++i) { float a = fmaxf(v0[i], 0.f); v0[i] = a * a; a = fmaxf(v1[i], 0.f); v1[i] = a * a; }
            *(u32x4*)(O + (size_t)r * ldc + u.pn * 256 + cl) = pack_row8(v0, v1);
        EPI_END
    }
};

DI void phase_conv(const bf16_t* qkv, const float* conv_w, bf16_t* Qc, bf16_t* Kc, bf16_t* Vc, int wave, int lane) {
    const int gw = blockIdx.x * 8 + wave, NGW = gridDim.x * 8;
    for (int it = gw; it < 6 * 1024; it += NGW) {
        const int g = it % 6, run = it / 6, t0 = run * 16, tl0 = t0 & 8191, ch = g * 512 + 8 * lane;
        u32x4 rows[20];
#pragma unroll
        for (int i = 0; i < 20; ++i) { const int tl = tl0 - 2 + i; rows[i] = (tl >= 0 && tl < 8192) ? *(const u32x4*)(qkv + (size_t)(t0 - 2 + i) * 3072 + ch) : (u32x4){0u, 0u, 0u, 0u}; }
        f32x4 wl[5], wh[5];
#pragma unroll
        for (int j = 0; j < 5; ++j) { wl[j] = *(const f32x4*)(conv_w + j * 3072 + ch); wh[j] = *(const f32x4*)(conv_w + j * 3072 + ch + 4); }
        bf16_t* dst = (g < 2 ? Qc : (g < 4 ? Kc : Vc)) + (size_t)t0 * 1024 + (g & 1) * 512 + 8 * lane;
        const float post = g < 2 ? 0.08838834764831845f : 1.f;
#pragma unroll
        for (int i = 0; i < 16; ++i) {
            float a[8] = {0.f, 0.f, 0.f, 0.f, 0.f, 0.f, 0.f, 0.f};
#pragma unroll
            for (int j = 0; j < 5; ++j) { const u32x4 r = rows[i + j];
                a[0] += wl[j][0] * bflo(r.x); a[1] += wl[j][1] * bfhi(r.x); a[2] += wl[j][2] * bflo(r.y); a[3] += wl[j][3] * bfhi(r.y);
                a[4] += wh[j][0] * bflo(r.z); a[5] += wh[j][1] * bfhi(r.z); a[6] += wh[j][2] * bflo(r.w); a[7] += wh[j][3] * bfhi(r.w); }
            float ss = 0.f;
#pragma unroll
            for (int e = 0; e < 8; ++e) { a[e] = siluf_(a[e]); ss += a[e] * a[e]; }
            if (g < 4) { ss += __shfl_xor(ss, 1); ss += __shfl_xor(ss, 2); ss += __shfl_xor(ss, 4); ss += __shfl_xor(ss, 8);
                const float sc = rsqrtf(ss + EPS) * post;
#pragma unroll
                for (int e = 0; e < 8; ++e) a[e] *= sc; }
            u32x4 o; o.x = pk2(a[0], a[1]); o.y = pk2(a[2], a[3]); o.z = pk2(a[4], a[5]); o.w = pk2(a[6], a[7]);
            *(u32x4*)(dst + (size_t)i * 1024) = o;
        }
    }
}
DI void normrope16(bf16_t* ptr, const float* nw, const LAS f32x2* tab, float scale, int lane) {
    u32x4 a = *(const u32x4*)ptr, b = *(const u32x4*)(ptr + 8);
    float v[16];
    v[0] = bflo(a.x); v[1] = bfhi(a.x); v[2] = bflo(a.y); v[3] = bfhi(a.y); v[4] = bflo(a.z); v[5] = bfhi(a.z); v[6] = bflo(a.w); v[7] = bfhi(a.w);
    v[8] = bflo(b.x); v[9] = bfhi(b.x); v[10] = bflo(b.y); v[11] = bfhi(b.y); v[12] = bflo(b.z); v[13] = bfhi(b.z); v[14] = bflo(b.w); v[15] = bfhi(b.w);
    float ss = 0.f;
#pragma unroll
    for (int i = 0; i < 16; ++i) ss += v[i] * v[i];
    ss += __shfl_xor(ss, 1); ss += __shfl_xor(ss, 2); ss += __shfl_xor(ss, 4);
    const float rstd = rsqrtf(ss * (1.f / 128.f) + EPS);
    const int sub = lane & 7;
#pragma unroll
    for (int i = 0; i < 16; ++i) v[i] = v[i] * rstd * nw[sub * 16 + i];
#pragma unroll
    for (int i = 0; i < 16; ++i) { const float pr = __shfl_xor(v[i], 1); const f32x2 cs = tab[i];
        if (sub == 0) v[i] = v[i] * cs[0] - pr * cs[1]; else if (sub == 1) v[i] = v[i] * cs[0] + pr * cs[1]; }
    u32x4 o0, o1;
    o0.x = pk2(v[0] * scale, v[1] * scale); o0.y = pk2(v[2] * scale, v[3] * scale); o0.z = pk2(v[4] * scale, v[5] * scale); o0.w = pk2(v[6] * scale, v[7] * scale);
    o1.x = pk2(v[8] * scale, v[9] * scale); o1.y = pk2(v[10] * scale, v[11] * scale); o1.z = pk2(v[12] * scale, v[13] * scale); o1.w = pk2(v[14] * scale, v[15] * scale);
    *(u32x4*)ptr = o0; *(u32x4*)(ptr + 8) = o1;
}
DI void phase_swa_normrope(bf16_t* QSW, bf16_t* KVSW, const float* qn_w, const float* kn_w, LAS unsigned char* lds, int wave, int lane) {
    const int gw = blockIdx.x * 8 + wave, NGW = gridDim.x * 8;
    LAS f32x2* tab = (LAS f32x2*)(lds + wave * 128);
    for (int tk = gw; tk < T; tk += NGW) {
        const int pos = tk & 8191;
        if (lane < 16) {
            const float invf = exp2f(-(float)lane * (18.931568569324174f / 16.f));
            const float ang = (float)pos * invf;
            const double ad = (double)ang; const double kq = __builtin_rint(ad * 0.15915494309189535); const float rr = (float)(ad - kq * 6.283185307179586);
            f32x2 cs; cs[0] = __cosf(rr); cs[1] = __sinf(rr); tab[lane] = cs;
        }
        LDS_WAIT();
        normrope16(QSW + (size_t)tk * 1024 + lane * 16, qn_w, tab, 0.08838834764831845f, lane);
        if (lane < 16) normrope16(KVSW + (size_t)tk * 512 + lane * 16, kn_w, tab, 1.f, lane);
        LDS_WAIT();
    }
}

DI void swa_block(const bf16_t* QSW, const bf16_t* KVSW, const float* sink, bf16_t* Ysw, LAS unsigned char* lds, int tid, int wave, int lane) {
    const int fr = lane & 15, fq = lane >> 4, r = tid >> 2, sg = tid & 3, qi = 16 * wave + fr;
    LAS bf16_t* Kl = (LAS bf16_t*)lds; LAS bf16_t* VTl = Kl + 128 * 136;
    int it = blockIdx.x; if (it >= 1024) return;
    int kb = (((it >> 3) & 63) == 0) ? 1 : 0;
    u32x4 kk[4], vv[4]; bf16x8 qf[4], qn[4];
#define ATT_LOADKV(item_, kb_) do { const int hkv_ = ((item_) & 7) >> 2, nb_ = ((item_) >> 3) & 63, b_ = (item_) >> 9; const size_t tok_ = (size_t)b_ * L + 128 * (nb_ - 1 + (kb_)) + r; \
        const u32x4* ks_ = (const u32x4*)(KVSW + tok_ * 512 + hkv_ * 128 + sg * 32); const u32x4* vs_ = (const u32x4*)(KVSW + tok_ * 512 + 256 + hkv_ * 128 + sg * 32); \
        _Pragma("unroll") for (int i = 0; i < 4; ++i) { kk[i] = ks_[i]; vv[i] = vs_[i]; } } while (0)
#define ATT_LOADQ(dst, item_) do { const int hq_ = (item_) & 7, nb_ = ((item_) >> 3) & 63, b_ = (item_) >> 9; const size_t tq_ = (size_t)b_ * L + 128 * nb_ + qi; \
        _Pragma("unroll") for (int ks = 0; ks < 4; ++ks) dst[ks] = *(const bf16x8*)(QSW + tq_ * 1024 + hq_ * 128 + 32 * ks + 8 * fq); } while (0)
    ATT_LOADKV(it, kb); ATT_LOADQ(qf, it);
#pragma unroll
    for (int ks = 0; ks < 4; ++ks) qn[ks] = qf[ks];
    float mrun = 0.f, lrun = 0.f; f32x4 ot[8];
    bool first = true;
    for (;;) {
        const int hq = it & 7, nb = (it >> 3) & 63, b = it >> 9;
        __syncthreads();
#pragma unroll
        for (int i = 0; i < 4; ++i) { *(LAS u32x4*)(Kl + r * 136 + sg * 32 + 8 * i) = kk[i]; *(LAS u32x4*)(VTl + r * 136 + sg * 32 + 8 * i) = vv[i]; }
        __syncthreads();
        const bool last_kb = (kb == 2) || (nb + kb >= 64);
        int nit = it, nkb = kb + 1;
        if (last_kb) { nit = it + gridDim.x; nkb = (((nit >> 3) & 63) == 0) ? 1 : 0; }
        const bool more = nit < 1024;
        if (more) { ATT_LOADKV(nit, nkb); if (last_kb) ATT_LOADQ(qn, nit); }
        if (first) { mrun = sink[hq]; lrun = (fq == 0) ? 1.f : 0.f;
#pragma unroll
            for (int i = 0; i < 8; ++i) ot[i] = (f32x4){0.f, 0.f, 0.f, 0.f}; }
        f32x4 st[8];
#pragma unroll
        for (int mt = 0; mt < 8; ++mt) { st[mt] = (f32x4){0.f, 0.f, 0.f, 0.f};
#pragma unroll
            for (int ks = 0; ks < 4; ++ks) { const bf16x8 a = *(const LAS bf16x8*)(Kl + (16 * mt + fr) * 136 + 32 * ks + 8 * fq); st[mt] = mfma16(a, qf[ks], st[mt]); } }
        float mx = -INFINITY;
#pragma unroll
        for (int mt = 0; mt < 8; ++mt)
#pragma unroll
            for (int j = 0; j < 4; ++j) { const int kj = 16 * mt + 4 * fq + j; const bool valid = (kb == 0) ? (kj >= qi) : ((kb == 2) ? (kj <= qi) : true);
                const float sv = valid ? st[mt][j] : -INFINITY; st[mt][j] = sv; mx = fmaxf(mx, sv); }
        mx = fmaxf(mx, __shfl_xor(mx, 16)); mx = fmaxf(mx, __shfl_xor(mx, 32));
        const float mnew = fmaxf(mrun, mx), alpha = __expf(mrun - mnew);
        float ls = 0.f;
#pragma unroll
        for (int mt = 0; mt < 8; ++mt)
#pragma unroll
            for (int j = 0; j < 4; ++j) { const float pe = __expf(st[mt][j] - mnew); st[mt][j] = pe; ls += pe; }
        lrun = lrun * alpha + ls; mrun = mnew;
#pragma unroll
        for (int dt = 0; dt < 8; ++dt) ot[dt] *= alpha;
        bf16x8 pb[4];
#pragma unroll
        for (int ks = 0; ks < 4; ++ks) pb[ks] = pack8(st[2 * ks], st[2 * ks + 1]);
#pragma unroll
        for (int dt = 0; dt < 8; ++dt)
#pragma unroll
            for (int ks = 0; ks < 4; ++ks) { const LAS bf16_t* vp = VTl + (32 * ks + 4 * fq + (fr >> 2)) * 136 + 16 * dt + 4 * (fr & 3);
                const bf16x8 av = cat4(tr_read(vp), tr_read(vp + 16 * 136)); ot[dt] = mfma16(av, pb[ks], ot[dt]); }
        first = false;
        if (last_kb) {
            float lt = lrun; lt += __shfl_xor(lt, 16); lt += __shfl_xor(lt, 32);
            const float inv = 1.f / lt; const size_t tokq = (size_t)b * L + 128 * nb + qi;
#pragma unroll
            for (int dt = 0; dt < 8; ++dt) { u32x2 o; o.x = pk2(ot[dt][0] * inv, ot[dt][1] * inv); o.y = pk2(ot[dt][2] * inv, ot[dt][3] * inv);
                *(u32x2*)(Ysw + tokq * 1024 + hq * 128 + 16 * dt + 4 * fq) = o; }
#pragma unroll
            for (int ks = 0; ks < 4; ++ks) qf[ks] = qn[ks];
            first = true;
        }
        if (!more) break;
        it = nit; kb = nkb;
    }
#undef ATT_LOADKV
#undef ATT_LOADQ
}

constexpr int PREP_SET = 70400;
DI void dn_prep_pair(const unsigned char* ws_c, unsigned char* ws, LAS unsigned char* lds, int pair, int tid, int wave, int lane) {
    const bf16_t* Qc = (const bf16_t*)(ws_c + OFF_QC); const bf16_t* Kc = (const bf16_t*)(ws_c + OFF_KC); const bf16_t* Vc = (const bf16_t*)(ws_c + OFF_VC);
    const float* BA = (const float*)(ws_c + OFF_BA);
    bf16_t* Wg = (bf16_t*)(ws + OFF_W); bf16_t* Ug = (bf16_t*)(ws + OFF_U); bf16_t* Ag = (bf16_t*)(ws + OFF_A);
    f32x2* GC = (f32x2*)(ws + OFF_GC); float* EGL = (float*)(ws + OFF_EGL);
    { int l0 = threadIdx.x; asm volatile("" : "+v"(l0)); tid = l0; lane = l0 & 63; }
    const int grp = wave >> 2, wl = wave & 3, lt = tid & 255, item = 2 * pair + grp;
    const int n = item & 127, dirbh = item >> 7, dir = dirbh >> 4, b = (dirbh >> 3) & 1, h = dirbh & 7, fr = lane & 15, fq = lane >> 4;
    LAS unsigned char* base = lds + grp * PREP_SET;
    LAS bf16_t* Ks = (LAS bf16_t*)base; LAS bf16_t* Vs = Ks + 64 * 136; LAS float* Akk = (LAS float*)(base + 34816);
    LAS bf16_t* Qs = (LAS bf16_t*)(base + 51200);
    LAS bf16_t* Tb1 = (LAS bf16_t*)(base + 51200); LAS bf16_t* Tb2 = Tb1 + 64 * 72;
    LAS float* sg = (LAS float*)(base + 69632); LAS float* sb = sg + 64; LAS float* seg = sg + 128;
    __syncthreads();
    { const int c = lt >> 2, part = lt & 3;
      const size_t tok = (size_t)b * L + (dir ? (L - 1 - 64 * n - c) : (64 * n + c));
      const size_t go = tok * 1024 + h * 128 + part * 32;
      u32x4 kk[4], qq[4], vv[4];
#pragma unroll
      for (int i = 0; i < 4; ++i) { kk[i] = *(const u32x4*)(Kc + go + 8 * i); qq[i] = *(const u32x4*)(Qc + go + 8 * i); vv[i] = *(const u32x4*)(Vc + go + 8 * i); }
      if (wl == 0) {
          const size_t tk = (size_t)b * L + (dir ? (L - 1 - 64 * n - lane) : (64 * n + lane));
          const float beta = BA[tk * 32 + dir * 8 + h]; float g = BA[tk * 32 + 16 + dir * 8 + h];
#pragma unroll
          for (int off = 1; off < 64; off <<= 1) { const float t = __shfl_up(g, off); if (lane >= off) g += t; }
          const float eg = __expf(g), gl = __shfl(g, 63), dg = __expf(gl - g);
          sg[lane] = g; sb[lane] = beta; seg[lane] = eg;
          f32x2 w; w[0] = eg; w[1] = dg; GC[(size_t)dirbh * 8192 + 64 * n + lane] = w;
          if (lane == 63) EGL[dirbh * 128 + n] = eg;
      }
#pragma unroll
      for (int i = 0; i < 4; ++i) { *(LAS u32x4*)(Ks + c * 136 + part * 32 + 8 * i) = kk[i]; *(LAS u32x4*)(Qs + c * 136 + part * 32 + 8 * i) = qq[i]; *(LAS u32x4*)(Vs + c * 136 + part * 32 + 8 * i) = vv[i]; }
    }
    __syncthreads();
    for (int jb = wl; jb < 32; jb += 4) {
        const int which = jb >> 4, mt = (jb >> 2) & 3, nt = jb & 3;
        if (nt > mt && which == 0) continue;
        f32x4 acc = {0.f, 0.f, 0.f, 0.f};
        if (nt <= mt) {
            const LAS bf16_t* Cp = (which ? Qs : Ks) + (16 * mt + fr) * 136 + 8 * fq; const LAS bf16_t* Sp = Ks + (16 * nt + fr) * 136 + 8 * fq;
#pragma unroll
            for (int ks = 0; ks < 4; ++ks) acc = mfma16(*(const LAS bf16x8*)(Sp + 32 * ks), *(const LAS bf16x8*)(Cp + 32 * ks), acc);
        }
        const int cc = 16 * mt + fr; const float gc = sg[cc], bc = sb[cc];
        f32x4 o;
#pragma unroll
        for (int j = 0; j < 4; ++j) { const int s = 16 * nt + 4 * fq + j; const float dec = (s <= cc) ? __expf(gc - sg[s]) : 0.f;
            o[j] = (which == 0) ? ((s < cc) ? bc * acc[j] * dec : 0.f) : acc[j] * dec; }
        if (which == 0) { LAS float* ap = Akk + (16 * nt + 4 * fq) * 64 + cc;
            ap[0] = o[0]; ap[64] = o[1]; ap[128] = o[2]; ap[192] = o[3]; }
        else { u32x2 w; w.x = pk2(o[0], o[1]); w.y = pk2(o[2], o[3]); *(u32x2*)(Ag + (size_t)item * 4096 + cc * 64 + 16 * nt + 4 * fq) = w; }
    }
    __syncthreads();
    {
        int zoff = 0; asm volatile("" : "+v"(zoff));
        const LAS float* Akz = Akk + zoff;
        LAS float* Tl = (LAS float*)(base + 51200);
        LAS float* Xs = (LAS float*)(lds + 2 * PREP_SET + grp * 4096);
        LAS float* Dl = (LAS float*)(lds + 2 * PREP_SET + 8192 + grp * 4096);
        {   float Y[16];
#pragma unroll
            for (int r = 0; r < 16; ++r) Y[r] = (lane == r) ? 1.f : 0.f;
#pragma unroll
            for (int jj = 0; jj < 16; ++jj) {
                const float t = Y[jj]; if (lane < 16) Dl[(wl * 16 + jj) * 16 + lane] = t;
                if (jj < 15) { const LAS float* ar = Akz + (16 * wl + jj) * 64 + 16 * wl;
#pragma unroll
                    for (int r4 = (jj + 1) / 4; r4 < 4; ++r4) { const f32x4 av = *(const LAS f32x4*)(ar + 4 * r4);
#pragma unroll
                        for (int e = 0; e < 4; ++e) { if (4 * r4 + e > jj) fnma(Y[4 * r4 + e], av[e], t); } } }
            }
        }
        __syncthreads();
        const LAS float* Dz = Dl + zoff;
        for (int P = 0; P < 4; ++P) {
            float X[4];
#pragma unroll
            for (int e = 0; e < 4; ++e) X[e] = (lane == 16 * P + 4 * wl + e) ? 1.f : 0.f;
            const int nj = 16 * P;
            if (nj > 0) {
                float tj = Tl[lane]; f32x4 a0 = *(const LAS f32x4*)(Akz + 16 * P + 4 * wl);
                for (int j = 0; j < nj; ++j) {
                    const int jn = (j + 1 < nj) ? j + 1 : j;
                    const float tn = Tl[jn * 64 + lane]; const f32x4 n0 = *(const LAS f32x4*)(Akz + jn * 64 + 16 * P + 4 * wl);
#pragma unroll
                    for (int e = 0; e < 4; ++e) fnma(X[e], a0[e], tj);
                    tj = tn; a0 = n0;
                }
            }
#pragma unroll
            for (int e = 0; e < 4; ++e) Xs[(4 * wl + e) * 64 + lane] = X[e];
            __syncthreads();
            {   float Tn[4] = {0.f, 0.f, 0.f, 0.f}; float xk[16]; f32x4 dv[4][4];
#pragma unroll
                for (int k = 0; k < 16; ++k) xk[k] = Xs[k * 64 + lane];
#pragma unroll
                for (int e = 0; e < 4; ++e)
#pragma unroll
                    for (int k4 = 0; k4 < 4; ++k4) dv[e][k4] = *(const LAS f32x4*)(Dz + (P * 16 + 4 * wl + e) * 16 + 4 * k4);
#pragma unroll
                for (int k = 0; k < 16; ++k)
#pragma unroll
                    for (int e = 0; e < 4; ++e) fpma(Tn[e], dv[e][k >> 2][k & 3], xk[k]);
#pragma unroll
                for (int e = 0; e < 4; ++e) Tl[(16 * P + 4 * wl + e) * 64 + lane] = Tn[e];
            }
            __syncthreads();
        }
        const float c1 = sb[lane], c2 = -c1 * seg[lane];
        float Tc[16];
#pragma unroll
        for (int i = 0; i < 16; ++i) Tc[i] = Tl[(16 * wl + i) * 64 + lane];
        __syncthreads();
#pragma unroll
        for (int i = 0; i < 16; ++i) { const unsigned w = pk2(Tc[i] * c1, Tc[i] * c2); Tb1[(16 * wl + i) * 72 + lane] = (bf16_t)(w & 0xffffu); Tb2[(16 * wl + i) * 72 + lane] = (bf16_t)(w >> 16); }
    }
    __syncthreads();
    { int l2 = threadIdx.x; asm volatile("" : "+v"(l2)); lane = l2 & 63; }
    const int fr2 = lane & 15, fq2 = lane >> 4;
#define fr fr2
#define fq fq2
    for (int jb = wl; jb < 64; jb += 4) {
        const int which = jb >> 5, mt = (jb >> 3) & 3, nt = jb & 7;
        const LAS bf16_t* Tp = (which ? Tb2 : Tb1) + (16 * mt + fr) * 72 + 8 * fq;
        const LAS bf16_t* Xp = (which ? Ks : Vs) + (8 * fq + (fr >> 2)) * 136 + 16 * nt + 4 * (fr & 3);
        f32x4 acc = {0.f, 0.f, 0.f, 0.f};
        acc = mfma16(cat4(tr_read(Xp), tr_read(Xp + 4 * 136)), *(const LAS bf16x8*)Tp, acc);
        if (mt >= 2) acc = mfma16(cat4(tr_read(Xp + 32 * 136), tr_read(Xp + 36 * 136)), *(const LAS bf16x8*)(Tp + 32), acc);
        u32x2 w; w.x = pk2(acc[0], acc[1]); w.y = pk2(acc[2], acc[3]);
        *(u32x2*)((which ? Wg : Ug) + ((size_t)item * 64 + 16 * mt + fr) * 128 + 16 * nt + 4 * fq) = w;
    }
#undef fr
#undef fq
}

constexpr int SC4_BUF = 71168;
DI void scan_item(const unsigned char* ws_c, unsigned char* ws, LAS unsigned char* lds, int dirbh, int half, int tid, int wave, int lane) {
    const bf16_t* Qc = (const bf16_t*)(ws_c + OFF_QC); const bf16_t* Kc = (const bf16_t*)(ws_c + OFF_KC);
    const bf16_t* Wg = (const bf16_t*)(ws_c + OFF_W); const bf16_t* Ug = (const bf16_t*)(ws_c + OFF_U); const bf16_t* Ag = (const bf16_t*)(ws_c + OFF_A);
    const f32x2* GC = (const f32x2*)(ws_c + OFF_GC);
    const int dir = dirbh >> 4, b = (dirbh >> 3) & 1, h = dirbh & 7, e0 = 64 * half + 16 * (wave & 3), el = 16 * (wave & 3), fr = lane & 15, fq = lane >> 4;
    bf16_t* Og = (bf16_t*)(ws + (dir ? OFF_OB : OFF_OF));
    struct Stg { u32x4 w0, w1, q0, q1, k0, k1, a, u; f32x2 g; };
#define SC_LOAD(R, vt, nn) do { const int row = (vt) >> 3, s8 = (vt) & 7, row2 = (vt) >> 1, hf = (vt) & 1; const size_t ci = (size_t)dirbh * 128 + (nn); \
        const bf16_t* wsrc = Wg + (ci * 64 + row) * 128 + s8 * 16; R.w0 = *(const u32x4*)wsrc; R.w1 = *(const u32x4*)(wsrc + 8); \
        const size_t tok = (size_t)b * L + (dir ? (L - 1 - 64 * (nn) - row) : (64 * (nn) + row)); const size_t go = tok * 1024 + h * 128 + s8 * 16; \
        R.q0 = *(const u32x4*)(Qc + go); R.q1 = *(const u32x4*)(Qc + go + 8); R.k0 = *(const u32x4*)(Kc + go); R.k1 = *(const u32x4*)(Kc + go + 8); \
        R.a = *(const u32x4*)(Ag + (ci * 64 + row) * 64 + s8 * 8); \
        R.u = *(const u32x4*)(Ug + (ci * 64 + row) * 128 + 64 * half + s8 * 8); \
        if ((vt) < 64) R.g = GC[(size_t)dirbh * 8192 + 64 * (nn) + (vt)]; } while (0)
#define SC_STORE(R, vt, bufp) do { const int row = (vt) >> 3, s8 = (vt) & 7, row2 = (vt) >> 1, hf = (vt) & 1; \
        LAS bf16_t* Wl_ = (LAS bf16_t*)(bufp); LAS bf16_t* Ql_ = Wl_ + 64 * 136; LAS bf16_t* Kl_ = Ql_ + 64 * 136; LAS bf16_t* Al_ = Kl_ + 64 * 136; LAS bf16_t* Ul_ = Al_ + 64 * 72; LAS float* EG_ = (LAS float*)(Ul_ + 64 * 72); \
        *(LAS u32x4*)(Wl_ + row * 136 + s8 * 16) = R.w0; *(LAS u32x4*)(Wl_ + row * 136 + s8 * 16 + 8) = R.w1; \
        *(LAS u32x4*)(Ql_ + row * 136 + s8 * 16) = R.q0; *(LAS u32x4*)(Ql_ + row * 136 + s8 * 16 + 8) = R.q1; \
        *(LAS u32x4*)(Kl_ + row * 136 + s8 * 16) = R.k0; *(LAS u32x4*)(Kl_ + row * 136 + s8 * 16 + 8) = R.k1; \
        *(LAS u32x4*)(Al_ + row * 72 + s8 * 8) = R.a; \
        *(LAS u32x4*)(Ul_ + row * 72 + s8 * 8) = R.u; \
        if ((vt) < 64) { EG_[(vt)] = R.g[0]; EG_[64 + (vt)] = R.g[1]; } } while (0)
    __syncthreads();
    { Stg R; R.u = (u32x4){0u, 0u, 0u, 0u}; R.g = (f32x2){0.f, 0.f}; SC_LOAD(R, tid, 0); SC_STORE(R, tid, lds); }
    __syncthreads();
    if (wave >= 4) {
        const int v0 = tid - 256, v1 = tid; const bool two = true;
        Stg R0, R1; R0.u = (u32x4){0u, 0u, 0u, 0u}; R0.g = (f32x2){0.f, 0.f}; R1 = R0;
        SC_LOAD(R0, v0, 1); if (two) SC_LOAD(R1, v1, 1);
        for (int n = 0; n < 128; ++n) {
            LAS unsigned char* nxt = lds + ((n + 1) & 1) * SC4_BUF;
            if (n + 1 < 128) { SC_STORE(R0, v0, nxt); if (two) SC_STORE(R1, v1, nxt); }
            if (n + 2 < 128) { SC_LOAD(R0, v0, n + 2); if (two) SC_LOAD(R1, v1, n + 2); }
            __syncthreads();
        }
    } else {
    f32x4 S[8];
#pragma unroll
    for (int i = 0; i < 8; ++i) S[i] = (f32x4){0.f, 0.f, 0.f, 0.f};
    for (int n = 0; n < 128; ++n) {
        LAS unsigned char* cur = lds + (n & 1) * SC4_BUF;
        {
            const LAS bf16_t* Wl = (const LAS bf16_t*)cur; const LAS bf16_t* Ql = Wl + 64 * 136; const LAS bf16_t* Kl = Ql + 64 * 136; const LAS bf16_t* Al = Kl + 64 * 136; const LAS bf16_t* Ul = Al + 64 * 72;
            const LAS float* EG = (const LAS float*)(Ul + 64 * 72); const LAS float* DG = EG + 64;
            bf16x8 Sb[4];
#pragma unroll
            for (int ks = 0; ks < 4; ++ks) Sb[ks] = pack8(S[2 * ks], S[2 * ks + 1]);
            f32x4 vn[4], oq[4], oa[4];
#pragma unroll
            for (int mt = 0; mt < 4; ++mt) {
#pragma unroll
                for (int j = 0; j < 4; ++j) vn[mt][j] = bf2f(Ul[(16 * mt + 4 * fq + j) * 72 + el + fr]);
                oq[mt] = (f32x4){0.f, 0.f, 0.f, 0.f}; oa[mt] = (f32x4){0.f, 0.f, 0.f, 0.f};
#pragma unroll
                for (int ks = 0; ks < 4; ++ks) { const LAS bf16_t* wp = Wl + (16 * mt + fr) * 136 + 32 * ks + 4 * fq; const LAS bf16_t* qp = Ql + (16 * mt + fr) * 136 + 32 * ks + 4 * fq;
                    vn[mt] = mfma16(cat4(*(const LAS s16x4*)wp, *(const LAS s16x4*)(wp + 16)), Sb[ks], vn[mt]);
                    oq[mt] = mfma16(Sb[ks], cat4(*(const LAS s16x4*)qp, *(const LAS s16x4*)(qp + 16)), oq[mt]); }
            }
            bf16x8 vb[2], vpb[2];
#pragma unroll
            for (int k2 = 0; k2 < 2; ++k2) { vb[k2] = pack8(vn[2 * k2], vn[2 * k2 + 1]);
                f32x4 a = vn[2 * k2], bb = vn[2 * k2 + 1];
#pragma unroll
                for (int j = 0; j < 4; ++j) { a[j] *= DG[32 * k2 + 4 * fq + j]; bb[j] *= DG[32 * k2 + 16 + 4 * fq + j]; }
                vpb[k2] = pack8(a, bb); }
#pragma unroll
            for (int mt = 0; mt < 4; ++mt)
#pragma unroll
                for (int k2 = 0; k2 < 2; ++k2) { if (k2 == 0 || mt >= 2) { const LAS bf16_t* ap = Al + (16 * mt + fr) * 72 + 32 * k2 + 4 * fq;
                    oa[mt] = mfma16(vb[k2], cat4(*(const LAS s16x4*)ap, *(const LAS s16x4*)(ap + 16)), oa[mt]); } }
#pragma unroll
            for (int mt = 0; mt < 4; ++mt) { const int cc = 16 * mt + fr; const size_t tok = (size_t)b * L + (dir ? (L - 1 - 64 * n - cc) : (64 * n + cc));
                const float eg = EG[cc]; u32x2 w; w.x = pk2(eg * oq[mt][0] + oa[mt][0], eg * oq[mt][1] + oa[mt][1]); w.y = pk2(eg * oq[mt][2] + oa[mt][2], eg * oq[mt][3] + oa[mt][3]);
                *(u32x2*)(Og + tok * 1024 + h * 128 + e0 + 4 * fq) = w; }
            const float egl = EG[63];
#pragma unroll
            for (int dt = 0; dt < 8; ++dt) { S[dt] *= egl;
#pragma unroll
                for (int k2 = 0; k2 < 2; ++k2) { const LAS bf16_t* kp = Kl + (32 * k2 + 4 * fq + (fr >> 2)) * 136 + 16 * dt + 4 * (fr & 3);
                    S[dt] = mfma16(cat4(tr_read(kp), tr_read(kp + 16 * 136)), vpb[k2], S[dt]); } }
        }
        __syncthreads();
    }
    }
#undef SC_LOAD
#undef SC_STORE
}

DI void phase_gated_norm(const bf16_t* OF, const bf16_t* OB, const bf16_t* Z, const float* nw, bf16_t* Y, int wave, int lane) {
    const int gw = blockIdx.x * 8 + wave, NGW = gridDim.x * 8;
    for (int tk = gw; tk < T; tk += NGW) {
        const size_t o = (size_t)tk * 1024 + lane * 16;
        const u32x4 f0 = *(const u32x4*)(OF + o), f1 = *(const u32x4*)(OF + o + 8), b0 = *(const u32x4*)(OB + o), b1 = *(const u32x4*)(OB + o + 8), z0 = *(const u32x4*)(Z + o), z1 = *(const u32x4*)(Z + o + 8);
        const unsigned fw[8] = {f0.x, f0.y, f0.z, f0.w, f1.x, f1.y, f1.z, f1.w}, bw[8] = {b0.x, b0.y, b0.z, b0.w, b1.x, b1.y, b1.z, b1.w}, zw[8] = {z0.x, z0.y, z0.z, z0.w, z1.x, z1.y, z1.z, z1.w};
        float v[16]; float ss = 0.f;
#pragma unroll
        for (int i = 0; i < 8; ++i) { v[2 * i] = bflo(fw[i]) + bflo(bw[i]); v[2 * i + 1] = bfhi(fw[i]) + bfhi(bw[i]); ss += v[2 * i] * v[2 * i] + v[2 * i + 1] * v[2 * i + 1]; }
        ss += __shfl_xor(ss, 1); ss += __shfl_xor(ss, 2); ss += __shfl_xor(ss, 4);
        const float rstd = rsqrtf(ss * (1.f / 128.f) + EPS);
        const float* wp = nw + (lane & 7) * 16;
        unsigned ow[8];
#pragma unroll
        for (int i = 0; i < 8; ++i) ow[i] = pk2(v[2 * i] * rstd * wp[2 * i] * bflo(zw[i]), v[2 * i + 1] * rstd * wp[2 * i + 1] * bfhi(zw[i]));
        u32x4 o0 = {ow[0], ow[1], ow[2], ow[3]}, o1 = {ow[4], ow[5], ow[6], ow[7]};
        *(u32x4*)(Y + o) = o0; *(u32x4*)(Y + o + 8) = o1;
    }
}

#define XB_TMO      128
#define XB_XCNT(j)  (256  + 64 * (j))
#define XB_XSUB(j)  (1280 + 64 * (j))
#define XB_XGEN(j)  (2304 + 64 * (j))
#define XB_TOP      3328
#define XB_TOPGEN   3392
#define XCD_BAR_WORDS 3456
#define XB_SPIN_CAP (1u << 18)

__device__ __forceinline__ unsigned xb_ld(unsigned* p)              { return __hip_atomic_load(p, __ATOMIC_RELAXED, __HIP_MEMORY_SCOPE_AGENT); }
__device__ __forceinline__ unsigned xb_add(unsigned* p, unsigned v) { return __hip_atomic_fetch_add(p, v, __ATOMIC_RELAXED, __HIP_MEMORY_SCOPE_AGENT); }
__device__ __forceinline__ unsigned xb_xcc_id() { return (unsigned)__builtin_amdgcn_s_getreg((3 << 11) | 20) & 0xFu; }
#define XB_SPIN(cond, bar) do { unsigned _sp = 0; while (cond) { __builtin_amdgcn_s_sleep(1); \
    if ((++_sp & 255u) == 0u) { if (xb_ld(&(bar)[XB_TMO])) break; if (_sp > XB_SPIN_CAP) { atomicAdd(&(bar)[XB_TMO], 1u); break; } } } } while (0)

struct XcdBarrier {
    unsigned* bar; unsigned x;
    volatile LAS unsigned* st;
};

__device__ __forceinline__ XcdBarrier xcd_barrier_post(unsigned* bar, volatile LAS unsigned* st) {
    XcdBarrier b; b.bar = bar; b.x = xb_xcc_id(); b.st = st;
    if (threadIdx.x == 0) (void)xb_add(&bar[XB_XCNT(b.x)], 1u);
    return b;
}
__device__ __forceinline__ void xcd_barrier_complete(unsigned* bar, unsigned x, unsigned& nloc, unsigned& nx) {
    const unsigned G = gridDim.x * gridDim.y * gridDim.z;
    unsigned sum, cnt, mine, sp = 0u;
    for (;;) {
        sum = 0u; cnt = 0u; mine = 0u;
#pragma unroll
        for (unsigned j = 0; j < 16; ++j) { const unsigned c = xb_ld(&bar[XB_XCNT(j)]); sum += c; cnt += (c > 0u) ? 1u : 0u; mine = (j == x) ? c : mine; }
        if (sum == G) break;
        __builtin_amdgcn_s_sleep(1);
        if ((++sp & 255u) == 0u) { if (xb_ld(&bar[XB_TMO])) break; if (sp > XB_SPIN_CAP) { atomicAdd(&bar[XB_TMO], 1u); break; } }
    }
    nloc = mine > 0u ? mine : 1u; nx = cnt > 0u ? cnt : 1u;
}

__device__ __forceinline__ void xcd_barrier(const XcdBarrier& b) {
    asm volatile("s_waitcnt vmcnt(0)" ::: "memory");
    __syncthreads();
    if (threadIdx.x == 0) {
        unsigned* bar = b.bar;
        __builtin_amdgcn_s_waitcnt(0);
        unsigned nloc = b.st[0], nx = b.st[1];
        if (nloc == 0u) { xcd_barrier_complete(bar, b.x, nloc, nx); b.st[0] = nloc; b.st[1] = nx; }
        const unsigned old = xb_add(&bar[XB_XSUB(b.x)], 1u);
        const unsigned gen = old / nloc;
        if (old + 1u == (gen + 1u) * nloc) {
            __builtin_amdgcn_fence(__ATOMIC_RELEASE, "agent");
            asm volatile("s_waitcnt vmcnt(0)" ::: "memory");
            const unsigned og = xb_add(&bar[XB_TOP], 1u);
            const unsigned tg = og / nx;
            if (og + 1u == (tg + 1u) * nx) xb_add(&bar[XB_TOPGEN], 1u);
            else XB_SPIN(xb_ld(&bar[XB_TOPGEN]) == tg, bar);
            __builtin_amdgcn_fence(__ATOMIC_ACQUIRE, "agent");
            xb_add(&bar[XB_XGEN(b.x)], 1u);
            asm volatile("s_waitcnt vmcnt(0)" ::: "memory");
        } else {
            XB_SPIN(xb_ld(&bar[XB_XGEN(b.x)]) == gen, bar);
            __builtin_amdgcn_fence(__ATOMIC_ACQUIRE, "agent");
            asm volatile("s_waitcnt vmcnt(0)" ::: "memory");
        }
    }
    __syncthreads();
}


struct SplitOrder {
    int nM, nN, G, c, lim;
    __device__ bool next(int i, pg8::Unit& u) const {
        const long Lx = (long)i * G + c; if (Lx >= lim) return false;
        const int wgid = (int)Lx; const int nig = pg8::WGM * nN, gid = wgid / nig, fm = gid * pg8::WGM, gsz = (nM - fm) < pg8::WGM ? (nM - fm) : pg8::WGM;
        u.pm = fm + ((wgid % nig) % gsz); u.pn = (wgid % nig) / gsz; return true;
    }
    __device__ __forceinline__ void a_ready(const pg8::Unit&) const {}
    __device__ __forceinline__ void done(const pg8::Unit&) const {}
};
struct EpiSig2 {
    static constexpr bool PERM = true, AFTER_DRAIN = false;
    bf16_t* O1; bf16_t* O2;
    DI void operator()(EPI_ARGS) const {
        bf16_t* O = (u.pn < 8 ? O1 : O2) + (u.pn & 7) * 256;
        EPI_BEGIN
#pragma unroll
            for (int i = 0; i < 4; ++i) { v0[i] = sigmoidf_(v0[i]); v1[i] = sigmoidf_(v1[i]); }
            *(u32x4*)(O + (size_t)r * 2048 + cl) = pack_row8(v0, v1);
        EPI_END
    }
};
constexpr bool GEMM_ALIGN = true, GEMM_SP2 = true;
template <class Epi> DI void run_gemm(LAS unsigned char* lds, const bf16_t* A, const bf16_t* Bt, int N, int K, const Epi& E) {
    pg8::Gemm g{A, Bt, T, N, K}; pg8::StaticOrder S; S.init(T, N, (int)gridDim.x, (int)blockIdx.x);
    pg8::gemm_phase<Epi, pg8::StaticOrder, GEMM_ALIGN, GEMM_SP2>(lds, g, S, E);
}

#define REP_P0 1
#define REP_P1 1
#define REP_P3 1
#define REP_P6 1
#define REP_P9 1
#define REP_ATT 1
#define REP_PREP 1
#define REP_SCAN 1
__global__ void __launch_bounds__(512, 2) hybrid_fwd(Params p) {
    extern __shared__ __attribute__((aligned(16))) unsigned char lds_raw[];
    LAS unsigned char* lds = (LAS unsigned char*)lds_raw;
    cg::grid_group grid = cg::this_grid();
    int tid, lane, wave;
#define FRESH_IDS() do { int t_ = threadIdx.x; asm volatile("" : "+v"(t_)); tid = t_; lane = t_ & 63; wave = __builtin_amdgcn_readfirstlane(t_ >> 6); } while (0)
    FRESH_IDS();
    unsigned char* ws = p.ws;
    const float* MOD = (const float*)(ws + OFF_MOD);

    volatile LAS unsigned* xst = (volatile LAS unsigned*)(lds + LDS_BYTES - 16);
    if (tid < 2) xst[tid] = 0u;
    if (blockIdx.x == 0) { for (int i = tid; i < 4096; i += 512) __hip_atomic_store((unsigned*)ws + i, 0u, __ATOMIC_RELAXED, __HIP_MEMORY_SCOPE_AGENT); }
    for (int rep = 0; rep < REP_P0; ++rep) phase0(p, lds, tid, wave, lane);
    grid.sync(); FRESH_IDS();
    XcdBarrier xbar = xcd_barrier_post((unsigned*)ws, xst);
#define GRID_BAR() do { xcd_barrier(xbar); FRESH_IDS(); } while (0)
    for (int rep = 0; rep < REP_P1; ++rep) phase_modnorm(p.x, p.norm1_w, MOD, 0, 2048, (bf16_t*)(ws + OFF_H), wave, lane);
    GRID_BAR();
    { EpiIn E{(bf16_t*)(ws + OFF_QKV), (bf16_t*)(ws + OFF_Z), (bf16_t*)(ws + OFF_QSW), (bf16_t*)(ws + OFF_KVSW), (float*)(ws + OFF_BA), p.a_log, p.dt_bias};
      run_gemm(lds, (const bf16_t*)(ws + OFF_H), (const bf16_t*)(ws + OFF_WIN) + (size_t)4096 * 2048, 5888, 2048, E); }
    GRID_BAR();
    for (int rep = 0; rep < REP_P3; ++rep) phase_conv((const bf16_t*)(ws + OFF_QKV), p.conv_w, (bf16_t*)(ws + OFF_QC), (bf16_t*)(ws + OFF_KC), (bf16_t*)(ws + OFF_VC), wave, lane);
    phase_swa_normrope((bf16_t*)(ws + OFF_QSW), (bf16_t*)(ws + OFF_KVSW), p.qn_w, p.kn_w, lds, wave, lane);
    GRID_BAR();
    for (int rep = 0; rep < REP_ATT; ++rep) swa_block((const bf16_t*)(ws + OFF_QSW), (const bf16_t*)(ws + OFF_KVSW), p.sink, (bf16_t*)(ws + OFF_YSW), lds, tid, wave, lane);
    for (int rep = 0; rep < REP_PREP; ++rep) for (int it = blockIdx.x; it < 2048; it += gridDim.x) dn_prep_pair(ws, ws, lds, it, tid, wave, lane);
    GRID_BAR();
    bf16_t* TG1 = (bf16_t*)p.out; bf16_t* TG2 = TG1 + (size_t)T * 2048;
    if (gridDim.x == 256) {
        const int bid = blockIdx.x;
        pg8::Gemm g{(const bf16_t*)(ws + OFF_H), (const bf16_t*)(ws + OFF_WIN), T, 4096, 2048}; EpiSig2 Eg{TG1, TG2};
        if (((bid >> 3) & 3) == 0) {
            for (int rep = 0; rep < REP_SCAN; ++rep) scan_item(ws, ws, lds, (bid >> 6) * 8 + (bid & 7), (bid >> 5) & 1, tid, wave, lane);
        } else {
            const int cv = bid - 8 * ((bid >> 5) + 1);
            SplitOrder S{64, 16, 192, cv, 1024};
            pg8::gemm_phase<EpiSig2, SplitOrder, GEMM_ALIGN, GEMM_SP2>(lds, g, S, Eg);
            asm volatile("s_waitcnt vmcnt(0)" ::: "memory"); __syncthreads();
            if (threadIdx.x == 0) { unsigned* cnt = (unsigned*)ws + 3584;
                __builtin_amdgcn_fence(__ATOMIC_RELEASE, "agent"); asm volatile("s_waitcnt vmcnt(0)" ::: "memory");
                __hip_atomic_fetch_add(cnt, 1u, __ATOMIC_RELAXED, __HIP_MEMORY_SCOPE_AGENT);
                unsigned sp = 0; while (__hip_atomic_load(cnt, __ATOMIC_RELAXED, __HIP_MEMORY_SCOPE_AGENT) < 192u && ++sp < (1u << 24)) __builtin_amdgcn_s_sleep(2);
                __builtin_amdgcn_fence(__ATOMIC_ACQUIRE, "agent"); asm volatile("s_waitcnt vmcnt(0)" ::: "memory"); }
            __syncthreads(); FRESH_IDS();
            { pg8::Gemm gb{(const bf16_t*)(ws + OFF_YSW), (const bf16_t*)(ws + OFF_WSW), T, 2048, 1024}; const SplitOrder Sb = cv < 64 ? SplitOrder{64, 8, 64, 384 + cv, 512} : SplitOrder{64, 8, 128, cv - 64, 384};
              EpiMerge<false> Eb{TG2, nullptr, TG2}; pg8::gemm_phase<EpiMerge<false>, SplitOrder, GEMM_ALIGN, GEMM_SP2>(lds, gb, Sb, Eb); }
        }
    } else {
        for (int d = blockIdx.x; d < 64; d += gridDim.x) scan_item(ws, ws, lds, d >> 1, d & 1, tid, wave, lane);
        { EpiSig Eg{TG1, 2048}; run_gemm(lds, (const bf16_t*)(ws + OFF_H), (const bf16_t*)(ws + OFF_WIN), 2048, 2048, Eg); }
        { EpiSig Eg{TG2, 2048}; run_gemm(lds, (const bf16_t*)(ws + OFF_H), (const bf16_t*)(ws + OFF_WIN) + (size_t)2048 * 2048, 2048, 2048, Eg); }
        { EpiMerge<false> Eb{TG2, nullptr, TG2}; run_gemm(lds, (const bf16_t*)(ws + OFF_YSW), (const bf16_t*)(ws + OFF_WSW), 2048, 1024, Eb); }
    }
    GRID_BAR();
    for (int rep = 0; rep < REP_P6; ++rep) phase_gated_norm((const bf16_t*)(ws + OFF_OF), (const bf16_t*)(ws + OFF_OB), (const bf16_t*)(ws + OFF_Z), p.dn_norm_w, (bf16_t*)(ws + OFF_YDN), wave, lane);
    GRID_BAR();
    { EpiMerge<true> Ea{TG1, TG2, (bf16_t*)(ws + OFF_MRG)};
      run_gemm(lds, (const bf16_t*)(ws + OFF_YDN), (const bf16_t*)(ws + OFF_WDN), 2048, 1024, Ea); }
    GRID_BAR();
    { EpiRes E{p.x, MOD + 4096, p.out};
      run_gemm(lds, (const bf16_t*)(ws + OFF_MRG), (const bf16_t*)(ws + OFF_WOUT), 2048, 2048, E); }
    GRID_BAR();
    for (int rep = 0; rep < REP_P9; ++rep) { phase_modnorm(p.out, p.norm2_w, MOD, 6144, 8192, (bf16_t*)(ws + OFF_H), wave, lane);
    phase_mlp_weights(p, lds, wave, lane); }
    GRID_BAR();
    { EpiRelu2 E{(bf16_t*)(ws + OFF_UU), 8192};
      run_gemm(lds, (const bf16_t*)(ws + OFF_H), (const bf16_t*)(ws + OFF_WMI), 8192, 2048, E); }
    GRID_BAR();
    { EpiRes E{p.out, MOD + 10240, p.out};
      run_gemm(lds, (const bf16_t*)(ws + OFF_UU), (const bf16_t*)(ws + OFF_WMO), 2048, 8192, E); }
}

extern "C" void kernel_launch(void* const* d_in, const int* in_sizes, int n_in, void* d_out, int out_size, void* d_ws, size_t ws_size, hipStream_t stream) {
    static int grid_blocks = 0;
    if (grid_blocks == 0) {
        if (n_in != 19 || out_size != T * D || ws_size < WS_END) { fprintf(stderr, "kernel_launch: unexpected shapes (n_in %d out %d ws %zu)\n", n_in, out_size, ws_size); grid_blocks = -1; return; }
        int dev = 0, cus = 0, per_cu = 0;
        hipGetDevice(&dev); hipDeviceGetAttribute(&cus, hipDeviceAttributeMultiprocessorCount, dev);
        hipFuncSetAttribute((const void*)hybrid_fwd, hipFuncAttributeMaxDynamicSharedMemorySize, LDS_BYTES);
        hipOccupancyMaxActiveBlocksPerMultiprocessor(&per_cu, (const void*)hybrid_fwd, 512, LDS_BYTES);
        if (per_cu < 1) { fprintf(stderr, "kernel_launch: occupancy query says %d blocks/CU\n", per_cu); per_cu = 1; }
        (void)hipGetLastError();
        grid_blocks = cus * per_cu;
    }
    if (grid_blocks < 0) return;
    Params p{};
    p.x = (const float*)d_in[0]; p.c = (const float*)d_in[1]; p.w_ada = (const float*)d_in[2]; p.b_ada = (const float*)d_in[3]; p.norm1_w = (const float*)d_in[4];
    p.w_in = (const float*)d_in[5]; p.conv_w = (const float*)d_in[6]; p.a_log = (const float*)d_in[7]; p.dt_bias = (const float*)d_in[8]; p.dn_norm_w = (const float*)d_in[9];
    p.w_dn = (const float*)d_in[10]; p.qn_w = (const float*)d_in[11]; p.kn_w = (const float*)d_in[12]; p.sink = (const float*)d_in[13]; p.w_sw = (const float*)d_in[14];
    p.w_out = (const float*)d_in[15]; p.norm2_w = (const float*)d_in[16]; p.w_mi = (const float*)d_in[17]; p.w_mo = (const float*)d_in[18];
    p.out = (float*)d_out; p.ws = (unsigned char*)d_ws;
    void* args[] = {&p};
    hipError_t e = hipLaunchCooperativeKernel((const void*)hybrid_fwd, dim3(grid_blocks), dim3(512), args, LDS_BYTES, stream);
    if (e != hipSuccess) fprintf(stderr, "cooperative launch failed: %s (grid %d)\n", hipGetErrorString(e), grid_blocks);
}
```

```cpp
#include <hip/hip_runtime.h>
#include <hip/hip_cooperative_groups.h>
#include <cstdio>
#include <cstdint>
namespace cg = cooperative_groups;

namespace pg8 {
#define PG8_LAS __attribute__((address_space(3)))
typedef unsigned short bf16_t;
typedef short bf16x8 __attribute__((ext_vector_type(8)));
typedef float f32x4 __attribute__((ext_vector_type(4)));
typedef unsigned u32x4 __attribute__((ext_vector_type(4)));
constexpr int BM = 256, BK = 64, HALF = 128, HTB = HALF * BK * 2  , STAGE_BYTES = 8 * HTB, NXCD = 8, WGM = 8;

__host__ __device__ __forceinline__ int lds_byte(int r, int c) { const int st = (r >> 4) * 2 + (c >> 5), rr = r & 15, cc = c & 31, ob = rr * 64 + cc * 2; return st * 1024 + (ob ^ (((ob >> 9) & 1) << 5)); }
__host__ __device__ __forceinline__ void stage_rc(int b, int& R, int& C) { const int st = b / 1024, sb = b % 1024, swz = sb ^ (((sb >> 9) & 1) << 5); R = (st >> 1) * 16 + swz / 64; C = (st & 1) * 32 + (swz % 64) / 2; }
__host__ __device__ __forceinline__ int perm32(int rho) { const int n = rho >> 4, i = rho & 15; return 8 * (i >> 2) + 4 * n + (i & 3); }

struct Unit { int pm, pn; };
struct Gemm { const bf16_t* A; const bf16_t* Bt; int M, N, K; };

struct StaticOrder {
    int nM, nN, nwg, G, c;
    __host__ __device__ void init(int M, int N, int G_, int c_) { nM = M / BM; nN = N / BM; nwg = nM * nN; G = G_; c = c_; }
    __host__ __device__ bool next(int i, Unit& u) const {
        const long L = (long)i * G + c; if (L >= nwg) return false;
        int wgid = (int)L; { const int q = nwg / NXCD, r = nwg % NXCD, xcd = wgid % NXCD, off = wgid / NXCD; wgid = (xcd < r ? xcd * (q + 1) : r * (q + 1) + (xcd - r) * q) + off; }
        const int nig = WGM * nN, gid = wgid / nig, fm = gid * WGM, gsz = (nM - fm) < WGM ? (nM - fm) : WGM;
        u.pm = fm + ((wgid % nig) % gsz); u.pn = (wgid % nig) / gsz; return true;
    }
    __device__ __forceinline__ void a_ready(const Unit&) const {}
    __device__ __forceinline__ void done(const Unit&) const {}
};
typedef float f32x2v __attribute__((ext_vector_type(2)));
typedef __bf16 bf16x2v __attribute__((ext_vector_type(2)));
__device__ __forceinline__ unsigned cvt_pk_bf16(float lo, float hi) { const f32x2v v = {lo, hi}; return __builtin_bit_cast(unsigned, __builtin_convertvector(v, bf16x2v)); }

template <class Epi, class Sched, bool ALIGN_EPI = false, bool SP2 = false>
__device__ __forceinline__ void gemm_phase(PG8_LAS unsigned char* lds, const Gemm g, const Sched& S, const Epi& E) {
    int tid_l = threadIdx.x; asm volatile("" : "+v"(tid_l));
    const int tid = tid_l, wid = __builtin_amdgcn_readfirstlane(tid >> 6), lane = tid & 63, wr = wid >> 2, wc = wid & 3, fr = lane & 15, fq = lane >> 4;
    const int K = g.K, nt = K / BK;
    unsigned voffA[2], voffB[2];
#pragma unroll
    for (int i = 0; i < 2; ++i) { int R, C; stage_rc(tid * 16 + i * 8192, R, C); const int Rb = Epi::PERM ? ((R & ~31) + perm32(R & 31)) : R;
        voffA[i] = (unsigned)(R * K + C) * 2u; voffB[i] = (unsigned)(Rb * K + C) * 2u; }
    const size_t kstep = (size_t)(BK * 2);
    const size_t hstep = (size_t)HALF * K * 2;
    const size_t tstep = 2 * hstep;
    const unsigned ldsw = (unsigned)wid * 1024u;
    const int aoff = lds_byte(wr * 64 + fr, fq * 8), boff = lds_byte(wc * 32 + fr, fq * 8);
#define PG8_SA(b, h) (((b) * 2 + (h)) * HTB)
#define PG8_SB(b, h) ((4 + (b) * 2 + (h)) * HTB)
#define PG8_STAGE(bufoff, gbase, voff) do { _Pragma("unroll") for (int _i = 0; _i < 2; ++_i) \
        __builtin_amdgcn_global_load_lds((const unsigned*)((const char*)(gbase) + (voff)[_i]), (PG8_LAS unsigned*)(lds + (bufoff) + ldsw + _i * 8192), 16, 0, 0); } while (0)
#define PG8_LDA(dst, b, h) do { _Pragma("unroll") for (int m = 0; m < 4; ++m) _Pragma("unroll") for (int k = 0; k < 2; ++k) dst[m][k] = *(const PG8_LAS bf16x8*)(lds + PG8_SA(b, h) + aoff + m * 2048 + k * 1024); } while (0)
#define PG8_LDB(dst, b, h) do { _Pragma("unroll") for (int n = 0; n < 2; ++n) _Pragma("unroll") for (int k = 0; k < 2; ++k) dst[n][k] = *(const PG8_LAS bf16x8*)(lds + PG8_SB(b, h) + boff + n * 2048 + k * 1024); } while (0)
#define PG8_MMA(ai, bj, At, Bt) do { __builtin_amdgcn_s_setprio(1); _Pragma("unroll") for (int m = 0; m < 4; ++m) _Pragma("unroll") for (int n = 0; n < 2; ++n) _Pragma("unroll") for (int k = 0; k < 2; ++k) \
        acc[ai][bj][m][n] = __builtin_amdgcn_mfma_f32_16x16x32_bf16(Bt[n][k], At[m][k], acc[ai][bj][m][n], 0, 0, 0); __builtin_amdgcn_s_setprio(0); } while (0)
#define PG8_WAIT_V(n) asm volatile("s_waitcnt vmcnt(" #n ")" ::: "memory")
#define PG8_WAIT_L(n) asm volatile("s_waitcnt lgkmcnt(" #n ")" ::: "memory")
#define PG8_BAR __builtin_amdgcn_s_barrier()
#define PG8_SCHED __builtin_amdgcn_sched_barrier(0)
    Unit cur, nxt; int ui = 0;
    if (!S.next(0, cur)) return;
    f32x4 acc[2][2][4][2];
#pragma unroll
    for (int a = 0; a < 2; ++a)
#pragma unroll
        for (int b = 0; b < 2; ++b)
#pragma unroll
            for (int m = 0; m < 4; ++m)
#pragma unroll
                for (int n = 0; n < 2; ++n) acc[a][b][m][n] = (f32x4){0.f, 0.f, 0.f, 0.f};
    bf16x8 At[4][2], B0[2][2], B1[2][2];
    const char* cA = (const char*)g.A + (size_t)cur.pm * tstep; const char* cB = (const char*)g.Bt + (size_t)cur.pn * tstep;
    S.a_ready(cur);
    if constexpr (SP2) {
        PG8_STAGE(PG8_SB(0, 0), cB, voffB); PG8_STAGE(PG8_SB(0, 1), cB + hstep, voffB); PG8_STAGE(PG8_SA(0, 0), cA, voffA); PG8_STAGE(PG8_SA(0, 1), cA + hstep, voffA);
        if (wr == 1) PG8_BAR;
        PG8_WAIT_V(2); PG8_BAR;
        PG8_STAGE(PG8_SB(1, 0), cB + kstep, voffB); PG8_STAGE(PG8_SA(1, 0), cA + kstep, voffA); PG8_STAGE(PG8_SB(1, 1), cB + hstep + kstep, voffB);
        PG8_WAIT_V(6); PG8_BAR;
    } else {
        PG8_STAGE(PG8_SB(0, 0), cB, voffB); PG8_STAGE(PG8_SA(0, 0), cA, voffA); PG8_STAGE(PG8_SB(0, 1), cB + hstep, voffB); PG8_STAGE(PG8_SA(0, 1), cA + hstep, voffA);
        if (wr == 1) PG8_BAR;
        PG8_WAIT_V(4); PG8_BAR;
        PG8_STAGE(PG8_SB(1, 0), cB + kstep, voffB); PG8_STAGE(PG8_SA(1, 0), cA + kstep, voffA); PG8_STAGE(PG8_SB(1, 1), cB + hstep + kstep, voffB);
        PG8_WAIT_V(6); PG8_BAR;
    }
    for (;;) {
        const bool has_next = S.next(ui + 1, nxt);
        const char* nA = has_next ? (const char*)g.A + (size_t)nxt.pm * tstep : cA; const char* nB = has_next ? (const char*)g.Bt + (size_t)nxt.pn * tstep : cB;
        for (int t = 0; t < nt; t += 2) {
            const bool last = (t == nt - 2);
            const char* a1 = cA + (size_t)(t + 1) * kstep;
            const char* a2 = last ? nA : cA + (size_t)(t + 2) * kstep; const char* b2 = last ? nB : cB + (size_t)(t + 2) * kstep;
            const char* a3 = a2 + kstep; const char* b3 = b2 + kstep;
            if (last && has_next) S.a_ready(nxt);
            if constexpr (SP2) {
            PG8_LDB(B0, 0, 0); PG8_LDB(B1, 0, 1); PG8_SCHED; PG8_LDA(At, 0, 0); PG8_STAGE(PG8_SA(1, 1), a1 + hstep, voffA);
            PG8_WAIT_V(8); PG8_WAIT_L(0); PG8_BAR; PG8_MMA(0, 0, At, B0); PG8_MMA(0, 1, At, B1); PG8_BAR; PG8_SCHED;
            PG8_LDA(At, 0, 1); PG8_STAGE(PG8_SB(0, 0), b2, voffB); PG8_STAGE(PG8_SB(0, 1), b2 + hstep, voffB); PG8_STAGE(PG8_SA(0, 0), a2, voffA);
            PG8_WAIT_V(8); PG8_WAIT_L(0); PG8_BAR; PG8_MMA(1, 0, At, B0); PG8_MMA(1, 1, At, B1); PG8_BAR; PG8_SCHED;
            PG8_LDB(B0, 1, 0); PG8_LDB(B1, 1, 1); PG8_SCHED; PG8_LDA(At, 1, 0); PG8_STAGE(PG8_SA(0, 1), a2 + hstep, voffA);
            PG8_WAIT_V(8); PG8_WAIT_L(0); PG8_BAR; PG8_MMA(0, 0, At, B0); PG8_MMA(0, 1, At, B1); PG8_BAR; PG8_SCHED;
            PG8_LDA(At, 1, 1); PG8_STAGE(PG8_SB(1, 0), b3, voffB); PG8_STAGE(PG8_SB(1, 1), b3 + hstep, voffB); PG8_STAGE(PG8_SA(1, 0), a3, voffA);
            PG8_WAIT_V(8); PG8_WAIT_L(0); PG8_BAR; PG8_MMA(1, 0, At, B0); PG8_MMA(1, 1, At, B1); PG8_BAR; PG8_SCHED;
            } else {
            PG8_LDB(B0, 0, 0); PG8_SCHED; PG8_LDA(At, 0, 0); PG8_STAGE(PG8_SA(1, 1), a1 + hstep, voffA);
            PG8_WAIT_L(8); PG8_BAR; PG8_WAIT_L(0); PG8_MMA(0, 0, At, B0); PG8_BAR; PG8_SCHED;
            PG8_LDB(B1, 0, 1); PG8_STAGE(PG8_SB(0, 0), b2, voffB);
            PG8_BAR; PG8_WAIT_L(0); PG8_MMA(0, 1, At, B1); PG8_BAR;
            PG8_LDA(At, 0, 1); PG8_STAGE(PG8_SA(0, 0), a2, voffA);
            PG8_BAR; PG8_WAIT_L(0); PG8_MMA(1, 0, At, B0); PG8_BAR; PG8_SCHED;
            PG8_STAGE(PG8_SB(0, 1), b2 + hstep, voffB);
            PG8_WAIT_V(6); PG8_BAR; PG8_MMA(1, 1, At, B1); PG8_BAR;
            PG8_LDB(B0, 1, 0); PG8_SCHED; PG8_LDA(At, 1, 0); PG8_STAGE(PG8_SA(0, 1), a2 + hstep, voffA);
            PG8_WAIT_L(8); PG8_BAR; PG8_WAIT_L(0); PG8_MMA(0, 0, At, B0); PG8_BAR; PG8_SCHED;
            PG8_LDB(B1, 1, 1); PG8_STAGE(PG8_SB(1, 0), b3, voffB);
            PG8_BAR; PG8_WAIT_L(0); PG8_MMA(0, 1, At, B1); PG8_BAR;
            PG8_LDA(At, 1, 1); PG8_STAGE(PG8_SA(1, 0), a3, voffA);
            PG8_BAR; PG8_WAIT_L(0); PG8_MMA(1, 0, At, B0); PG8_BAR; PG8_SCHED;
            PG8_STAGE(PG8_SB(1, 1), b3 + hstep, voffB);
            PG8_WAIT_V(6); PG8_BAR; PG8_MMA(1, 1, At, B1); PG8_BAR;
            }
        }
        if constexpr (ALIGN_EPI) { if (wr == 0) PG8_BAR; }
        if constexpr (!Epi::AFTER_DRAIN) { E(acc, cur, wr, wc, fr, fq); S.done(cur); }
        if (!has_next) break;
#pragma unroll
        for (int a = 0; a < 2; ++a)
#pragma unroll
            for (int b = 0; b < 2; ++b)
#pragma unroll
                for (int m = 0; m < 4; ++m)
#pragma unroll
                    for (int n = 0; n < 2; ++n) acc[a][b][m][n] = (f32x4){0.f, 0.f, 0.f, 0.f};
        cur = nxt; cA = nA; cB = nB; ++ui;
        if constexpr (ALIGN_EPI) { if (wr == 1) PG8_BAR; }
    }
    PG8_WAIT_V(0);
    if constexpr (!ALIGN_EPI) { if (wr == 0) PG8_BAR; }
    PG8_BAR;
    if constexpr (Epi::AFTER_DRAIN) { E.fused(acc, cur, wr, wc, fr, fq, lds, wid, lane); S.done(cur); }
#undef PG8_SA
#undef PG8_SB
#undef PG8_STAGE
#undef PG8_LDA
#undef PG8_LDB
#undef PG8_MMA
#undef PG8_WAIT_V
#undef PG8_WAIT_L
#undef PG8_BAR
#undef PG8_SCHED
}
}

#define DI __device__ __forceinline__
#define LAS __attribute__((address_space(3)))
using pg8::bf16_t; using pg8::bf16x8; using pg8::f32x4; using pg8::u32x4;
typedef unsigned u32x2 __attribute__((ext_vector_type(2)));
typedef short s16x4 __attribute__((ext_vector_type(4)));
typedef float f32x2 __attribute__((ext_vector_type(2)));

constexpr int T = 16384, L = 8192, D = 2048;
constexpr float EPS = 1e-6f;
constexpr size_t MiB = 1u << 20;
constexpr size_t OFF_MOD = 65536, OFF_BA = 1 * MiB, OFF_GC = 3 * MiB, OFF_EGL = 5 * MiB,
    OFF_WDN = 8 * MiB, OFF_WSW = 12 * MiB, OFF_WOUT = 16 * MiB, OFF_WIN = 24 * MiB, OFF_H = 64 * MiB, OFF_Z = 128 * MiB, OFF_QSW = 160 * MiB, OFF_KVSW = 192 * MiB,
    OFF_QKV = 208 * MiB, OFF_QC = 304 * MiB, OFF_KC = 336 * MiB, OFF_VC = 368 * MiB, OFF_YSW = 400 * MiB,
    OFF_W = 208 * MiB, OFF_A = 272 * MiB, OFF_U = 432 * MiB, OFF_OF = 368 * MiB, OFF_OB = 160 * MiB, OFF_YDN = 208 * MiB, OFF_TG = 240 * MiB, OFF_MRG = 304 * MiB,
    OFF_WMI = 128 * MiB, OFF_WMO = 160 * MiB, OFF_UU = 208 * MiB, WS_END = 496 * MiB;
constexpr int LDS_BYTES = 160 * 1024;

struct Params {
    const float *x, *c, *w_ada, *b_ada, *norm1_w, *w_in, *conv_w, *a_log, *dt_bias, *dn_norm_w, *w_dn, *qn_w, *kn_w, *sink, *w_sw, *w_out, *norm2_w, *w_mi, *w_mo;
    float* out; unsigned char* ws;
};

DI float bflo(unsigned u) { return __uint_as_float(u << 16); }
DI float bfhi(unsigned u) { return __uint_as_float(u & 0xffff0000u); }
DI float bf2f(unsigned short u) { return __uint_as_float(((unsigned)u) << 16); }
DI unsigned short f2bf(float f) { unsigned u = __float_as_uint(f); return (unsigned short)((u + 0x7fffu + ((u >> 16) & 1u)) >> 16); }
DI unsigned pk2(float lo, float hi) { return pg8::cvt_pk_bf16(lo, hi); }
DI float wave_sum(float v) {
#pragma unroll
    for (int o = 1; o < 64; o <<= 1) v += __shfl_xor(v, o);
    return v;
}
DI float sigmoidf_(float x) { return 1.f / (1.f + __expf(-x)); }
DI float siluf_(float x) { return x / (1.f + __expf(-x)); }
DI f32x4 mfma16(bf16x8 a, bf16x8 b, f32x4 c) { return __builtin_amdgcn_mfma_f32_16x16x32_bf16(a, b, c, 0, 0, 0); }
DI bf16x8 pack8(f32x4 a, f32x4 b) { u32x4 p; p.x = pk2(a[0], a[1]); p.y = pk2(a[2], a[3]); p.z = pk2(b[0], b[1]); p.w = pk2(b[2], b[3]); return __builtin_bit_cast(bf16x8, p); }
DI bf16x8 cat4(s16x4 lo, s16x4 hi) { return __builtin_shufflevector(lo, hi, 0, 1, 2, 3, 4, 5, 6, 7); }
#define LDS_WAIT() asm volatile("s_waitcnt lgkmcnt(0)" ::: "memory")
DI void fpma(float& acc, float a, float t) { asm("v_fma_f32 %0, %1, %2, %0" : "+v"(acc) : "v"(a), "v"(t)); }
DI void fnma(float& acc, float a, float t) { asm("v_fma_f32 %0, -%1, %2, %0" : "+v"(acc) : "v"(a), "v"(t)); }
DI s16x4 tr_read(const LAS bf16_t* p) { return __builtin_amdgcn_ds_read_tr16_b64_v4i16((LAS s16x4*)p); }

DI void transpose_item(const float* W, int K, int N, bf16_t* WT, int k0, int n0, int dst_row0, int ncols, LAS float* scr, int lane) {
    const int sub = lane >> 4, c4 = lane & 15;
    f32x4 v[16];
    if (4 * c4 < ncols) {
#pragma unroll
        for (int i = 0; i < 16; ++i) v[i] = *(const f32x4*)(W + (size_t)(k0 + 4 * i + sub) * N + n0 + 4 * c4);
#pragma unroll
        for (int i = 0; i < 16; ++i) { LAS float* d = scr + (4 * i + sub) * 65 + 4 * c4; d[0] = v[i][0]; d[1] = v[i][1]; d[2] = v[i][2]; d[3] = v[i][3]; }
    }
    LDS_WAIT();
    const int c = lane & 7;
#pragma unroll
    for (int j = 0; j < 8; ++j) { const int n = (lane >> 3) + 8 * j; const LAS float* s = scr + (8 * c) * 65 + n;
        if (n < ncols) { u32x4 o; o.x = pk2(s[0 * 65], s[1 * 65]); o.y = pk2(s[2 * 65], s[3 * 65]); o.z = pk2(s[4 * 65], s[5 * 65]); o.w = pk2(s[6 * 65], s[7 * 65]);
            *(u32x4*)(WT + (size_t)(dst_row0 + n) * K + k0 + 8 * c) = o; } }
    LDS_WAIT();
}
DI void win_tile(int t, int& n0, int& dst, int& ncols) {
    if (t < 64) { n0 = 64 * t; dst = 4096 + n0; ncols = 64; }
    else if (t < 88) { n0 = 4128 + 64 * (t - 64); dst = 8192 + 64 * (t - 64); ncols = 64; }
    else if (t < 152) { n0 = 5664 + 64 * (t - 88); dst = 64 * (t - 88); ncols = 64; }
    else { n0 = 4096; dst = 9728; ncols = 32; }
}

DI void phase0(const Params& p, LAS unsigned char* lds, int tid, int wave, int lane) {
    unsigned char* ws = p.ws;
    if (blockIdx.x < 192) {
        LAS float* sc = (LAS float*)lds; LAS float* red = sc + 4096;
        for (int i = tid; i < 4096; i += 512) sc[i] = siluf_(p.c[i]);
        __syncthreads();
        const int col = blockIdx.x * 64 + lane; float a0 = 0.f, a1 = 0.f;
        const float* wp = p.w_ada + (size_t)(wave * 256) * 12288 + col;
#pragma unroll 32
        for (int k = 0; k < 256; ++k) { const float w = wp[(size_t)k * 12288]; a0 += sc[wave * 256 + k] * w; a1 += sc[2048 + wave * 256 + k] * w; }
        red[(wave * 2 + 0) * 64 + lane] = a0; red[(wave * 2 + 1) * 64 + lane] = a1;
        __syncthreads();
        if (wave < 2) { float s = 0.f;
#pragma unroll
            for (int w = 0; w < 8; ++w) s += red[(w * 2 + wave) * 64 + lane];
            ((float*)(ws + OFF_MOD))[wave * 12288 + col] = s + p.b_ada[col]; }
        __syncthreads();
    }
    LAS float* scr = (LAS float*)(lds + wave * 16640);
    const int gw = blockIdx.x * 8 + wave, NGW = gridDim.x * 8;
    constexpr int I_IN = 32 * 153, I_DN = 16 * 32, I_OUT = 32 * 32;
    for (int it = gw; it < I_IN + 2 * I_DN + I_OUT; it += NGW) {
        int r = it;
        if (r < I_IN) { int n0, dst, nc; win_tile(r % 153, n0, dst, nc); transpose_item(p.w_in, 2048, 9760, (bf16_t*)(ws + OFF_WIN), 64 * (r / 153), n0, dst, nc, scr, lane); continue; } r -= I_IN;
        if (r < I_DN) { transpose_item(p.w_dn, 1024, 2048, (bf16_t*)(ws + OFF_WDN), 64 * (r / 32), 64 * (r % 32), 64 * (r % 32), 64, scr, lane); continue; } r -= I_DN;
        if (r < I_DN) { transpose_item(p.w_sw, 1024, 2048, (bf16_t*)(ws + OFF_WSW), 64 * (r / 32), 64 * (r % 32), 64 * (r % 32), 64, scr, lane); continue; } r -= I_DN;
        transpose_item(p.w_out, 2048, 2048, (bf16_t*)(ws + OFF_WOUT), 64 * (r / 32), 64 * (r % 32), 64 * (r % 32), 64, scr, lane);
    }
    { u32x4* z = (u32x4*)((bf16_t*)(ws + OFF_WIN) + (size_t)9760 * 2048); const u32x4 zero = {0u, 0u, 0u, 0u};
      for (int i = blockIdx.x * 512 + tid; i < 57344; i += gridDim.x * 512) z[i] = zero; }
}
DI void phase_mlp_weights(const Params& p, LAS unsigned char* lds, int wave, int lane) {
    LAS float* scr = (LAS float*)(lds + wave * 16640);
    const int gw = blockIdx.x * 8 + wave, NGW = gridDim.x * 8;
    constexpr int I_MI = 32 * 128, I_MO = 128 * 32;
    for (int it = gw; it < I_MI + I_MO; it += NGW) {
        int r = it;
        if (r < I_MI) { transpose_item(p.w_mi, 2048, 8192, (bf16_t*)(p.ws + OFF_WMI), 64 * (r / 128), 64 * (r % 128), 64 * (r % 128), 64, scr, lane); continue; } r -= I_MI;
        transpose_item(p.w_mo, 8192, 2048, (bf16_t*)(p.ws + OFF_WMO), 64 * (r / 32), 64 * (r % 32), 64 * (r % 32), 64, scr, lane);
    }
}

DI void phase_modnorm(const float* x, const float* normw, const float* mod, int shift_off, int scale_off, bf16_t* H, int wave, int lane) {
    const int gw = blockIdx.x * 8 + wave, NGW = gridDim.x * 8;
    for (int m0 = 2 * gw; m0 < T; m0 += 2 * NGW) {
        const int b = m0 >> 13;
        const f32x4* xr = (const f32x4*)(x + (size_t)m0 * D) + lane;
        f32x4 v[2][8]; float s[2] = {0.f, 0.f};
#pragma unroll
        for (int r = 0; r < 2; ++r)
#pragma unroll
            for (int j = 0; j < 8; ++j) v[r][j] = xr[r * (D / 4) + 64 * j];
#pragma unroll
        for (int r = 0; r < 2; ++r)
#pragma unroll
            for (int j = 0; j < 8; ++j) s[r] += (v[r][j][0] * v[r][j][0] + v[r][j][1] * v[r][j][1]) + (v[r][j][2] * v[r][j][2] + v[r][j][3] * v[r][j][3]);
        const float rstd0 = rsqrtf(wave_sum(s[0]) * (1.f / D) + EPS), rstd1 = rsqrtf(wave_sum(s[1]) * (1.f / D) + EPS);
        u32x2* o = (u32x2*)(H + (size_t)m0 * D) + lane;
#pragma unroll
        for (int j = 0; j < 8; ++j) { const int col = 256 * j + 4 * lane;
            const f32x4 nw = *(const f32x4*)(normw + col), sc = *(const f32x4*)(mod + b * 12288 + scale_off + col), sh = *(const f32x4*)(mod + b * 12288 + shift_off + col);
            f32x4 a;
#pragma unroll
            for (int i = 0; i < 4; ++i) a[i] = nw[i] * (1.f + sc[i]);
            u32x2 w0, w1;
            w0.x = pk2(v[0][j][0] * rstd0 * a[0] + sh[0], v[0][j][1] * rstd0 * a[1] + sh[1]); w0.y = pk2(v[0][j][2] * rstd0 * a[2] + sh[2], v[0][j][3] * rstd0 * a[3] + sh[3]);
            w1.x = pk2(v[1][j][0] * rstd1 * a[0] + sh[0], v[1][j][1] * rstd1 * a[1] + sh[1]); w1.y = pk2(v[1][j][2] * rstd1 * a[2] + sh[2], v[1][j][3] * rstd1 * a[3] + sh[3]);
            o[64 * j] = w0; o[D / 4 + 64 * j] = w1; }
    }
}

#define EPI_ARGS const f32x4 (&acc)[2][2][4][2], const pg8::Unit& u, int wr, int wc, int fr, int fq
#define EPI_BEGIN _Pragma("unroll") for (int ai = 0; ai < 2; ++ai) _Pragma("unroll") for (int m = 0; m < 4; ++m) { const int r = u.pm * 256 + ai * 128 + wr * 64 + m * 16 + fr; \
    _Pragma("unroll") for (int bj = 0; bj < 2; ++bj) { const int cl = bj * 128 + wc * 32 + 8 * fq; f32x4 v0 = acc[ai][bj][m][0], v1 = acc[ai][bj][m][1];
#define EPI_END } }
DI u32x4 pack_row8(f32x4 a, f32x4 b) { u32x4 o; o.x = pk2(a[0], a[1]); o.y = pk2(a[2], a[3]); o.z = pk2(b[0], b[1]); o.w = pk2(b[2], b[3]); return o; }

struct EpiIn {
    static constexpr bool PERM = true, AFTER_DRAIN = false;
    bf16_t *qkv, *z, *qsw, *kvsw; float* ba; const float* a_log; const float* dt_bias;
    DI void operator()(EPI_ARGS) const {
        const int pn = u.pn;
        if (pn < 22) {
            bf16_t* base; int ldc, c0; bool act = false;
            if (pn < 12) { base = qkv; ldc = 3072; c0 = pn * 256; }
            else if (pn < 16) { base = z; ldc = 1024; c0 = (pn - 12) * 256; act = true; }
            else if (pn < 20) { base = qsw; ldc = 1024; c0 = (pn - 16) * 256; }
            else { base = kvsw; ldc = 512; c0 = (pn - 20) * 256; }
            EPI_BEGIN
                if (act) {
#pragma unroll
                    for (int i = 0; i < 4; ++i) { v0[i] = siluf_(v0[i]); v1[i] = siluf_(v1[i]); } }
                *(u32x4*)(base + (size_t)r * ldc + c0 + cl) = pack_row8(v0, v1);
            EPI_END
        } else if (wc == 0) {
            const int j0 = (fq & 1) * 8;
            f32x4 al0 = {0, 0, 0, 0}, al1 = al0, db0 = al0, db1 = al0;
            if (fq >= 2) { al0 = *(const f32x4*)(a_log + j0); al1 = *(const f32x4*)(a_log + j0 + 4); db0 = *(const f32x4*)(dt_bias + j0); db1 = *(const f32x4*)(dt_bias + j0 + 4); }
#pragma unroll
            for (int ai = 0; ai < 2; ++ai)
#pragma unroll
                for (int m = 0; m < 4; ++m) { const int r = u.pm * 256 + ai * 128 + wr * 64 + m * 16 + fr;
                    f32x4 v0 = acc[ai][0][m][0], v1 = acc[ai][0][m][1];
                    if (fq < 2) {
#pragma unroll
                        for (int i = 0; i < 4; ++i) { v0[i] = sigmoidf_(v0[i]); v1[i] = sigmoidf_(v1[i]); }
                    } else {
#pragma unroll
                        for (int i = 0; i < 4; ++i) {
                            float a = v0[i] + db0[i]; float sp = fmaxf(a, 0.f) + log1pf(__expf(-fabsf(a))); v0[i] = -__expf(al0[i]) * sp;
                            a = v1[i] + db1[i]; sp = fmaxf(a, 0.f) + log1pf(__expf(-fabsf(a))); v1[i] = -__expf(al1[i]) * sp; }
                    }
                    *(f32x4*)(ba + (size_t)r * 32 + 8 * fq) = v0; *(f32x4*)(ba + (size_t)r * 32 + 8 * fq + 4) = v1; }
        }
    }
};
struct EpiSig {
    static constexpr bool PERM = true, AFTER_DRAIN = false;
    bf16_t* O; int ldc;
    DI void operator()(EPI_ARGS) const {
        EPI_BEGIN
#pragma unroll
            for (int i = 0; i < 4; ++i) { v0[i] = sigmoidf_(v0[i]); v1[i] = sigmoidf_(v1[i]); }
            *(u32x4*)(O + (size_t)r * ldc + u.pn * 256 + cl) = pack_row8(v0, v1);
        EPI_END
    }
};
template <bool ADD> struct EpiMerge {
    static constexpr bool PERM = true, AFTER_DRAIN = false;
    const bf16_t* TG; const bf16_t* ADDEND; bf16_t* OUT;
    DI void operator()(EPI_ARGS) const {
        EPI_BEGIN
            const size_t off = (size_t)r * 2048 + u.pn * 256 + cl;
            const u32x4 g = *(const u32x4*)(TG + off);
            v0[0] *= bflo(g.x); v0[1] *= bfhi(g.x); v0[2] *= bflo(g.y); v0[3] *= bfhi(g.y); v1[0] *= bflo(g.z); v1[1] *= bfhi(g.z); v1[2] *= bflo(g.w); v1[3] *= bfhi(g.w);
            if (ADD) { const u32x4 o = *(const u32x4*)(ADDEND + off);
                v0[0] += bflo(o.x); v0[1] += bfhi(o.x); v0[2] += bflo(o.y); v0[3] += bfhi(o.y); v1[0] += bflo(o.z); v1[1] += bfhi(o.z); v1[2] += bflo(o.w); v1[3] += bfhi(o.w); }
            *(u32x4*)(OUT + off) = pack_row8(v0, v1);
        EPI_END
    }
};
struct EpiRes {
    static constexpr bool PERM = true, AFTER_DRAIN = false;
    const float* res; const float* gate; float* out;
    DI void operator()(EPI_ARGS) const {
        const float* gp = gate + (u.pm >> 5) * 12288 + u.pn * 256;
        EPI_BEGIN
            const size_t off = (size_t)r * 2048 + u.pn * 256 + cl;
            const f32x4 g0 = *(const f32x4*)(gp + cl), g1 = *(const f32x4*)(gp + cl + 4);
            const f32x4 x0 = *(const f32x4*)(res + off), x1 = *(const f32x4*)(res + off + 4);
            *(f32x4*)(out + off) = x0 + g0 * v0; *(f32x4*)(out + off + 4) = x1 + g1 * v1;
        EPI_END
    }
};
struct EpiRelu2 {
    static constexpr bool PERM = true, AFTER_DRAIN = false;
    bf16_t* O; int ldc;
    DI void operator()(EPI_ARGS) const {
        EPI_BEGIN
#pragma unroll
            for (int i = 0; i < 4; ++i) { float a = fmaxf(v0[i], 0.f); v0[i] = a * a; a = fmaxf(v1[i], 0.f); v1[i] = a * a; }
            *(u32x4*)(O + (size_t)r * ldc + u.pn * 256 + cl) = pack_row8(v0, v1);
        EPI_END
    }
};

DI void phase_conv(const bf16_t* qkv, const float* conv_w, bf16_t* Qc, bf16_t* Kc, bf16_t* Vc, int wave, int lane) {
    const int gw = blockIdx.x * 8 + wave, NGW = gridDim.x * 8;
    for (int it = gw; it < 6 * 1024; it += NGW) {
        const int g = it % 6, run = it / 6, t0 = run * 16, tl0 = t0 & 8191, ch = g * 512 + 8 * lane;
        u32x4 rows[20];
#pragma unroll
        for (int i = 0; i < 20; ++i) { const int tl = tl0 - 2 + i; rows[i] = (tl >= 0 && tl < 8192) ? *(const u32x4*)(qkv + (size_t)(t0 - 2 + i) * 3072 + ch) : (u32x4){0u, 0u, 0u, 0u}; }
        f32x4 wl[5], wh[5];
#pragma unroll
        for (int j = 0; j < 5; ++j) { wl[j] = *(const f32x4*)(conv_w + j * 3072 + ch); wh[j] = *(const f32x4*)(conv_w + j * 3072 + ch + 4); }
        bf16_t* dst = (g < 2 ? Qc : (g < 4 ? Kc : Vc)) + (size_t)t0 * 1024 + (g & 1) * 512 + 8 * lane;
        const float post = g < 2 ? 0.08838834764831845f : 1.f;
#pragma unroll
        for (int i = 0; i < 16; ++i) {
            float a[8] = {0.f, 0.f, 0.f, 0.f, 0.f, 0.f, 0.f, 0.f};
#pragma unroll
            for (int j = 0; j < 5; ++j) { const u32x4 r = rows[i + j];
                a[0] += wl[j][0] * bflo(r.x); a[1] += wl[j][1] * bfhi(r.x); a[2] += wl[j][2] * bflo(r.y); a[3] += wl[j][3] * bfhi(r.y);
                a[4] += wh[j][0] * bflo(r.z); a[5] += wh[j][1] * bfhi(r.z); a[6] += wh[j][2] * bflo(r.w); a[7] += wh[j][3] * bfhi(r.w); }
            float ss = 0.f;
#pragma unroll
            for (int e = 0; e < 8; ++e) { a[e] = siluf_(a[e]); ss += a[e] * a[e]; }
            if (g < 4) { ss += __shfl_xor(ss, 1); ss += __shfl_xor(ss, 2); ss += __shfl_xor(ss, 4); ss += __shfl_xor(ss, 8);
                const float sc = rsqrtf(ss + EPS) * post;
#pragma unroll
                for (int e = 0; e < 8; ++e) a[e] *= sc; }
            u32x4 o; o.x = pk2(a[0], a[1]); o.y = pk2(a[2], a[3]); o.z = pk2(a[4], a[5]); o.w = pk2(a[6], a[7]);
            *(u32x4*)(dst + (size_t)i * 1024) = o;
        }
    }
}
DI void normrope16(bf16_t* ptr, const float* nw, const LAS f32x2* tab, float scale, int lane) {
    u32x4 a = *(const u32x4*)ptr, b = *(const u32x4*)(ptr + 8);
    float v[16];
    v[0] = bflo(a.x); v[1] = bfhi(a.x); v[2] = bflo(a.y); v[3] = bfhi(a.y); v[4] = bflo(a.z); v[5] = bfhi(a.z); v[6] = bflo(a.w); v[7] = bfhi(a.w);
    v[8] = bflo(b.x); v[9] = bfhi(b.x); v[10] = bflo(b.y); v[11] = bfhi(b.y); v[12] = bflo(b.z); v[13] = bfhi(b.z); v[14] = bflo(b.w); v[15] = bfhi(b.w);
    float ss = 0.f;
#pragma unroll
    for (int i = 0; i < 16; ++i) ss += v[i] * v[i];
    ss += __shfl_xor(ss, 1); ss += __shfl_xor(ss, 2); ss += __shfl_xor(ss, 4);
    const float rstd = rsqrtf(ss * (1.f / 128.f) + EPS);
    const int sub = lane & 7;
#pragma unroll
    for (int i = 0; i < 16; ++i) v[i] = v[i] * rstd * nw[sub * 16 + i];
#pragma unroll
    for (int i = 0; i < 16; ++i) { const float pr = __shfl_xor(v[i], 1); const f32x2 cs = tab[i];
        if (sub == 0) v[i] = v[i] * cs[0] - pr * cs[1]; else if (sub == 1) v[i] = v[i] * cs[0] + pr * cs[1]; }
    u32x4 o0, o1;
    o0.x = pk2(v[0] * scale, v[1] * scale); o0.y = pk2(v[2] * scale, v[3] * scale); o0.z = pk2(v[4] * scale, v[5] * scale); o0.w = pk2(v[6] * scale, v[7] * scale);
    o1.x = pk2(v[8] * scale, v[9] * scale); o1.y = pk2(v[10] * scale, v[11] * scale); o1.z = pk2(v[12] * scale, v[13] * scale); o1.w = pk2(v[14] * scale, v[15] * scale);
    *(u32x4*)ptr = o0; *(u32x4*)(ptr + 8) = o1;
}
DI void phase_swa_normrope(bf16_t* QSW, bf16_t* KVSW, const float* qn_w, const float* kn_w, LAS unsigned char* lds, int wave, int lane) {
    const int gw = blockIdx.x * 8 + wave, NGW = gridDim.x * 8;
    LAS f32x2* tab = (LAS f32x2*)(lds + wave * 128);
    for (int tk = gw; tk < T; tk += NGW) {
        const int pos = tk & 8191;
        if (lane < 16) {
            const float invf = exp2f(-(float)lane * (18.931568569324174f / 16.f));
            const float ang = (float)pos * invf;
            const double ad = (double)ang; const double kq = __builtin_rint(ad * 0.15915494309189535); const float rr = (float)(ad - kq * 6.283185307179586);
            f32x2 cs; cs[0] = __cosf(rr); cs[1] = __sinf(rr); tab[lane] = cs;
        }
        LDS_WAIT();
        normrope16(QSW + (size_t)tk * 1024 + lane * 16, qn_w, tab, 0.08838834764831845f, lane);
        if (lane < 16) normrope16(KVSW + (size_t)tk * 512 + lane * 16, kn_w, tab, 1.f, lane);
        LDS_WAIT();
    }
}

DI void swa_block(const bf16_t* QSW, const bf16_t* KVSW, const float* sink, bf16_t* Ysw, LAS unsigned char* lds, int tid, int wave, int lane) {
    const int fr = lane & 15, fq = lane >> 4, r = tid >> 2, sg = tid & 3, qi = 16 * wave + fr;
    LAS bf16_t* Kl = (LAS bf16_t*)lds; LAS bf16_t* VTl = Kl + 128 * 136;
    int it = blockIdx.x; if (it >= 1024) return;
    int kb = (((it >> 3) & 63) == 0) ? 1 : 0;
    u32x4 kk[4], vv[4]; bf16x8 qf[4], qn[4];
#define ATT_LOADKV(item_, kb_) do { const int hkv_ = ((item_) & 7) >> 2, nb_ = ((item_) >> 3) & 63, b_ = (item_) >> 9; const size_t tok_ = (size_t)b_ * L + 128 * (nb_ - 1 + (kb_)) + r; \
        const u32x4* ks_ = (const u32x4*)(KVSW + tok_ * 512 + hkv_ * 128 + sg * 32); const u32x4* vs_ = (const u32x4*)(KVSW + tok_ * 512 + 256 + hkv_ * 128 + sg * 32); \
        _Pragma("unroll") for (int i = 0; i < 4; ++i) { kk[i] = ks_[i]; vv[i] = vs_[i]; } } while (0)
#define ATT_LOADQ(dst, item_) do { const int hq_ = (item_) & 7, nb_ = ((item_) >> 3) & 63, b_ = (item_) >> 9; const size_t tq_ = (size_t)b_ * L + 128 * nb_ + qi; \
        _Pragma("unroll") for (int ks = 0; ks < 4; ++ks) dst[ks] = *(const bf16x8*)(QSW + tq_ * 1024 + hq_ * 128 + 32 * ks + 8 * fq); } while (0)
    ATT_LOADKV(it, kb); ATT_LOADQ(qf, it);
#pragma unroll
    for (int ks = 0; ks < 4; ++ks) qn[ks] = qf[ks];
    float mrun = 0.f, lrun = 0.f; f32x4 ot[8];
    bool first = true;
    for (;;) {
        const int hq = it & 7, nb = (it >> 3) & 63, b = it >> 9;
        __syncthreads();
#pragma unroll
        for (int i = 0; i < 4; ++i) { *(LAS u32x4*)(Kl + r * 136 + sg * 32 + 8 * i) = kk[i]; *(LAS u32x4*)(VTl + r * 136 + sg * 32 + 8 * i) = vv[i]; }
        __syncthreads();
        const bool last_kb = (kb == 2) || (nb + kb >= 64);
        int nit = it, nkb = kb + 1;
        if (last_kb) { nit = it + gridDim.x; nkb = (((nit >> 3) & 63) == 0) ? 1 : 0; }
        const bool more = nit < 1024;
        if (more) { ATT_LOADKV(nit, nkb); if (last_kb) ATT_LOADQ(qn, nit); }
        if (first) { mrun = sink[hq]; lrun = (fq == 0) ? 1.f : 0.f;
#pragma unroll
            for (int i = 0; i < 8; ++i) ot[i] = (f32x4){0.f, 0.f, 0.f, 0.f}; }
        f32x4 st[8];
#pragma unroll
        for (int mt = 0; mt < 8; ++mt) { st[mt] = (f32x4){0.f, 0.f, 0.f, 0.f};
#pragma unroll
            for (int ks = 0; ks < 4; ++ks) { const bf16x8 a = *(const LAS bf16x8*)(Kl + (16 * mt + fr) * 136 + 32 * ks + 8 * fq); st[mt] = mfma16(a, qf[ks], st[mt]); } }
        float mx = -INFINITY;
#pragma unroll
        for (int mt = 0; mt < 8; ++mt)
#pragma unroll
            for (int j = 0; j < 4; ++j) { const int kj = 16 * mt + 4 * fq + j; const bool valid = (kb == 0) ? (kj >= qi) : ((kb == 2) ? (kj <= qi) : true);
                const float sv = valid ? st[mt][j] : -INFINITY; st[mt][j] = sv; mx = fmaxf(mx, sv); }
        mx = fmaxf(mx, __shfl_xor(mx, 16)); mx = fmaxf(mx, __shfl_xor(mx, 32));
        const float mnew = fmaxf(mrun, mx), alpha = __expf(mrun - mnew);
        float ls = 0.f;
#pragma unroll
        for (int mt = 0; mt < 8; ++mt)
#pragma unroll
            for (int j = 0; j < 4; ++j) { const float pe = __expf(st[mt][j] - mnew); st[mt][j] = pe; ls += pe; }
        lrun = lrun * alpha + ls; mrun = mnew;
#pragma unroll
        for (int dt = 0; dt < 8; ++dt) ot[dt] *= alpha;
        bf16x8 pb[4];
#pragma unroll
        for (int ks = 0; ks < 4; ++ks) pb[ks] = pack8(st[2 * ks], st[2 * ks + 1]);
#pragma unroll
        for (int dt = 0; dt < 8; ++dt)
#pragma unroll
            for (int ks = 0; ks < 4; ++ks) { const LAS bf16_t* vp = VTl + (32 * ks + 4 * fq + (fr >> 2)) * 136 + 16 * dt + 4 * (fr & 3);
                const bf16x8 av = cat4(tr_read(vp), tr_read(vp + 16 * 136)); ot[dt] = mfma16(av, pb[ks], ot[dt]); }
        first = false;
        if (last_kb) {
            float lt = lrun; lt += __shfl_xor(lt, 16); lt += __shfl_xor(lt, 32);
            const float inv = 1.f / lt; const size_t tokq = (size_t)b * L + 128 * nb + qi;
#pragma unroll
            for (int dt = 0; dt < 8; ++dt) { u32x2 o; o.x = pk2(ot[dt][0] * inv, ot[dt][1] * inv); o.y = pk2(ot[dt][2] * inv, ot[dt][3] * inv);
                *(u32x2*)(Ysw + tokq * 1024 + hq * 128 + 16 * dt + 4 * fq) = o; }
#pragma unroll
            for (int ks = 0; ks < 4; ++ks) qf[ks] = qn[ks];
            first = true;
        }
        if (!more) break;
        it = nit; kb = nkb;
    }
#undef ATT_LOADKV
#undef ATT_LOADQ
}

constexpr int PREP_SET = 70400;
struct PrepStage { u32x4 kk[4], qq[4], vv[4]; float beta, g; };
DI void prep_load(PrepStage& R, const unsigned char* ws_c, int pair, int tid, int wave, int lane) {
    const bf16_t* Qc = (const bf16_t*)(ws_c + OFF_QC); const bf16_t* Kc = (const bf16_t*)(ws_c + OFF_KC); const bf16_t* Vc = (const bf16_t*)(ws_c + OFF_VC);
    const float* BA = (const float*)(ws_c + OFF_BA);
    const int grp = wave >> 2, wl = wave & 3, lt = tid & 255, item = 2 * pair + grp;
    const int n = item & 127, dirbh = item >> 7, dir = dirbh >> 4, b = (dirbh >> 3) & 1, h = dirbh & 7;
    const int c = lt >> 2, part = lt & 3;
    const size_t tok = (size_t)b * L + (dir ? (L - 1 - 64 * n - c) : (64 * n + c));
    const size_t go = tok * 1024 + h * 128 + part * 32;
#pragma unroll
    for (int i = 0; i < 4; ++i) { R.kk[i] = *(const u32x4*)(Kc + go + 8 * i); R.qq[i] = *(const u32x4*)(Qc + go + 8 * i); R.vv[i] = *(const u32x4*)(Vc + go + 8 * i); }
    if (wl == 0) { const size_t tk = (size_t)b * L + (dir ? (L - 1 - 64 * n - lane) : (64 * n + lane));
        R.beta = BA[tk * 32 + dir * 8 + h]; R.g = BA[tk * 32 + 16 + dir * 8 + h]; }
}
DI void dn_prep_pair(const unsigned char* ws_c, unsigned char* ws, LAS unsigned char* lds, int pair, int npair, PrepStage& R, int tid, int wave, int lane) {
    const bf16_t* Qc = (const bf16_t*)(ws_c + OFF_QC); const bf16_t* Kc = (const bf16_t*)(ws_c + OFF_KC); const bf16_t* Vc = (const bf16_t*)(ws_c + OFF_VC);
    const float* BA = (const float*)(ws_c + OFF_BA);
    bf16_t* Wg = (bf16_t*)(ws + OFF_W); bf16_t* Ug = (bf16_t*)(ws + OFF_U); bf16_t* Ag = (bf16_t*)(ws + OFF_A);
    f32x2* GC = (f32x2*)(ws + OFF_GC); float* EGL = (float*)(ws + OFF_EGL);
    { int l0 = threadIdx.x; asm volatile("" : "+v"(l0)); tid = l0; lane = l0 & 63; }
    const int grp = wave >> 2, wl = wave & 3, lt = tid & 255, item = 2 * pair + grp;
    const int n = item & 127, dirbh = item >> 7, dir = dirbh >> 4, b = (dirbh >> 3) & 1, h = dirbh & 7, fr = lane & 15, fq = lane >> 4;
    LAS unsigned char* base = lds + grp * PREP_SET;
    LAS bf16_t* Ks = (LAS bf16_t*)base; LAS bf16_t* Vs = Ks + 64 * 136; LAS float* Akk = (LAS float*)(base + 34816);
    LAS bf16_t* Qs = (LAS bf16_t*)(base + 51200);
    LAS bf16_t* Tb1 = (LAS bf16_t*)(base + 51200); LAS bf16_t* Tb2 = Tb1 + 64 * 72;
    LAS float* sg = (LAS float*)(base + 69632); LAS float* sb = sg + 64; LAS float* seg = sg + 128;
    __syncthreads();
    { const int c = lt >> 2, part = lt & 3;
      if (wl == 0) {
          const float beta = R.beta; float g = R.g;
#pragma unroll
          for (int off = 1; off < 64; off <<= 1) { const float t = __shfl_up(g, off); if (lane >= off) g += t; }
          const float eg = __expf(g), gl = __shfl(g, 63), dg = __expf(gl - g);
          sg[lane] = g; sb[lane] = beta; seg[lane] = eg;
          f32x2 w; w[0] = eg; w[1] = dg; GC[(size_t)dirbh * 8192 + 64 * n + lane] = w;
          if (lane == 63) EGL[dirbh * 128 + n] = eg;
      }
#pragma unroll
      for (int i = 0; i < 4; ++i) { *(LAS u32x4*)(Ks + c * 136 + part * 32 + 8 * i) = R.kk[i]; *(LAS u32x4*)(Qs + c * 136 + part * 32 + 8 * i) = R.qq[i]; *(LAS u32x4*)(Vs + c * 136 + part * 32 + 8 * i) = R.vv[i]; }
    }
    if (npair >= 0) prep_load(R, ws_c, npair, tid, wave, lane);
    __syncthreads();
    for (int jb = wl; jb < 32; jb += 4) {
        const int which = jb >> 4, mt = (jb >> 2) & 3, nt = jb & 3;
        if (nt > mt && which == 0) continue;
        f32x4 acc = {0.f, 0.f, 0.f, 0.f};
        if (nt <= mt) {
            const LAS bf16_t* Cp = (which ? Qs : Ks) + (16 * mt + fr) * 136 + 8 * fq; const LAS bf16_t* Sp = Ks + (16 * nt + fr) * 136 + 8 * fq;
#pragma unroll
            for (int ks = 0; ks < 4; ++ks) acc = mfma16(*(const LAS bf16x8*)(Sp + 32 * ks), *(const LAS bf16x8*)(Cp + 32 * ks), acc);
        }
        const int cc = 16 * mt + fr; const float gc = sg[cc], bc = sb[cc];
        f32x4 o;
#pragma unroll
        for (int j = 0; j < 4; ++j) { const int s = 16 * nt + 4 * fq + j; const float dec = (s <= cc) ? __expf(gc - sg[s]) : 0.f;
            o[j] = (which == 0) ? ((s < cc) ? bc * acc[j] * dec : 0.f) : acc[j] * dec; }
        if (which == 0) { LAS float* ap = Akk + (16 * nt + 4 * fq) * 64 + cc;
            ap[0] = o[0]; ap[64] = o[1]; ap[128] = o[2]; ap[192] = o[3]; }
        else { u32x2 w; w.x = pk2(o[0], o[1]); w.y = pk2(o[2], o[3]); *(u32x2*)(Ag + (size_t)item * 4096 + cc * 64 + 16 * nt + 4 * fq) = w; }
    }
    __syncthreads();
    {
        int zoff = 0; asm volatile("" : "+v"(zoff));
        const LAS float* Akz = Akk + zoff;
        LAS float* Tl = (LAS float*)(base + 51200);
        LAS float* Xs = (LAS float*)(lds + 2 * PREP_SET + grp * 4096);
        LAS float* Dl = (LAS float*)(lds + 2 * PREP_SET + 8192 + grp * 4096);
        {   float Y[16];
#pragma unroll
            for (int r = 0; r < 16; ++r) Y[r] = (lane == r) ? 1.f : 0.f;
#pragma unroll
            for (int jj = 0; jj < 16; ++jj) {
                const float t = Y[jj]; if (lane < 16) Dl[(wl * 16 + jj) * 16 + lane] = t;
                if (jj < 15) { const LAS float* ar = Akz + (16 * wl + jj) * 64 + 16 * wl;
#pragma unroll
                    for (int r4 = (jj + 1) / 4; r4 < 4; ++r4) { const f32x4 av = *(const LAS f32x4*)(ar + 4 * r4);
#pragma unroll
                        for (int e = 0; e < 4; ++e) { if (4 * r4 + e > jj) fnma(Y[4 * r4 + e], av[e], t); } } }
            }
        }
        __syncthreads();
        const LAS float* Dz = Dl + zoff;
        for (int P = 0; P < 4; ++P) {
            float X[4];
#pragma unroll
            for (int e = 0; e < 4; ++e) X[e] = (lane == 16 * P + 4 * wl + e) ? 1.f : 0.f;
            const int nj = 16 * P;
            if (nj > 0) {
                float tj = Tl[lane]; f32x4 a0 = *(const LAS f32x4*)(Akz + 16 * P + 4 * wl);
                for (int j = 0; j < nj; ++j) {
                    const int jn = (j + 1 < nj) ? j + 1 : j;
                    const float tn = Tl[jn * 64 + lane]; const f32x4 n0 = *(const LAS f32x4*)(Akz + jn * 64 + 16 * P + 4 * wl);
#pragma unroll
                    for (int e = 0; e < 4; ++e) fnma(X[e], a0[e], tj);
                    tj = tn; a0 = n0;
                }
            }
#pragma unroll
            for (int e = 0; e < 4; ++e) Xs[(4 * wl + e) * 64 + lane] = X[e];
            __syncthreads();
            {   float Tn[4] = {0.f, 0.f, 0.f, 0.f}; float xk[16]; f32x4 dv[4][4];
#pragma unroll
                for (int k = 0; k < 16; ++k) xk[k] = Xs[k * 64 + lane];
#pragma unroll
                for (int e = 0; e < 4; ++e)
#pragma unroll
                    for (int k4 = 0; k4 < 4; ++k4) dv[e][k4] = *(const LAS f32x4*)(Dz + (P * 16 + 4 * wl + e) * 16 + 4 * k4);
#pragma unroll
                for (int k = 0; k < 16; ++k)
#pragma unroll
                    for (int e = 0; e < 4; ++e) fpma(Tn[e], dv[e][k >> 2][k & 3], xk[k]);
#pragma unroll
                for (int e = 0; e < 4; ++e) Tl[(16 * P + 4 * wl + e) * 64 + lane] = Tn[e];
            }
            __syncthreads();
        }
        const float c1 = sb[lane], c2 = -c1 * seg[lane];
        float Tc[16];
#pragma unroll
        for (int i = 0; i < 16; ++i) Tc[i] = Tl[(16 * wl + i) * 64 + lane];
        __syncthreads();
#pragma unroll
        for (int i = 0; i < 16; ++i) { const unsigned w = pk2(Tc[i] * c1, Tc[i] * c2); Tb1[(16 * wl + i) * 72 + lane] = (bf16_t)(w & 0xffffu); Tb2[(16 * wl + i) * 72 + lane] = (bf16_t)(w >> 16); }
    }
    __syncthreads();
    { int l2 = threadIdx.x; asm volatile("" : "+v"(l2)); lane = l2 & 63; }
    const int fr2 = lane & 15, fq2 = lane >> 4;
#define fr fr2
#define fq fq2
    for (int jb = wl; jb < 64; jb += 4) {
        const int which = jb >> 5, mt = (jb >> 3) & 3, nt = jb & 7;
        const LAS bf16_t* Tp = (which ? Tb2 : Tb1) + (16 * mt + fr) * 72 + 8 * fq;
        const LAS bf16_t* Xp = (which ? Ks : Vs) + (8 * fq + (fr >> 2)) * 136 + 16 * nt + 4 * (fr & 3);
        f32x4 acc = {0.f, 0.f, 0.f, 0.f};
        acc = mfma16(cat4(tr_read(Xp), tr_read(Xp + 4 * 136)), *(const LAS bf16x8*)Tp, acc);
        if (mt >= 2) acc = mfma16(cat4(tr_read(Xp + 32 * 136), tr_read(Xp + 36 * 136)), *(const LAS bf16x8*)(Tp + 32), acc);
        u32x2 w; w.x = pk2(acc[0], acc[1]); w.y = pk2(acc[2], acc[3]);
        *(u32x2*)((which ? Wg : Ug) + ((size_t)item * 64 + 16 * mt + fr) * 128 + 16 * nt + 4 * fq) = w;
    }
#undef fr
#undef fq
}

constexpr int SC4_BUF = 71168;
DI void scan_item(const unsigned char* ws_c, unsigned char* ws, LAS unsigned char* lds, int dirbh, int half, int tid, int wave, int lane) {
    const bf16_t* Qc = (const bf16_t*)(ws_c + OFF_QC); const bf16_t* Kc = (const bf16_t*)(ws_c + OFF_KC);
    const bf16_t* Wg = (const bf16_t*)(ws_c + OFF_W); const bf16_t* Ug = (const bf16_t*)(ws_c + OFF_U); const bf16_t* Ag = (const bf16_t*)(ws_c + OFF_A);
    const f32x2* GC = (const f32x2*)(ws_c + OFF_GC);
    const int dir = dirbh >> 4, b = (dirbh >> 3) & 1, h = dirbh & 7, e0 = 64 * half + 16 * (wave & 3), el = 16 * (wave & 3), fr = lane & 15, fq = lane >> 4;
    bf16_t* Og = (bf16_t*)(ws + (dir ? OFF_OB : OFF_OF));
    struct Stg { u32x4 w0, w1, q0, q1, k0, k1, a, u; f32x2 g; };
#define SC_LOAD(R, vt, nn) do { const int row = (vt) >> 3, s8 = (vt) & 7, row2 = (vt) >> 1, hf = (vt) & 1; const size_t ci = (size_t)dirbh * 128 + (nn); \
        const bf16_t* wsrc = Wg + (ci * 64 + row) * 128 + s8 * 16; R.w0 = *(const u32x4*)wsrc; R.w1 = *(const u32x4*)(wsrc + 8); \
        const size_t tok = (size_t)b * L + (dir ? (L - 1 - 64 * (nn) - row) : (64 * (nn) + row)); const size_t go = tok * 1024 + h * 128 + s8 * 16; \
        R.q0 = *(const u32x4*)(Qc + go); R.q1 = *(const u32x4*)(Qc + go + 8); R.k0 = *(const u32x4*)(Kc + go); R.k1 = *(const u32x4*)(Kc + go + 8); \
        R.a = *(const u32x4*)(Ag + (ci * 64 + row) * 64 + s8 * 8); \
        R.u = *(const u32x4*)(Ug + (ci * 64 + row) * 128 + 64 * half + s8 * 8); \
        if ((vt) < 64) R.g = GC[(size_t)dirbh * 8192 + 64 * (nn) + (vt)]; } while (0)
#define SC_STORE(R, vt, bufp) do { const int row = (vt) >> 3, s8 = (vt) & 7, row2 = (vt) >> 1, hf = (vt) & 1; \
        LAS bf16_t* Wl_ = (LAS bf16_t*)(bufp); LAS bf16_t* Ql_ = Wl_ + 64 * 136; LAS bf16_t* Kl_ = Ql_ + 64 * 136; LAS bf16_t* Al_ = Kl_ + 64 * 136; LAS bf16_t* Ul_ = Al_ + 64 * 72; LAS float* EG_ = (LAS float*)(Ul_ + 64 * 72); \
        *(LAS u32x4*)(Wl_ + row * 136 + s8 * 16) = R.w0; *(LAS u32x4*)(Wl_ + row * 136 + s8 * 16 + 8) = R.w1; \
        *(LAS u32x4*)(Ql_ + row * 136 + s8 * 16) = R.q0; *(LAS u32x4*)(Ql_ + row * 136 + s8 * 16 + 8) = R.q1; \
        *(LAS u32x4*)(Kl_ + row * 136 + s8 * 16) = R.k0; *(LAS u32x4*)(Kl_ + row * 136 + s8 * 16 + 8) = R.k1; \
        *(LAS u32x4*)(Al_ + row * 72 + s8 * 8) = R.a; \
        *(LAS u32x4*)(Ul_ + row * 72 + s8 * 8) = R.u; \
        if ((vt) < 64) { EG_[(vt)] = R.g[0]; EG_[64 + (vt)] = R.g[1]; } } while (0)
    __syncthreads();
    { Stg R; R.u = (u32x4){0u, 0u, 0u, 0u}; R.g = (f32x2){0.f, 0.f}; SC_LOAD(R, tid, 0); SC_STORE(R, tid, lds); }
    __syncthreads();
    if (wave >= 4) {
        const int v0 = tid - 256, v1 = tid; const bool two = true;
        Stg R0, R1; R0.u = (u32x4){0u, 0u, 0u, 0u}; R0.g = (f32x2){0.f, 0.f}; R1 = R0;
        SC_LOAD(R0, v0, 1); if (two) SC_LOAD(R1, v1, 1);
        for (int n = 0; n < 128; ++n) {
            LAS unsigned char* nxt = lds + ((n + 1) & 1) * SC4_BUF;
            if (n + 1 < 128) { SC_STORE(R0, v0, nxt); if (two) SC_STORE(R1, v1, nxt); }
            if (n + 2 < 128) { SC_LOAD(R0, v0, n + 2); if (two) SC_LOAD(R1, v1, n + 2); }
            __syncthreads();
        }
    } else {
    f32x4 S[8];
#pragma unroll
    for (int i = 0; i < 8; ++i) S[i] = (f32x4){0.f, 0.f, 0.f, 0.f};
    for (int n = 0; n < 128; ++n) {
        LAS unsigned char* cur = lds + (n & 1) * SC4_BUF;
        {
            const LAS bf16_t* Wl = (const LAS bf16_t*)cur; const LAS bf16_t* Ql = Wl + 64 * 136; const LAS bf16_t* Kl = Ql + 64 * 136; const LAS bf16_t* Al = Kl + 64 * 136; const LAS bf16_t* Ul = Al + 64 * 72;
            const LAS float* EG = (const LAS float*)(Ul + 64 * 72); const LAS float* DG = EG + 64;
            bf16x8 Sb[4];
#pragma unroll
            for (int ks = 0; ks < 4; ++ks) Sb[ks] = pack8(S[2 * ks], S[2 * ks + 1]);
            f32x4 vn[4], oq[4], oa[4];
#pragma unroll
            for (int mt = 0; mt < 4; ++mt) {
#pragma unroll
                for (int j = 0; j < 4; ++j) vn[mt][j] = bf2f(Ul[(16 * mt + 4 * fq + j) * 72 + el + fr]);
                oq[mt] = (f32x4){0.f, 0.f, 0.f, 0.f}; oa[mt] = (f32x4){0.f, 0.f, 0.f, 0.f};
#pragma unroll
                for (int ks = 0; ks < 4; ++ks) { const LAS bf16_t* wp = Wl + (16 * mt + fr) * 136 + 32 * ks + 4 * fq; const LAS bf16_t* qp = Ql + (16 * mt + fr) * 136 + 32 * ks + 4 * fq;
                    vn[mt] = mfma16(cat4(*(const LAS s16x4*)wp, *(const LAS s16x4*)(wp + 16)), Sb[ks], vn[mt]);
                    oq[mt] = mfma16(Sb[ks], cat4(*(const LAS s16x4*)qp, *(const LAS s16x4*)(qp + 16)), oq[mt]); }
            }
            bf16x8 vb[2], vpb[2];
#pragma unroll
            for (int k2 = 0; k2 < 2; ++k2) { vb[k2] = pack8(vn[2 * k2], vn[2 * k2 + 1]);
                f32x4 a = vn[2 * k2], bb = vn[2 * k2 + 1];
#pragma unroll
                for (int j = 0; j < 4; ++j) { a[j] *= DG[32 * k2 + 4 * fq + j]; bb[j] *= DG[32 * k2 + 16 + 4 * fq + j]; }
                vpb[k2] = pack8(a, bb); }
#pragma unroll
            for (int mt = 0; mt < 4; ++mt)
#pragma unroll
                for (int k2 = 0; k2 < 2; ++k2) { if (k2 == 0 || mt >= 2) { const LAS bf16_t* ap = Al + (16 * mt + fr) * 72 + 32 * k2 + 4 * fq;
                    oa[mt] = mfma16(vb[k2], cat4(*(const LAS s16x4*)ap, *(const LAS s16x4*)(ap + 16)), oa[mt]); } }
#pragma unroll
            for (int mt = 0; mt < 4; ++mt) { const int cc = 16 * mt + fr; const size_t tok = (size_t)b * L + (dir ? (L - 1 - 64 * n - cc) : (64 * n + cc));
                const float eg = EG[cc]; u32x2 w; w.x = pk2(eg * oq[mt][0] + oa[mt][0], eg * oq[mt][1] + oa[mt][1]); w.y = pk2(eg * oq[mt][2] + oa[mt][2], eg * oq[mt][3] + oa[mt][3]);
                *(u32x2*)(Og + tok * 1024 + h * 128 + e0 + 4 * fq) = w; }
            const float egl = EG[63];
#pragma unroll
            for (int dt = 0; dt < 8; ++dt) { S[dt] *= egl;
#pragma unroll
                for (int k2 = 0; k2 < 2; ++k2) { const LAS bf16_t* kp = Kl + (32 * k2 + 4 * fq + (fr >> 2)) * 136 + 16 * dt + 4 * (fr & 3);
                    S[dt] = mfma16(cat4(tr_read(kp), tr_read(kp + 16 * 136)), vpb[k2], S[dt]); } }
        }
        __syncthreads();
    }
    }
#undef SC_LOAD
#undef SC_STORE
}

DI void phase_gated_norm(const bf16_t* OF, const bf16_t* OB, const bf16_t* Z, const float* nw, bf16_t* Y, int wave, int lane) {
    const int gw = blockIdx.x * 8 + wave, NGW = gridDim.x * 8;
    for (int tk = gw; tk < T; tk += NGW) {
        const size_t o = (size_t)tk * 1024 + lane * 16;
        const u32x4 f0 = *(const u32x4*)(OF + o), f1 = *(const u32x4*)(OF + o + 8), b0 = *(const u32x4*)(OB + o), b1 = *(const u32x4*)(OB + o + 8), z0 = *(const u32x4*)(Z + o), z1 = *(const u32x4*)(Z + o + 8);
        const unsigned fw[8] = {f0.x, f0.y, f0.z, f0.w, f1.x, f1.y, f1.z, f1.w}, bw[8] = {b0.x, b0.y, b0.z, b0.w, b1.x, b1.y, b1.z, b1.w}, zw[8] = {z0.x, z0.y, z0.z, z0.w, z1.x, z1.y, z1.z, z1.w};
        float v[16]; float ss = 0.f;
#pragma unroll
        for (int i = 0; i < 8; ++i) { v[2 * i] = bflo(fw[i]) + bflo(bw[i]); v[2 * i + 1] = bfhi(fw[i]) + bfhi(bw[i]); ss += v[2 * i] * v[2 * i] + v[2 * i + 1] * v[2 * i + 1]; }
        ss += __shfl_xor(ss, 1); ss += __shfl_xor(ss, 2); ss += __shfl_xor(ss, 4);
        const float rstd = rsqrtf(ss * (1.f / 128.f) + EPS);
        const float* wp = nw + (lane & 7) * 16;
        unsigned ow[8];
#pragma unroll
        for (int i = 0; i < 8; ++i) ow[i] = pk2(v[2 * i] * rstd * wp[2 * i] * bflo(zw[i]), v[2 * i + 1] * rstd * wp[2 * i + 1] * bfhi(zw[i]));
        u32x4 o0 = {ow[0], ow[1], ow[2], ow[3]}, o1 = {ow[4], ow[5], ow[6], ow[7]};
        *(u32x4*)(Y + o) = o0; *(u32x4*)(Y + o + 8) = o1;
    }
}

#define XB_TMO      128
#define XB_XCNT(j)  (256  + 64 * (j))
#define XB_XSUB(j)  (1280 + 64 * (j))
#define XB_XGEN(j)  (2304 + 64 * (j))
#define XB_TOP      3328
#define XB_TOPGEN   3392
#define XCD_BAR_WORDS 3456
#define XB_SPIN_CAP (1u << 18)

__device__ __forceinline__ unsigned xb_ld(unsigned* p)              { return __hip_atomic_load(p, __ATOMIC_RELAXED, __HIP_MEMORY_SCOPE_AGENT); }
__device__ __forceinline__ unsigned xb_add(unsigned* p, unsigned v) { return __hip_atomic_fetch_add(p, v, __ATOMIC_RELAXED, __HIP_MEMORY_SCOPE_AGENT); }
__device__ __forceinline__ unsigned xb_xcc_id() { return (unsigned)__builtin_amdgcn_s_getreg((3 << 11) | 20) & 0xFu; }
#define XB_SPIN(cond, bar) do { unsigned _sp = 0; while (cond) { __builtin_amdgcn_s_sleep(1); \
    if ((++_sp & 255u) == 0u) { if (xb_ld(&(bar)[XB_TMO])) break; if (_sp > XB_SPIN_CAP) { atomicAdd(&(bar)[XB_TMO], 1u); break; } } } } while (0)

struct XcdBarrier {
    unsigned* bar; unsigned x;
    volatile LAS unsigned* st;
};

__device__ __forceinline__ XcdBarrier xcd_barrier_post(unsigned* bar, volatile LAS unsigned* st) {
    XcdBarrier b; b.bar = bar; b.x = xb_xcc_id(); b.st = st;
    if (threadIdx.x == 0) (void)xb_add(&bar[XB_XCNT(b.x)], 1u);
    return b;
}
__device__ __forceinline__ void xcd_barrier_complete(unsigned* bar, unsigned x, unsigned& nloc, unsigned& nx) {
    const unsigned G = gridDim.x * gridDim.y * gridDim.z;
    unsigned sum, cnt, mine, sp = 0u;
    for (;;) {
        sum = 0u; cnt = 0u; mine = 0u;
#pragma unroll
        for (unsigned j = 0; j < 16; ++j) { const unsigned c = xb_ld(&bar[XB_XCNT(j)]); sum += c; cnt += (c > 0u) ? 1u : 0u; mine = (j == x) ? c : mine; }
        if (sum == G) break;
        __builtin_amdgcn_s_sleep(1);
        if ((++sp & 255u) == 0u) { if (xb_ld(&bar[XB_TMO])) break; if (sp > XB_SPIN_CAP) { atomicAdd(&bar[XB_TMO], 1u); break; } }
    }
    nloc = mine > 0u ? mine : 1u; nx = cnt > 0u ? cnt : 1u;
}

__device__ __forceinline__ void xcd_barrier(const XcdBarrier& b) {
    asm volatile("s_waitcnt vmcnt(0)" ::: "memory");
    __syncthreads();
    if (threadIdx.x == 0) {
        unsigned* bar = b.bar;
        __builtin_amdgcn_s_waitcnt(0);
        unsigned nloc = b.st[0], nx = b.st[1];
        if (nloc == 0u) { xcd_barrier_complete(bar, b.x, nloc, nx); b.st[0] = nloc; b.st[1] = nx; }
        const unsigned old = xb_add(&bar[XB_XSUB(b.x)], 1u);
        const unsigned gen = old / nloc;
        if (old + 1u == (gen + 1u) * nloc) {
            __builtin_amdgcn_fence(__ATOMIC_RELEASE, "agent");
            asm volatile("s_waitcnt vmcnt(0)" ::: "memory");
            const unsigned og = xb_add(&bar[XB_TOP], 1u);
            const unsigned tg = og / nx;
            if (og + 1u == (tg + 1u) * nx) xb_add(&bar[XB_TOPGEN], 1u);
            else XB_SPIN(xb_ld(&bar[XB_TOPGEN]) == tg, bar);
            __builtin_amdgcn_fence(__ATOMIC_ACQUIRE, "agent");
            xb_add(&bar[XB_XGEN(b.x)], 1u);
            asm volatile("s_waitcnt vmcnt(0)" ::: "memory");
        } else {
            XB_SPIN(xb_ld(&bar[XB_XGEN(b.x)]) == gen, bar);
            __builtin_amdgcn_fence(__ATOMIC_ACQUIRE, "agent");
            asm volatile("s_waitcnt vmcnt(0)" ::: "memory");
        }
    }
    __syncthreads();
}


struct SplitOrder {
    int nM, nN, G, c, lim;
    __device__ bool next(int i, pg8::Unit& u) const {
        const long Lx = (long)i * G + c; if (Lx >= lim) return false;
        const int wgid = (int)Lx; const int nig = pg8::WGM * nN, gid = wgid / nig, fm = gid * pg8::WGM, gsz = (nM - fm) < pg8::WGM ? (nM - fm) : pg8::WGM;
        u.pm = fm + ((wgid % nig) % gsz); u.pn = (wgid % nig) / gsz; return true;
    }
    __device__ __forceinline__ void a_ready(const pg8::Unit&) const {}
    __device__ __forceinline__ void done(const pg8::Unit&) const {}
};
struct EpiSig2 {
    static constexpr bool PERM = true, AFTER_DRAIN = false;
    bf16_t* O1; bf16_t* O2;
    DI void operator()(EPI_ARGS) const {
        bf16_t* O = (u.pn < 8 ? O1 : O2) + (u.pn & 7) * 256;
        EPI_BEGIN
#pragma unroll
            for (int i = 0; i < 4; ++i) { v0[i] = sigmoidf_(v0[i]); v1[i] = sigmoidf_(v1[i]); }
            *(u32x4*)(O + (size_t)r * 2048 + cl) = pack_row8(v0, v1);
        EPI_END
    }
};
constexpr bool GEMM_ALIGN = true, GEMM_SP2 = true;
template <class Epi> DI void run_gemm(LAS unsigned char* lds, const bf16_t* A, const bf16_t* Bt, int N, int K, const Epi& E) {
    pg8::Gemm g{A, Bt, T, N, K}; pg8::StaticOrder S; S.init(T, N, (int)gridDim.x, (int)blockIdx.x);
    pg8::gemm_phase<Epi, pg8::StaticOrder, GEMM_ALIGN, GEMM_SP2>(lds, g, S, E);
}

#define REP_P0 1
#define REP_P1 1
#define REP_P3 1
#define REP_P6 1
#define REP_P9 1
#define REP_ATT 1
#define REP_PREP 1
#define REP_SCAN 1
__global__ void __launch_bounds__(512, 2) hybrid_fwd(Params p) {
    extern __shared__ __attribute__((aligned(16))) unsigned char lds_raw[];
    LAS unsigned char* lds = (LAS unsigned char*)lds_raw;
    cg::grid_group grid = cg::this_grid();
    int tid, lane, wave;
#define FRESH_IDS() do { int t_ = threadIdx.x; asm volatile("" : "+v"(t_)); tid = t_; lane = t_ & 63; wave = __builtin_amdgcn_readfirstlane(t_ >> 6); } while (0)
    FRESH_IDS();
    unsigned char* ws = p.ws;
    const float* MOD = (const float*)(ws + OFF_MOD);

    volatile LAS unsigned* xst = (volatile LAS unsigned*)(lds + LDS_BYTES - 16);
    if (tid < 2) xst[tid] = 0u;
    if (blockIdx.x == 0) { for (int i = tid; i < 4096; i += 512) __hip_atomic_store((unsigned*)ws + i, 0u, __ATOMIC_RELAXED, __HIP_MEMORY_SCOPE_AGENT); }
    for (int rep = 0; rep < REP_P0; ++rep) phase0(p, lds, tid, wave, lane);
    grid.sync(); FRESH_IDS();
    XcdBarrier xbar = xcd_barrier_post((unsigned*)ws, xst);
#define GRID_BAR() do { xcd_barrier(xbar); FRESH_IDS(); } while (0)
    for (int rep = 0; rep < REP_P1; ++rep) phase_modnorm(p.x, p.norm1_w, MOD, 0, 2048, (bf16_t*)(ws + OFF_H), wave, lane);
    GRID_BAR();
    { EpiIn E{(bf16_t*)(ws + OFF_QKV), (bf16_t*)(ws + OFF_Z), (bf16_t*)(ws + OFF_QSW), (bf16_t*)(ws + OFF_KVSW), (float*)(ws + OFF_BA), p.a_log, p.dt_bias};
      run_gemm(lds, (const bf16_t*)(ws + OFF_H), (const bf16_t*)(ws + OFF_WIN) + (size_t)4096 * 2048, 5888, 2048, E); }
    GRID_BAR();
    for (int rep = 0; rep < REP_P3; ++rep) phase_conv((const bf16_t*)(ws + OFF_QKV), p.conv_w, (bf16_t*)(ws + OFF_QC), (bf16_t*)(ws + OFF_KC), (bf16_t*)(ws + OFF_VC), wave, lane);
    phase_swa_normrope((bf16_t*)(ws + OFF_QSW), (bf16_t*)(ws + OFF_KVSW), p.qn_w, p.kn_w, lds, wave, lane);
    GRID_BAR();
    for (int rep = 0; rep < REP_ATT; ++rep) swa_block((const bf16_t*)(ws + OFF_QSW), (const bf16_t*)(ws + OFF_KVSW), p.sink, (bf16_t*)(ws + OFF_YSW), lds, tid, wave, lane);
    { PrepStage R; R.beta = 0.f; R.g = 0.f;
      if (blockIdx.x < 2048) prep_load(R, ws, blockIdx.x, tid, wave, lane);
      for (int it = blockIdx.x; it < 2048; it += gridDim.x) { const int nit = it + (int)gridDim.x; dn_prep_pair(ws, ws, lds, it, nit < 2048 ? nit : -1, R, tid, wave, lane); } }
    GRID_BAR();
    bf16_t* TG1 = (bf16_t*)p.out; bf16_t* TG2 = TG1 + (size_t)T * 2048;
    if (gridDim.x == 256) {
        const int bid = blockIdx.x;
        pg8::Gemm g{(const bf16_t*)(ws + OFF_H), (const bf16_t*)(ws + OFF_WIN), T, 4096, 2048}; EpiSig2 Eg{TG1, TG2};
        if (((bid >> 3) & 3) == 0) {
            for (int rep = 0; rep < REP_SCAN; ++rep) scan_item(ws, ws, lds, (bid >> 6) * 8 + (bid & 7), (bid >> 5) & 1, tid, wave, lane);
        } else {
            const int cv = bid - 8 * ((bid >> 5) + 1);
            SplitOrder S{64, 16, 192, cv, 1024};
            pg8::gemm_phase<EpiSig2, SplitOrder, GEMM_ALIGN, GEMM_SP2>(lds, g, S, Eg);
            asm volatile("s_waitcnt vmcnt(0)" ::: "memory"); __syncthreads();
            if (threadIdx.x == 0) { unsigned* cnt = (unsigned*)ws + 3584;
                __builtin_amdgcn_fence(__ATOMIC_RELEASE, "agent"); asm volatile("s_waitcnt vmcnt(0)" ::: "memory");
                __hip_atomic_fetch_add(cnt, 1u, __ATOMIC_RELAXED, __HIP_MEMORY_SCOPE_AGENT);
                unsigned sp = 0; while (__hip_atomic_load(cnt, __ATOMIC_RELAXED, __HIP_MEMORY_SCOPE_AGENT) < 192u && ++sp < (1u << 24)) __builtin_amdgcn_s_sleep(2);
                __builtin_amdgcn_fence(__ATOMIC_ACQUIRE, "agent"); asm volatile("s_waitcnt vmcnt(0)" ::: "memory"); }
            __syncthreads(); FRESH_IDS();
            { pg8::Gemm gb{(const bf16_t*)(ws + OFF_YSW), (const bf16_t*)(ws + OFF_WSW), T, 2048, 1024}; const SplitOrder Sb = cv < 64 ? SplitOrder{64, 8, 64, 384 + cv, 512} : SplitOrder{64, 8, 128, cv - 64, 384};
              EpiMerge<false> Eb{TG2, nullptr, TG2}; pg8::gemm_phase<EpiMerge<false>, SplitOrder, GEMM_ALIGN, GEMM_SP2>(lds, gb, Sb, Eb); }
        }
    } else {
        for (int d = blockIdx.x; d < 64; d += gridDim.x) scan_item(ws, ws, lds, d >> 1, d & 1, tid, wave, lane);
        { EpiSig Eg{TG1, 2048}; run_gemm(lds, (const bf16_t*)(ws + OFF_H), (const bf16_t*)(ws + OFF_WIN), 2048, 2048, Eg); }
        { EpiSig Eg{TG2, 2048}; run_gemm(lds, (const bf16_t*)(ws + OFF_H), (const bf16_t*)(ws + OFF_WIN) + (size_t)2048 * 2048, 2048, 2048, Eg); }
        { EpiMerge<false> Eb{TG2, nullptr, TG2}; run_gemm(lds, (const bf16_t*)(ws + OFF_YSW), (const bf16_t*)(ws + OFF_WSW), 2048, 1024, Eb); }
    }
    GRID_BAR();
    for (int rep = 0; rep < REP_P6; ++rep) phase_gated_norm((const bf16_t*)(ws + OFF_OF), (const bf16_t*)(ws + OFF_OB), (const bf16_t*)(ws + OFF_Z), p.dn_norm_w, (bf16_t*)(ws + OFF_YDN), wave, lane);
    GRID_BAR();
    { EpiMerge<true> Ea{TG1, TG2, (bf16_t*)(ws + OFF_MRG)};
      run_gemm(lds, (const bf16_t*)(ws + OFF_YDN), (const bf16_t*)(ws + OFF_WDN), 2048, 1024, Ea); }
    GRID_BAR();
    { EpiRes E{p.x, MOD + 4096, p.out};
      run_gemm(lds, (const bf16_t*)(ws + OFF_MRG), (const bf16_t*)(ws + OFF_WOUT), 2048, 2048, E); }
    GRID_BAR();
    for (int rep = 0; rep < REP_P9; ++rep) { phase_modnorm(p.out, p.norm2_w, MOD, 6144, 8192, (bf16_t*)(ws + OFF_H), wave, lane);
    phase_mlp_weights(p, lds, wave, lane); }
    GRID_BAR();
    { EpiRelu2 E{(bf16_t*)(ws + OFF_UU), 8192};
      run_gemm(lds, (const bf16_t*)(ws + OFF_H), (const bf16_t*)(ws + OFF_WMI), 8192, 2048, E); }
    GRID_BAR();
    { EpiRes E{p.out, MOD + 10240, p.out};
      run_gemm(lds, (const bf16_t*)(ws + OFF_UU), (const bf16_t*)(ws + OFF_WMO), 2048, 8192, E); }
}

extern "C" void kernel_launch(void* const* d_in, const int* in_sizes, int n_in, void* d_out, int out_size, void* d_ws, size_t ws_size, hipStream_t stream) {
    static int grid_blocks = 0;
    if (grid_blocks == 0) {
        if (n_in != 19 || out_size != T * D || ws_size < WS_END) { fprintf(stderr, "kernel_launch: unexpected shapes (n_in %d out %d ws %zu)\n", n_in, out_size, ws_size); grid_blocks = -1; return; }
        int dev = 0, cus = 0, per_cu = 0;
        hipGetDevice(&dev); hipDeviceGetAttribute(&cus, hipDeviceAttributeMultiprocessorCount, dev);
        hipFuncSetAttribute((const void*)hybrid_fwd, hipFuncAttributeMaxDynamicSharedMemorySize, LDS_BYTES);
        hipOccupancyMaxActiveBlocksPerMultiprocessor(&per_cu, (const void*)hybrid_fwd, 512, LDS_BYTES);
        if (per_cu < 1) { fprintf(stderr, "kernel_launch: occupancy query says %d blocks/CU\n", per_cu); per_cu = 1; }
        (void)hipGetLastError();
        grid_blocks = cus * per_cu;
    }
    if (grid_blocks < 0) return;
    Params p{};
    p.x = (const float*)d_in[0]; p.c = (const float*)d_in[1]; p.w_ada = (const float*)d_in[2]; p.b_ada = (const float*)d_in[3]; p.norm1_w = (const float*)d_in[4];
    p.w_in = (const float*)d_in[5]; p.conv_w = (const float*)d_in[6]; p.a_log = (const float*)d_in[7]; p.dt_bias = (const float*)d_in[8]; p.dn_norm_w = (const float*)d_in[9];
    p.w_dn = (const float*)d_in[10]; p.qn_w = (const float*)d_in[11]; p.kn_w = (const float*)d_in[12]; p.sink = (const float*)d_in[13]; p.w_sw = (const float*)d_in[14];
    p.w_out = (const float*)d_in[15]; p.norm2_w = (const float*)d_in[16]; p.w_mi = (const float*)d_in[17]; p.w_mo = (const float*)d_in[18];
    p.out = (float*)d_out; p.ws = (unsigned char*)d_ws;
    void* args[] = {&p};
    hipError_t e = hipLaunchCooperativeKernel((const void*)hybrid_fwd, dim3(grid_blocks), dim3(512), args, LDS_BYTES, stream);
    if (e != hipSuccess) fprintf(stderr, "cooperative launch failed: %s (grid %d)\n", hipGetErrorString(e), grid_blocks);
}
```

```cpp
#include <hip/hip_runtime.h>
#include <hip/hip_cooperative_groups.h>
#include <cstdio>
#include <cstdint>
namespace cg = cooperative_groups;

namespace pg8 {
#define PG8_LAS __attribute__((address_space(3)))
typedef unsigned short bf16_t;
typedef short bf16x8 __attribute__((ext_vector_type(8)));
typedef float f32x4 __attribute__((ext_vector_type(4)));
typedef unsigned u32x4 __attribute__((ext_vector_type(4)));
constexpr int BM = 256, BK = 64, HALF = 128, HTB = HALF * BK * 2  , STAGE_BYTES = 8 * HTB, NXCD = 8, WGM = 8;

__host__ __device__ __forceinline__ int lds_byte(int r, int c) { const int st = (r >> 4) * 2 + (c >> 5), rr = r & 15, cc = c & 31, ob = rr * 64 + cc * 2; return st * 1024 + (ob ^ (((ob >> 9) & 1) << 5)); }
__host__ __device__ __forceinline__ void stage_rc(int b, int& R, int& C) { const int st = b / 1024, sb = b % 1024, swz = sb ^ (((sb >> 9) & 1) << 5); R = (st >> 1) * 16 + swz / 64; C = (st & 1) * 32 + (swz % 64) / 2; }
__host__ __device__ __forceinline__ int perm32(int rho) { const int n = rho >> 4, i = rho & 15; return 8 * (i >> 2) + 4 * n + (i & 3); }

struct Unit { int pm, pn; };
struct Gemm { const bf16_t* A; const bf16_t* Bt; int M, N, K; };

struct StaticOrder {
    int nM, nN, nwg, G, c;
    __host__ __device__ void init(int M, int N, int G_, int c_) { nM = M / BM; nN = N / BM; nwg = nM * nN; G = G_; c = c_; }
    __host__ __device__ bool next(int i, Unit& u) const {
        const long L = (long)i * G + c; if (L >= nwg) return false;
        int wgid = (int)L; { const int q = nwg / NXCD, r = nwg % NXCD, xcd = wgid % NXCD, off = wgid / NXCD; wgid = (xcd < r ? xcd * (q + 1) : r * (q + 1) + (xcd - r) * q) + off; }
        const int nig = WGM * nN, gid = wgid / nig, fm = gid * WGM, gsz = (nM - fm) < WGM ? (nM - fm) : WGM;
        u.pm = fm + ((wgid % nig) % gsz); u.pn = (wgid % nig) / gsz; return true;
    }
    __device__ __forceinline__ void a_ready(const Unit&) const {}
    __device__ __forceinline__ void done(const Unit&) const {}
};
typedef float f32x2v __attribute__((ext_vector_type(2)));
typedef __bf16 bf16x2v __attribute__((ext_vector_type(2)));
__device__ __forceinline__ unsigned cvt_pk_bf16(float lo, float hi) { const f32x2v v = {lo, hi}; return __builtin_bit_cast(unsigned, __builtin_convertvector(v, bf16x2v)); }

template <class Epi, class Sched, bool ALIGN_EPI = false, bool SP2 = false>
__device__ __forceinline__ void gemm_phase(PG8_LAS unsigned char* lds, const Gemm g, const Sched& S, const Epi& E) {
    int tid_l = threadIdx.x; asm volatile("" : "+v"(tid_l));
    const int tid = tid_l, wid = __builtin_amdgcn_readfirstlane(tid >> 6), lane = tid & 63, wr = wid >> 2, wc = wid & 3, fr = lane & 15, fq = lane >> 4;
    const int K = g.K, nt = K / BK;
    unsigned voffA[2], voffB[2];
#pragma unroll
    for (int i = 0; i < 2; ++i) { int R, C; stage_rc(tid * 16 + i * 8192, R, C); const int Rb = Epi::PERM ? ((R & ~31) + perm32(R & 31)) : R;
        voffA[i] = (unsigned)(R * K + C) * 2u; voffB[i] = (unsigned)(Rb * K + C) * 2u; }
    const size_t kstep = (size_t)(BK * 2);
    const size_t hstep = (size_t)HALF * K * 2;
    const size_t tstep = 2 * hstep;
    const unsigned ldsw = (unsigned)wid * 1024u;
    const int aoff = lds_byte(wr * 64 + fr, fq * 8), boff = lds_byte(wc * 32 + fr, fq * 8);
#define PG8_SA(b, h) (((b) * 2 + (h)) * HTB)
#define PG8_SB(b, h) ((4 + (b) * 2 + (h)) * HTB)
#define PG8_STAGE(bufoff, gbase, voff) do { _Pragma("unroll") for (int _i = 0; _i < 2; ++_i) \
        __builtin_amdgcn_global_load_lds((const unsigned*)((const char*)(gbase) + (voff)[_i]), (PG8_LAS unsigned*)(lds + (bufoff) + ldsw + _i * 8192), 16, 0, 0); } while (0)
#define PG8_LDA(dst, b, h) do { _Pragma("unroll") for (int m = 0; m < 4; ++m) _Pragma("unroll") for (int k = 0; k < 2; ++k) dst[m][k] = *(const PG8_LAS bf16x8*)(lds + PG8_SA(b, h) + aoff + m * 2048 + k * 1024); } while (0)
#define PG8_LDB(dst, b, h) do { _Pragma("unroll") for (int n = 0; n < 2; ++n) _Pragma("unroll") for (int k = 0; k < 2; ++k) dst[n][k] = *(const PG8_LAS bf16x8*)(lds + PG8_SB(b, h) + boff + n * 2048 + k * 1024); } while (0)
#define PG8_MMA(ai, bj, At, Bt) do { __builtin_amdgcn_s_setprio(1); _Pragma("unroll") for (int m = 0; m < 4; ++m) _Pragma("unroll") for (int n = 0; n < 2; ++n) _Pragma("unroll") for (int k = 0; k < 2; ++k) \
        acc[ai][bj][m][n] = __builtin_amdgcn_mfma_f32_16x16x32_bf16(Bt[n][k], At[m][k], acc[ai][bj][m][n], 0, 0, 0); __builtin_amdgcn_s_setprio(0); } while (0)
#define PG8_WAIT_V(n) asm volatile("s_waitcnt vmcnt(" #n ")" ::: "memory")
#define PG8_WAIT_L(n) asm volatile("s_waitcnt lgkmcnt(" #n ")" ::: "memory")
#define PG8_BAR __builtin_amdgcn_s_barrier()
#define PG8_SCHED __builtin_amdgcn_sched_barrier(0)
    Unit cur, nxt; int ui = 0;
    if (!S.next(0, cur)) return;
    f32x4 acc[2][2][4][2];
#pragma unroll
    for (int a = 0; a < 2; ++a)
#pragma unroll
        for (int b = 0; b < 2; ++b)
#pragma unroll
            for (int m = 0; m < 4; ++m)
#pragma unroll
                for (int n = 0; n < 2; ++n) acc[a][b][m][n] = (f32x4){0.f, 0.f, 0.f, 0.f};
    bf16x8 At[4][2], B0[2][2], B1[2][2];
    const char* cA = (const char*)g.A + (size_t)cur.pm * tstep; const char* cB = (const char*)g.Bt + (size_t)cur.pn * tstep;
    S.a_ready(cur);
    if constexpr (SP2) {
        PG8_STAGE(PG8_SB(0, 0), cB, voffB); PG8_STAGE(PG8_SB(0, 1), cB + hstep, voffB); PG8_STAGE(PG8_SA(0, 0), cA, voffA); PG8_STAGE(PG8_SA(0, 1), cA + hstep, voffA);
        if (wr == 1) PG8_BAR;
        PG8_WAIT_V(2); PG8_BAR;
        PG8_STAGE(PG8_SB(1, 0), cB + kstep, voffB); PG8_STAGE(PG8_SA(1, 0), cA + kstep, voffA); PG8_STAGE(PG8_SB(1, 1), cB + hstep + kstep, voffB);
        PG8_WAIT_V(6); PG8_BAR;
    } else {
        PG8_STAGE(PG8_SB(0, 0), cB, voffB); PG8_STAGE(PG8_SA(0, 0), cA, voffA); PG8_STAGE(PG8_SB(0, 1), cB + hstep, voffB); PG8_STAGE(PG8_SA(0, 1), cA + hstep, voffA);
        if (wr == 1) PG8_BAR;
        PG8_WAIT_V(4); PG8_BAR;
        PG8_STAGE(PG8_SB(1, 0), cB + kstep, voffB); PG8_STAGE(PG8_SA(1, 0), cA + kstep, voffA); PG8_STAGE(PG8_SB(1, 1), cB + hstep + kstep, voffB);
        PG8_WAIT_V(6); PG8_BAR;
    }
    for (;;) {
        const bool has_next = S.next(ui + 1, nxt);
        const char* nA = has_next ? (const char*)g.A + (size_t)nxt.pm * tstep : cA; const char* nB = has_next ? (const char*)g.Bt + (size_t)nxt.pn * tstep : cB;
        for (int t = 0; t < nt; t += 2) {
            const bool last = (t == nt - 2);
            const char* a1 = cA + (size_t)(t + 1) * kstep;
            const char* a2 = last ? nA : cA + (size_t)(t + 2) * kstep; const char* b2 = last ? nB : cB + (size_t)(t + 2) * kstep;
            const char* a3 = a2 + kstep; const char* b3 = b2 + kstep;
            if (last && has_next) S.a_ready(nxt);
            if constexpr (SP2) {
            PG8_LDB(B0, 0, 0); PG8_LDB(B1, 0, 1); PG8_SCHED; PG8_LDA(At, 0, 0); PG8_STAGE(PG8_SA(1, 1), a1 + hstep, voffA);
            PG8_WAIT_V(8); PG8_WAIT_L(0); PG8_BAR; PG8_MMA(0, 0, At, B0); PG8_MMA(0, 1, At, B1); PG8_BAR; PG8_SCHED;
            PG8_LDA(At, 0, 1); PG8_STAGE(PG8_SB(0, 0), b2, voffB); PG8_STAGE(PG8_SB(0, 1), b2 + hstep, voffB); PG8_STAGE(PG8_SA(0, 0), a2, voffA);
            PG8_WAIT_V(8); PG8_WAIT_L(0); PG8_BAR; PG8_MMA(1, 0, At, B0); PG8_MMA(1, 1, At, B1); PG8_BAR; PG8_SCHED;
            PG8_LDB(B0, 1, 0); PG8_LDB(B1, 1, 1); PG8_SCHED; PG8_LDA(At, 1, 0); PG8_STAGE(PG8_SA(0, 1), a2 + hstep, voffA);
            PG8_WAIT_V(8); PG8_WAIT_L(0); PG8_BAR; PG8_MMA(0, 0, At, B0); PG8_MMA(0, 1, At, B1); PG8_BAR; PG8_SCHED;
            PG8_LDA(At, 1, 1); PG8_STAGE(PG8_SB(1, 0), b3, voffB); PG8_STAGE(PG8_SB(1, 1), b3 + hstep, voffB); PG8_STAGE(PG8_SA(1, 0), a3, voffA);
            PG8_WAIT_V(8); PG8_WAIT_L(0); PG8_BAR; PG8_MMA(1, 0, At, B0); PG8_MMA(1, 1, At, B1); PG8_BAR; PG8_SCHED;
            } else {
            PG8_LDB(B0, 0, 0); PG8_SCHED; PG8_LDA(At, 0, 0); PG8_STAGE(PG8_SA(1, 1), a1 + hstep, voffA);
            PG8_WAIT_L(8); PG8_BAR; PG8_WAIT_L(0); PG8_MMA(0, 0, At, B0); PG8_BAR; PG8_SCHED;
            PG8_LDB(B1, 0, 1); PG8_STAGE(PG8_SB(0, 0), b2, voffB);
            PG8_BAR; PG8_WAIT_L(0); PG8_MMA(0, 1, At, B1); PG8_BAR;
            PG8_LDA(At, 0, 1); PG8_STAGE(PG8_SA(0, 0), a2, voffA);
            PG8_BAR; PG8_WAIT_L(0); PG8_MMA(1, 0, At, B0); PG8_BAR; PG8_SCHED;
            PG8_STAGE(PG8_SB(0, 1), b2 + hstep, voffB);
            PG8_WAIT_V(6); PG8_BAR; PG8_MMA(1, 1, At, B1); PG8_BAR;
            PG8_LDB(B0, 1, 0); PG8_SCHED; PG8_LDA(At, 1, 0); PG8_STAGE(PG8_SA(0, 1), a2 + hstep, voffA);
            PG8_WAIT_L(8); PG8_BAR; PG8_WAIT_L(0); PG8_MMA(0, 0, At, B0); PG8_BAR; PG8_SCHED;
            PG8_LDB(B1, 1, 1); PG8_STAGE(PG8_SB(1, 0), b3, voffB);
            PG8_BAR; PG8_WAIT_L(0); PG8_MMA(0, 1, At, B1); PG8_BAR;
            PG8_LDA(At, 1, 1); PG8_STAGE(PG8_SA(1, 0), a3, voffA);
            PG8_BAR; PG8_WAIT_L(0); PG8_MMA(1, 0, At, B0); PG8_BAR; PG8_SCHED;
            PG8_STAGE(PG8_SB(1, 1), b3 + hstep, voffB);
            PG8_WAIT_V(6); PG8_BAR; PG8_MMA(1, 1, At, B1); PG8_BAR;
            }
        }
        if constexpr (ALIGN_EPI) { if (wr == 0) PG8_BAR; }
        if constexpr (!Epi::AFTER_DRAIN) { E(acc, cur, wr, wc, fr, fq); S.done(cur); }
        if (!has_next) break;
#pragma unroll
        for (int a = 0; a < 2; ++a)
#pragma unroll
            for (int b = 0; b < 2; ++b)
#pragma unroll
                for (int m = 0; m < 4; ++m)
#pragma unroll
                    for (int n = 0; n < 2; ++n) acc[a][b][m][n] = (f32x4){0.f, 0.f, 0.f, 0.f};
        cur = nxt; cA = nA; cB = nB; ++ui;
        if constexpr (ALIGN_EPI) { if (wr == 1) PG8_BAR; }
    }
    PG8_WAIT_V(0);
    if constexpr (!ALIGN_EPI) { if (wr == 0) PG8_BAR; }
    PG8_BAR;
    if constexpr (Epi::AFTER_DRAIN) { E.fused(acc, cur, wr, wc, fr, fq, lds, wid, lane); S.done(cur); }
#undef PG8_SA
#undef PG8_SB
#undef PG8_STAGE
#undef PG8_LDA
#undef PG8_LDB
#undef PG8_MMA
#undef PG8_WAIT_V
#undef PG8_WAIT_L
#undef PG8_BAR
#undef PG8_SCHED
}
}

#define DI __device__ __forceinline__
#define LAS __attribute__((address_space(3)))
using pg8::bf16_t; using pg8::bf16x8; using pg8::f32x4; using pg8::u32x4;
typedef unsigned u32x2 __attribute__((ext_vector_type(2)));
typedef short s16x4 __attribute__((ext_vector_type(4)));
typedef float f32x2 __attribute__((ext_vector_type(2)));

constexpr int T = 16384, L = 8192, D = 2048;
constexpr float EPS = 1e-6f;
constexpr size_t MiB = 1u << 20;
constexpr size_t OFF_MOD = 65536, OFF_BA = 1 * MiB, OFF_GC = 3 * MiB, OFF_EGL = 5 * MiB,
    OFF_WDN = 8 * MiB, OFF_WSW = 12 * MiB, OFF_WOUT = 16 * MiB, OFF_WIN = 24 * MiB, OFF_H = 64 * MiB, OFF_Z = 128 * MiB, OFF_QSW = 160 * MiB, OFF_KVSW = 192 * MiB,
    OFF_QKV = 208 * MiB, OFF_QC = 304 * MiB, OFF_KC = 336 * MiB, OFF_VC = 368 * MiB, OFF_YSW = 400 * MiB,
    OFF_W = 208 * MiB, OFF_A = 272 * MiB, OFF_U = 432 * MiB, OFF_OF = 368 * MiB, OFF_OB = 160 * MiB, OFF_YDN = 208 * MiB, OFF_TG = 240 * MiB, OFF_MRG = 304 * MiB,
    OFF_WMI = 128 * MiB, OFF_WMO = 160 * MiB, OFF_UU = 208 * MiB, WS_END = 496 * MiB;
constexpr int LDS_BYTES = 160 * 1024;

struct Params {
    const float *x, *c, *w_ada, *b_ada, *norm1_w, *w_in, *conv_w, *a_log, *dt_bias, *dn_norm_w, *w_dn, *qn_w, *kn_w, *sink, *w_sw, *w_out, *norm2_w, *w_mi, *w_mo;
    float* out; unsigned char* ws;
};

DI float bflo(unsigned u) { return __uint_as_float(u << 16); }
DI float bfhi(unsigned u) { return __uint_as_float(u & 0xffff0000u); }
DI float bf2f(unsigned short u) { return __uint_as_float(((unsigned)u) << 16); }
DI unsigned short f2bf(float f) { unsigned u = __float_as_uint(f); return (unsigned short)((u + 0x7fffu + ((u >> 16) & 1u)) >> 16); }
DI unsigned pk2(float lo, float hi) { return pg8::cvt_pk_bf16(lo, hi); }
DI float wave_sum(float v) {
#pragma unroll
    for (int o = 1; o < 64; o <<= 1) v += __shfl_xor(v, o);
    return v;
}
DI float sigmoidf_(float x) { return 1.f / (1.f + __expf(-x)); }
DI float siluf_(float x) { return x / (1.f + __expf(-x)); }
DI f32x4 mfma16(bf16x8 a, bf16x8 b, f32x4 c) { return __builtin_amdgcn_mfma_f32_16x16x32_bf16(a, b, c, 0, 0, 0); }
DI bf16x8 pack8(f32x4 a, f32x4 b) { u32x4 p; p.x = pk2(a[0], a[1]); p.y = pk2(a[2], a[3]); p.z = pk2(b[0], b[1]); p.w = pk2(b[2], b[3]); return __builtin_bit_cast(bf16x8, p); }
DI bf16x8 cat4(s16x4 lo, s16x4 hi) { return __builtin_shufflevector(lo, hi, 0, 1, 2, 3, 4, 5, 6, 7); }
#define LDS_WAIT() asm volatile("s_waitcnt lgkmcnt(0)" ::: "memory")
DI void fpma(float& acc, float a, float t) { asm("v_fma_f32 %0, %1, %2, %0" : "+v"(acc) : "v"(a), "v"(t)); }
DI void fnma(float& acc, float a, float t) { asm("v_fma_f32 %0, -%1, %2, %0" : "+v"(acc) : "v"(a), "v"(t)); }
DI s16x4 tr_read(const LAS bf16_t* p) { return __builtin_amdgcn_ds_read_tr16_b64_v4i16((LAS s16x4*)p); }

DI void transpose_item(const float* W, int K, int N, bf16_t* WT, int k0, int n0, int dst_row0, int ncols, LAS float* scr, int lane) {
    const int sub = lane >> 4, c4 = lane & 15;
    f32x4 v[16];
    if (4 * c4 < ncols) {
#pragma unroll
        for (int i = 0; i < 16; ++i) v[i] = *(const f32x4*)(W + (size_t)(k0 + 4 * i + sub) * N + n0 + 4 * c4);
#pragma unroll
        for (int i = 0; i < 16; ++i) { LAS float* d = scr + (4 * i + sub) * 65 + 4 * c4; d[0] = v[i][0]; d[1] = v[i][1]; d[2] = v[i][2]; d[3] = v[i][3]; }
    }
    LDS_WAIT();
    const int c = lane & 7;
#pragma unroll
    for (int j = 0; j < 8; ++j) { const int n = (lane >> 3) + 8 * j; const LAS float* s = scr + (8 * c) * 65 + n;
        if (n < ncols) { u32x4 o; o.x = pk2(s[0 * 65], s[1 * 65]); o.y = pk2(s[2 * 65], s[3 * 65]); o.z = pk2(s[4 * 65], s[5 * 65]); o.w = pk2(s[6 * 65], s[7 * 65]);
            *(u32x4*)(WT + (size_t)(dst_row0 + n) * K + k0 + 8 * c) = o; } }
    LDS_WAIT();
}
DI void win_tile(int t, int& n0, int& dst, int& ncols) {
    if (t < 64) { n0 = 64 * t; dst = 4096 + n0; ncols = 64; }
    else if (t < 88) { n0 = 4128 + 64 * (t - 64); dst = 8192 + 64 * (t - 64); ncols = 64; }
    else if (t < 152) { n0 = 5664 + 64 * (t - 88); dst = 64 * (t - 88); ncols = 64; }
    else { n0 = 4096; dst = 9728; ncols = 32; }
}

DI void phase0(const Params& p, LAS unsigned char* lds, int tid, int wave, int lane) {
    unsigned char* ws = p.ws;
    if (blockIdx.x < 192) {
        LAS float* sc = (LAS float*)lds; LAS float* red = sc + 4096;
        for (int i = tid; i < 4096; i += 512) sc[i] = siluf_(p.c[i]);
        __syncthreads();
        const int col = blockIdx.x * 64 + lane; float a0 = 0.f, a1 = 0.f;
        const float* wp = p.w_ada + (size_t)(wave * 256) * 12288 + col;
#pragma unroll 32
        for (int k = 0; k < 256; ++k) { const float w = wp[(size_t)k * 12288]; a0 += sc[wave * 256 + k] * w; a1 += sc[2048 + wave * 256 + k] * w; }
        red[(wave * 2 + 0) * 64 + lane] = a0; red[(wave * 2 + 1) * 64 + lane] = a1;
        __syncthreads();
        if (wave < 2) { float s = 0.f;
#pragma unroll
            for (int w = 0; w < 8; ++w) s += red[(w * 2 + wave) * 64 + lane];
            ((float*)(ws + OFF_MOD))[wave * 12288 + col] = s + p.b_ada[col]; }
        __syncthreads();
    }
    LAS float* scr = (LAS float*)(lds + wave * 16640);
    const int gw = blockIdx.x * 8 + wave, NGW = gridDim.x * 8;
    constexpr int I_IN = 32 * 153, I_DN = 16 * 32, I_OUT = 32 * 32;
    for (int it = gw; it < I_IN + 2 * I_DN + I_OUT; it += NGW) {
        int r = it;
        if (r < I_IN) { int n0, dst, nc; win_tile(r % 153, n0, dst, nc); transpose_item(p.w_in, 2048, 9760, (bf16_t*)(ws + OFF_WIN), 64 * (r / 153), n0, dst, nc, scr, lane); continue; } r -= I_IN;
        if (r < I_DN) { transpose_item(p.w_dn, 1024, 2048, (bf16_t*)(ws + OFF_WDN), 64 * (r / 32), 64 * (r % 32), 64 * (r % 32), 64, scr, lane); continue; } r -= I_DN;
        if (r < I_DN) { transpose_item(p.w_sw, 1024, 2048, (bf16_t*)(ws + OFF_WSW), 64 * (r / 32), 64 * (r % 32), 64 * (r % 32), 64, scr, lane); continue; } r -= I_DN;
        transpose_item(p.w_out, 2048, 2048, (bf16_t*)(ws + OFF_WOUT), 64 * (r / 32), 64 * (r % 32), 64 * (r % 32), 64, scr, lane);
    }
    { u32x4* z = (u32x4*)((bf16_t*)(ws + OFF_WIN) + (size_t)9760 * 2048); const u32x4 zero = {0u, 0u, 0u, 0u};
      for (int i = blockIdx.x * 512 + tid; i < 57344; i += gridDim.x * 512) z[i] = zero; }
}
DI void phase_mlp_weights(const Params& p, LAS unsigned char* lds, int wave, int lane) {
    LAS float* scr = (LAS float*)(lds + wave * 16640);
    const int gw = blockIdx.x * 8 + wave, NGW = gridDim.x * 8;
    constexpr int I_MI = 32 * 128, I_MO = 128 * 32;
    for (int it = gw; it < I_MI + I_MO; it += NGW) {
        int r = it;
        if (r < I_MI) { transpose_item(p.w_mi, 2048, 8192, (bf16_t*)(p.ws + OFF_WMI), 64 * (r / 128), 64 * (r % 128), 64 * (r % 128), 64, scr, lane); continue; } r -= I_MI;
        transpose_item(p.w_mo, 8192, 2048, (bf16_t*)(p.ws + OFF_WMO), 64 * (r / 32), 64 * (r % 32), 64 * (r % 32), 64, scr, lane);
    }
}

DI void phase_modnorm(const float* x, const float* normw, const float* mod, int shift_off, int scale_off, bf16_t* H, int wave, int lane) {
    const int gw = blockIdx.x * 8 + wave, NGW = gridDim.x * 8;
    for (int m0 = 2 * gw; m0 < T; m0 += 2 * NGW) {
        const int b = m0 >> 13;
        const f32x4* xr = (const f32x4*)(x + (size_t)m0 * D) + lane;
        f32x4 v[2][8]; float s[2] = {0.f, 0.f};
#pragma unroll
        for (int r = 0; r < 2; ++r)
#pragma unroll
            for (int j = 0; j < 8; ++j) v[r][j] = xr[r * (D / 4) + 64 * j];
#pragma unroll
        for (int r = 0; r < 2; ++r)
#pragma unroll
            for (int j = 0; j < 8; ++j) s[r] += (v[r][j][0] * v[r][j][0] + v[r][j][1] * v[r][j][1]) + (v[r][j][2] * v[r][j][2] + v[r][j][3] * v[r][j][3]);
        const float rstd0 = rsqrtf(wave_sum(s[0]) * (1.f / D) + EPS), rstd1 = rsqrtf(wave_sum(s[1]) * (1.f / D) + EPS);
        u32x2* o = (u32x2*)(H + (size_t)m0 * D) + lane;
#pragma unroll
        for (int j = 0; j < 8; ++j) { const int col = 256 * j + 4 * lane;
            const f32x4 nw = *(const f32x4*)(normw + col), sc = *(const f32x4*)(mod + b * 12288 + scale_off + col), sh = *(const f32x4*)(mod + b * 12288 + shift_off + col);
            f32x4 a;
#pragma unroll
            for (int i = 0; i < 4; ++i) a[i] = nw[i] * (1.f + sc[i]);
            u32x2 w0, w1;
            w0.x = pk2(v[0][j][0] * rstd0 * a[0] + sh[0], v[0][j][1] * rstd0 * a[1] + sh[1]); w0.y = pk2(v[0][j][2] * rstd0 * a[2] + sh[2], v[0][j][3] * rstd0 * a[3] + sh[3]);
            w1.x = pk2(v[1][j][0] * rstd1 * a[0] + sh[0], v[1][j][1] * rstd1 * a[1] + sh[1]); w1.y = pk2(v[1][j][2] * rstd1 * a[2] + sh[2], v[1][j][3] * rstd1 * a[3] + sh[3]);
            o[64 * j] = w0; o[D / 4 + 64 * j] = w1; }
    }
}

#define EPI_ARGS const f32x4 (&acc)[2][2][4][2], const pg8::Unit& u, int wr, int wc, int fr, int fq
#define EPI_BEGIN _Pragma("unroll") for (int ai = 0; ai < 2; ++ai) _Pragma("unroll") for (int m = 0; m < 4; ++m) { const int r = u.pm * 256 + ai * 128 + wr * 64 + m * 16 + fr; \
    _Pragma("unroll") for (int bj = 0; bj < 2; ++bj) { const int cl = bj * 128 + wc * 32 + 8 * fq; f32x4 v0 = acc[ai][bj][m][0], v1 = acc[ai][bj][m][1];
#define EPI_END } }
DI u32x4 pack_row8(f32x4 a, f32x4 b) { u32x4 o; o.x = pk2(a[0], a[1]); o.y = pk2(a[2], a[3]); o.z = pk2(b[0], b[1]); o.w = pk2(b[2], b[3]); return o; }

struct EpiIn {
    static constexpr bool PERM = true, AFTER_DRAIN = false;
    bf16_t *qkv, *z, *qsw, *kvsw; float* ba; const float* a_log; const float* dt_bias;
    DI void operator()(EPI_ARGS) const {
        const int pn = u.pn;
        if (pn < 22) {
            bf16_t* base; int ldc, c0; bool act = false;
            if (pn < 12) { base = qkv; ldc = 3072; c0 = pn * 256; }
            else if (pn < 16) { base = z; ldc = 1024; c0 = (pn - 12) * 256; act = true; }
            else if (pn < 20) { base = qsw; ldc = 1024; c0 = (pn - 16) * 256; }
            else { base = kvsw; ldc = 512; c0 = (pn - 20) * 256; }
            EPI_BEGIN
                if (act) {
#pragma unroll
                    for (int i = 0; i < 4; ++i) { v0[i] = siluf_(v0[i]); v1[i] = siluf_(v1[i]); } }
                *(u32x4*)(base + (size_t)r * ldc + c0 + cl) = pack_row8(v0, v1);
            EPI_END
        } else if (wc == 0) {
            const int j0 = (fq & 1) * 8;
            f32x4 al0 = {0, 0, 0, 0}, al1 = al0, db0 = al0, db1 = al0;
            if (fq >= 2) { al0 = *(const f32x4*)(a_log + j0); al1 = *(const f32x4*)(a_log + j0 + 4); db0 = *(const f32x4*)(dt_bias + j0); db1 = *(const f32x4*)(dt_bias + j0 + 4); }
#pragma unroll
            for (int ai = 0; ai < 2; ++ai)
#pragma unroll
                for (int m = 0; m < 4; ++m) { const int r = u.pm * 256 + ai * 128 + wr * 64 + m * 16 + fr;
                    f32x4 v0 = acc[ai][0][m][0], v1 = acc[ai][0][m][1];
                    if (fq < 2) {
#pragma unroll
                        for (int i = 0; i < 4; ++i) { v0[i] = sigmoidf_(v0[i]); v1[i] = sigmoidf_(v1[i]); }
                    } else {
#pragma unroll
                        for (int i = 0; i < 4; ++i) {
                            float a = v0[i] + db0[i]; float sp = fmaxf(a, 0.f) + log1pf(__expf(-fabsf(a))); v0[i] = -__expf(al0[i]) * sp;
                            a = v1[i] + db1[i]; sp = fmaxf(a, 0.f) + log1pf(__expf(-fabsf(a))); v1[i] = -__expf(al1[i]) * sp; }
                    }
                    *(f32x4*)(ba + (size_t)r * 32 + 8 * fq) = v0; *(f32x4*)(ba + (size_t)r * 32 + 8 * fq + 4) = v1; }
        }
    }
};
struct EpiSig {
    static constexpr bool PERM = true, AFTER_DRAIN = false;
    bf16_t* O; int ldc;
    DI void operator()(EPI_ARGS) const {
        EPI_BEGIN
#pragma unroll
            for (int i = 0; i < 4; ++i) { v0[i] = sigmoidf_(v0[i]); v1[i] = sigmoidf_(v1[i]); }
            *(u32x4*)(O + (size_t)r * ldc + u.pn * 256 + cl) = pack_row8(v0, v1);
        EPI_END
    }
};
template <bool ADD> struct EpiMerge {
    static constexpr bool PERM = true, AFTER_DRAIN = false;
    const bf16_t* TG; const bf16_t* ADDEND; bf16_t* OUT;
    DI void operator()(EPI_ARGS) const {
        EPI_BEGIN
            const size_t off = (size_t)r * 2048 + u.pn * 256 + cl;
            const u32x4 g = *(const u32x4*)(TG + off);
            v0[0] *= bflo(g.x); v0[1] *= bfhi(g.x); v0[2] *= bflo(g.y); v0[3] *= bfhi(g.y); v1[0] *= bflo(g.z); v1[1] *= bfhi(g.z); v1[2] *= bflo(g.w); v1[3] *= bfhi(g.w);
            if (ADD) { const u32x4 o = *(const u32x4*)(ADDEND + off);
                v0[0] += bflo(o.x); v0[1] += bfhi(o.x); v0[2] += bflo(o.y); v0[3] += bfhi(o.y); v1[0] += bflo(o.z); v1[1] += bfhi(o.z); v1[2] += bflo(o.w); v1[3] += bfhi(o.w); }
            *(u32x4*)(OUT + off) = pack_row8(v0, v1);
        EPI_END
    }
};
struct EpiRes {
    static constexpr bool PERM = true, AFTER_DRAIN = false;
    const float* res; const float* gate; float* out;
    DI void operator()(EPI_ARGS) const {
        const float* gp = gate + (u.pm >> 5) * 12288 + u.pn * 256;
        EPI_BEGIN
            const size_t off = (size_t)r * 2048 + u.pn * 256 + cl;
            const f32x4 g0 = *(const f32x4*)(gp + cl), g1 = *(const f32x4*)(gp + cl + 4);
            const f32x4 x0 = *(const f32x4*)(res + off), x1 = *(const f32x4*)(res + off + 4);
            *(f32x4*)(out + off) = x0 + g0 * v0; *(f32x4*)(out + off + 4) = x1 + g1 * v1;
        EPI_END
    }
};
struct EpiRelu2 {
    static constexpr bool PERM = true, AFTER_DRAIN = false;
    bf16_t* O; int ldc;
    DI void operator()(EPI_ARGS) const {
        EPI_BEGIN
#pragma unroll
            for (int i = 0; i < 4; ++i) { float a = fmaxf(v0[i], 0.f); v0[i] = a * a; a = fmaxf(v1[i], 0.f); v1[i] = a * a; }
            *(u32x4*)(O + (size_t)r * ldc + u.pn * 256 + cl) = pack_row8(v0, v1);
        EPI_END
    }
};

DI void phase_conv(const bf16_t* qkv, const float* conv_w, bf16_t* Qc, bf16_t* Kc, bf16_t* Vc, int wave, int lane) {
    const int gw = blockIdx.x * 8 + wave, NGW = gridDim.x * 8;
    for (int it = gw; it < 6 * 1024; it += NGW) {
        const int g = it % 6, run = it / 6, t0 = run * 16, tl0 = t0 & 8191, ch = g * 512 + 8 * lane;
        u32x4 rows[20];
#pragma unroll
        for (int i = 0; i < 20; ++i) { const int tl = tl0 - 2 + i; rows[i] = (tl >= 0 && tl < 8192) ? *(const u32x4*)(qkv + (size_t)(t0 - 2 + i) * 3072 + ch) : (u32x4){0u, 0u, 0u, 0u}; }
        f32x4 wl[5], wh[5];
#pragma unroll
        for (int j = 0; j < 5; ++j) { wl[j] = *(const f32x4*)(conv_w + j * 3072 + ch); wh[j] = *(const f32x4*)(conv_w + j * 3072 + ch + 4); }
        bf16_t* dst = (g < 2 ? Qc : (g < 4 ? Kc : Vc)) + (size_t)t0 * 1024 + (g & 1) * 512 + 8 * lane;
        const float post = g < 2 ? 0.08838834764831845f : 1.f;
#pragma unroll
        for (int i = 0; i < 16; ++i) {
            float a[8] = {0.f, 0.f, 0.f, 0.f, 0.f, 0.f, 0.f, 0.f};
#pragma unroll
            for (int j = 0; j < 5; ++j) { const u32x4 r = rows[i + j];
                a[0] += wl[j][0] * bflo(r.x); a[1] += wl[j][1] * bfhi(r.x); a[2] += wl[j][2] * bflo(r.y); a[3] += wl[j][3] * bfhi(r.y);
                a[4] += wh[j][0] * bflo(r.z); a[5] += wh[j][1] * bfhi(r.z); a[6] += wh[j][2] * bflo(r.w); a[7] += wh[j][3] * bfhi(r.w); }
            float ss = 0.f;
#pragma unroll
            for (int e = 0; e < 8; ++e) { a[e] = siluf_(a[e]); ss += a[e] * a[e]; }
            if (g < 4) { ss += __shfl_xor(ss, 1); ss += __shfl_xor(ss, 2); ss += __shfl_xor(ss, 4); ss += __shfl_xor(ss, 8);
                const float sc = rsqrtf(ss + EPS) * post;
#pragma unroll
                for (int e = 0; e < 8; ++e) a[e] *= sc; }
            u32x4 o; o.x = pk2(a[0], a[1]); o.y = pk2(a[2], a[3]); o.z = pk2(a[4], a[5]); o.w = pk2(a[6], a[7]);
            *(u32x4*)(dst + (size_t)i * 1024) = o;
        }
    }
}
DI void normrope16(bf16_t* ptr, const float* nw, const LAS f32x2* tab, float scale, int lane) {
    u32x4 a = *(const u32x4*)ptr, b = *(const u32x4*)(ptr + 8);
    float v[16];
    v[0] = bflo(a.x); v[1] = bfhi(a.x); v[2] = bflo(a.y); v[3] = bfhi(a.y); v[4] = bflo(a.z); v[5] = bfhi(a.z); v[6] = bflo(a.w); v[7] = bfhi(a.w);
    v[8] = bflo(b.x); v[9] = bfhi(b.x); v[10] = bflo(b.y); v[11] = bfhi(b.y); v[12] = bflo(b.z); v[13] = bfhi(b.z); v[14] = bflo(b.w); v[15] = bfhi(b.w);
    float ss = 0.f;
#pragma unroll
    for (int i = 0; i < 16; ++i) ss += v[i] * v[i];
    ss += __shfl_xor(ss, 1); ss += __shfl_xor(ss, 2); ss += __shfl_xor(ss, 4);
    const float rstd = rsqrtf(ss * (1.f / 128.f) + EPS);
    const int sub = lane & 7;
#pragma unroll
    for (int i = 0; i < 16; ++i) v[i] = v[i] * rstd * nw[sub * 16 + i];
#pragma unroll
    for (int i = 0; i < 16; ++i) { const float pr = __shfl_xor(v[i], 1); const f32x2 cs = tab[i];
        if (sub == 0) v[i] = v[i] * cs[0] - pr * cs[1]; else if (sub == 1) v[i] = v[i] * cs[0] + pr * cs[1]; }
    u32x4 o0, o1;
    o0.x = pk2(v[0] * scale, v[1] * scale); o0.y = pk2(v[2] * scale, v[3] * scale); o0.z = pk2(v[4] * scale, v[5] * scale); o0.w = pk2(v[6] * scale, v[7] * scale);
    o1.x = pk2(v[8] * scale, v[9] * scale); o1.y = pk2(v[10] * scale, v[11] * scale); o1.z = pk2(v[12] * scale, v[13] * scale); o1.w = pk2(v[14] * scale, v[15] * scale);
    *(u32x4*)ptr = o0; *(u32x4*)(ptr + 8) = o1;
}
DI void phase_swa_normrope(bf16_t* QSW, bf16_t* KVSW, const float* qn_w, const float* kn_w, LAS unsigned char* lds, int wave, int lane) {
    const int gw = blockIdx.x * 8 + wave, NGW = gridDim.x * 8;
    LAS f32x2* tab = (LAS f32x2*)(lds + wave * 128);
    for (int tk = gw; tk < T; tk += NGW) {
        const int pos = tk & 8191;
        if (lane < 16) {
            const float invf = exp2f(-(float)lane * (18.931568569324174f / 16.f));
            const float ang = (float)pos * invf;
            const double ad = (double)ang; const double kq = __builtin_rint(ad * 0.15915494309189535); const float rr = (float)(ad - kq * 6.283185307179586);
            f32x2 cs; cs[0] = __cosf(rr); cs[1] = __sinf(rr); tab[lane] = cs;
        }
        LDS_WAIT();
        normrope16(QSW + (size_t)tk * 1024 + lane * 16, qn_w, tab, 0.08838834764831845f, lane);
        if (lane < 16) normrope16(KVSW + (size_t)tk * 512 + lane * 16, kn_w, tab, 1.f, lane);
        LDS_WAIT();
    }
}

DI void swa_block(const bf16_t* QSW, const bf16_t* KVSW, const float* sink, bf16_t* Ysw, LAS unsigned char* lds, int tid, int wave, int lane) {
    const int fr = lane & 15, fq = lane >> 4, r = tid >> 2, sg = tid & 3, qi = 16 * wave + fr;
    LAS bf16_t* Kl = (LAS bf16_t*)lds; LAS bf16_t* VTl = Kl + 128 * 136;
    int it = blockIdx.x; if (it >= 1024) return;
    int kb = (((it >> 3) & 63) == 0) ? 1 : 0;
    u32x4 kk[4], vv[4]; bf16x8 qf[4], qn[4];
#define ATT_LOADKV(item_, kb_) do { const int hkv_ = ((item_) & 7) >> 2, nb_ = ((item_) >> 3) & 63, b_ = (item_) >> 9; const size_t tok_ = (size_t)b_ * L + 128 * (nb_ - 1 + (kb_)) + r; \
        const u32x4* ks_ = (const u32x4*)(KVSW + tok_ * 512 + hkv_ * 128 + sg * 32); const u32x4* vs_ = (const u32x4*)(KVSW + tok_ * 512 + 256 + hkv_ * 128 + sg * 32); \
        _Pragma("unroll") for (int i = 0; i < 4; ++i) { kk[i] = ks_[i]; vv[i] = vs_[i]; } } while (0)
#define ATT_LOADQ(dst, item_) do { const int hq_ = (item_) & 7, nb_ = ((item_) >> 3) & 63, b_ = (item_) >> 9; const size_t tq_ = (size_t)b_ * L + 128 * nb_ + qi; \
        _Pragma("unroll") for (int ks = 0; ks < 4; ++ks) dst[ks] = *(const bf16x8*)(QSW + tq_ * 1024 + hq_ * 128 + 32 * ks + 8 * fq); } while (0)
    ATT_LOADKV(it, kb); ATT_LOADQ(qf, it);
#pragma unroll
    for (int ks = 0; ks < 4; ++ks) qn[ks] = qf[ks];
    float mrun = 0.f, lrun = 0.f; f32x4 ot[8];
    bool first = true;
    for (;;) {
        const int hq = it & 7, nb = (it >> 3) & 63, b = it >> 9;
        __syncthreads();
#pragma unroll
        for (int i = 0; i < 4; ++i) { *(LAS u32x4*)(Kl + r * 136 + sg * 32 + 8 * i) = kk[i]; *(LAS u32x4*)(VTl + r * 136 + sg * 32 + 8 * i) = vv[i]; }
        __syncthreads();
        const bool last_kb = (kb == 2) || (nb + kb >= 64);
        int nit = it, nkb = kb + 1;
        if (last_kb) { nit = it + gridDim.x; nkb = (((nit >> 3) & 63) == 0) ? 1 : 0; }
        const bool more = nit < 1024;
        if (more) { ATT_LOADKV(nit, nkb); if (last_kb) ATT_LOADQ(qn, nit); }
        if (first) { mrun = sink[hq]; lrun = (fq == 0) ? 1.f : 0.f;
#pragma unroll
            for (int i = 0; i < 8; ++i) ot[i] = (f32x4){0.f, 0.f, 0.f, 0.f}; }
        f32x4 st[8];
#pragma unroll
        for (int mt = 0; mt < 8; ++mt) { st[mt] = (f32x4){0.f, 0.f, 0.f, 0.f};
#pragma unroll
            for (int ks = 0; ks < 4; ++ks) { const bf16x8 a = *(const LAS bf16x8*)(Kl + (16 * mt + fr) * 136 + 32 * ks + 8 * fq); st[mt] = mfma16(a, qf[ks], st[mt]); } }
        float mx = -INFINITY;
#pragma unroll
        for (int mt = 0; mt < 8; ++mt)
#pragma unroll
            for (int j = 0; j < 4; ++j) { const int kj = 16 * mt + 4 * fq + j; const bool valid = (kb == 0) ? (kj >= qi) : ((kb == 2) ? (kj <= qi) : true);
                const float sv = valid ? st[mt][j] : -INFINITY; st[mt][j] = sv; mx = fmaxf(mx, sv); }
        mx = fmaxf(mx, __shfl_xor(mx, 16)); mx = fmaxf(mx, __shfl_xor(mx, 32));
        const float mnew = fmaxf(mrun, mx), alpha = __expf(mrun - mnew);
        float ls = 0.f;
#pragma unroll
        for (int mt = 0; mt < 8; ++mt)
#pragma unroll
            for (int j = 0; j < 4; ++j) { const float pe = __expf(st[mt][j] - mnew); st[mt][j] = pe; ls += pe; }
        lrun = lrun * alpha + ls; mrun = mnew;
#pragma unroll
        for (int dt = 0; dt < 8; ++dt) ot[dt] *= alpha;
        bf16x8 pb[4];
#pragma unroll
        for (int ks = 0; ks < 4; ++ks) pb[ks] = pack8(st[2 * ks], st[2 * ks + 1]);
#pragma unroll
        for (int dt = 0; dt < 8; ++dt)
#pragma unroll
            for (int ks = 0; ks < 4; ++ks) { const LAS bf16_t* vp = VTl + (32 * ks + 4 * fq + (fr >> 2)) * 136 + 16 * dt + 4 * (fr & 3);
                const bf16x8 av = cat4(tr_read(vp), tr_read(vp + 16 * 136)); ot[dt] = mfma16(av, pb[ks], ot[dt]); }
        first = false;
        if (last_kb) {
            float lt = lrun; lt += __shfl_xor(lt, 16); lt += __shfl_xor(lt, 32);
            const float inv = 1.f / lt; const size_t tokq = (size_t)b * L + 128 * nb + qi;
#pragma unroll
            for (int dt = 0; dt < 8; ++dt) { u32x2 o; o.x = pk2(ot[dt][0] * inv, ot[dt][1] * inv); o.y = pk2(ot[dt][2] * inv, ot[dt][3] * inv);
                *(u32x2*)(Ysw + tokq * 1024 + hq * 128 + 16 * dt + 4 * fq) = o; }
#pragma unroll
            for (int ks = 0; ks < 4; ++ks) qf[ks] = qn[ks];
            first = true;
        }
        if (!more) break;
        it = nit; kb = nkb;
    }
#undef ATT_LOADKV
#undef ATT_LOADQ
}

constexpr int PREP_SET = 70400;
struct PrepStage { u32x4 kk[4], qq[4], vv[4]; float beta, g; };
DI void prep_load(PrepStage& R, const unsigned char* ws_c, int pair, int tid, int wave, int lane) {
    const bf16_t* Qc = (const bf16_t*)(ws_c + OFF_QC); const bf16_t* Kc = (const bf16_t*)(ws_c + OFF_KC); const bf16_t* Vc = (const bf16_t*)(ws_c + OFF_VC);
    const float* BA = (const float*)(ws_c + OFF_BA);
    const int grp = wave >> 2, wl = wave & 3, lt = tid & 255, item = 2 * pair + grp;
    const int n = item & 127, dirbh = item >> 7, dir = dirbh >> 4, b = (dirbh >> 3) & 1, h = dirbh & 7;
    const int c = lt >> 2, part = lt & 3;
    const size_t tok = (size_t)b * L + (dir ? (L - 1 - 64 * n - c) : (64 * n + c));
    const size_t go = tok * 1024 + h * 128 + part * 32;
#pragma unroll
    for (int i = 0; i < 4; ++i) { R.kk[i] = *(const u32x4*)(Kc + go + 8 * i); R.qq[i] = *(const u32x4*)(Qc + go + 8 * i); R.vv[i] = *(const u32x4*)(Vc + go + 8 * i); }
    if (wl == 0) { const size_t tk = (size_t)b * L + (dir ? (L - 1 - 64 * n - lane) : (64 * n + lane));
        R.beta = BA[tk * 32 + dir * 8 + h]; R.g = BA[tk * 32 + 16 + dir * 8 + h]; }
}
DI void dn_prep_pair(const unsigned char* ws_c, unsigned char* ws, LAS unsigned char* lds, int pair, int npair, PrepStage& R, int tid, int wave, int lane) {
    const bf16_t* Qc = (const bf16_t*)(ws_c + OFF_QC); const bf16_t* Kc = (const bf16_t*)(ws_c + OFF_KC); const bf16_t* Vc = (const bf16_t*)(ws_c + OFF_VC);
    const float* BA = (const float*)(ws_c + OFF_BA);
    bf16_t* Wg = (bf16_t*)(ws + OFF_W); bf16_t* Ug = (bf16_t*)(ws + OFF_U); bf16_t* Ag = (bf16_t*)(ws + OFF_A);
    f32x2* GC = (f32x2*)(ws + OFF_GC); float* EGL = (float*)(ws + OFF_EGL);
    { int l0 = threadIdx.x; asm volatile("" : "+v"(l0)); tid = l0; lane = l0 & 63; }
    const int grp = wave >> 2, wl = wave & 3, lt = tid & 255, item = 2 * pair + grp;
    const int n = item & 127, dirbh = item >> 7, dir = dirbh >> 4, b = (dirbh >> 3) & 1, h = dirbh & 7, fr = lane & 15, fq = lane >> 4;
    LAS unsigned char* base = lds + grp * PREP_SET;
    LAS bf16_t* Ks = (LAS bf16_t*)base; LAS bf16_t* Vs = Ks + 64 * 136; LAS float* Akk = (LAS float*)(base + 34816);
    LAS bf16_t* Qs = (LAS bf16_t*)(base + 51200);
    LAS bf16_t* Tb1 = (LAS bf16_t*)(base + 51200); LAS bf16_t* Tb2 = Tb1 + 64 * 72;
    LAS float* sg = (LAS float*)(base + 69632); LAS float* sb = sg + 64; LAS float* seg = sg + 128;
    __syncthreads();
    { const int c = lt >> 2, part = lt & 3;
      if (wl == 0) {
          const float beta = R.beta; float g = R.g;
#pragma unroll
          for (int off = 1; off < 64; off <<= 1) { const float t = __shfl_up(g, off); if (lane >= off) g += t; }
          const float eg = __expf(g), gl = __shfl(g, 63), dg = __expf(gl - g);
          sg[lane] = g; sb[lane] = beta; seg[lane] = eg;
          f32x2 w; w[0] = eg; w[1] = dg; GC[(size_t)dirbh * 8192 + 64 * n + lane] = w;
          if (lane == 63) EGL[dirbh * 128 + n] = eg;
      }
#pragma unroll
      for (int i = 0; i < 4; ++i) { *(LAS u32x4*)(Ks + c * 136 + part * 32 + 8 * i) = R.kk[i]; *(LAS u32x4*)(Qs + c * 136 + part * 32 + 8 * i) = R.qq[i]; *(LAS u32x4*)(Vs + c * 136 + part * 32 + 8 * i) = R.vv[i]; }
    }
    if (npair >= 0) prep_load(R, ws_c, npair, tid, wave, lane);
    __syncthreads();
    {
        const int nt = wl;
        bf16x8 sf[4];
#pragma unroll
        for (int ks = 0; ks < 4; ++ks) sf[ks] = *(const LAS bf16x8*)(Ks + (16 * nt + fr) * 136 + 8 * fq + 32 * ks);
        f32x4 sgs;
#pragma unroll
        for (int j = 0; j < 4; ++j) sgs[j] = sg[16 * nt + 4 * fq + j];
        for (int mt = 0; mt < 4; ++mt) {
            const int cc = 16 * mt + fr; const float gc = sg[cc], bc = sb[cc];
            f32x4 ak = {0.f, 0.f, 0.f, 0.f}, aq = {0.f, 0.f, 0.f, 0.f};
            if (nt <= mt) {
                const LAS bf16_t* Kp = Ks + cc * 136 + 8 * fq; const LAS bf16_t* Qp = Qs + cc * 136 + 8 * fq;
#pragma unroll
                for (int ks = 0; ks < 4; ++ks) { ak = mfma16(sf[ks], *(const LAS bf16x8*)(Kp + 32 * ks), ak); aq = mfma16(sf[ks], *(const LAS bf16x8*)(Qp + 32 * ks), aq); }
            }
            f32x4 ok, oq;
#pragma unroll
            for (int j = 0; j < 4; ++j) { const int s_ = 16 * nt + 4 * fq + j; const float e_ = __expf(fminf(gc - sgs[j], 0.f));
                ok[j] = (s_ < cc) ? bc * ak[j] * e_ : 0.f; oq[j] = (s_ <= cc) ? aq[j] * e_ : 0.f; }
            if (nt <= mt) { LAS float* ap = Akk + (16 * nt + 4 * fq) * 64 + cc;
                ap[0] = ok[0]; ap[64] = ok[1]; ap[128] = ok[2]; ap[192] = ok[3]; }
            u32x2 w; w.x = pk2(oq[0], oq[1]); w.y = pk2(oq[2], oq[3]); *(u32x2*)(Ag + (size_t)item * 4096 + cc * 64 + 16 * nt + 4 * fq) = w;
        }
    }
    __syncthreads();
    {
        int zoff = 0; asm volatile("" : "+v"(zoff));
        const LAS float* Akz = Akk + zoff;
        LAS float* Tl = (LAS float*)(base + 51200);
        LAS float* Xs = (LAS float*)(lds + 2 * PREP_SET + grp * 4096);
        LAS float* Dl = (LAS float*)(lds + 2 * PREP_SET + 8192 + grp * 4096);
        {   float Y[16];
#pragma unroll
            for (int r = 0; r < 16; ++r) Y[r] = (lane == r) ? 1.f : 0.f;
#pragma unroll
            for (int jj = 0; jj < 16; ++jj) {
                const float t = Y[jj]; if (lane < 16) Dl[(wl * 16 + jj) * 16 + lane] = t;
                if (jj < 15) { const LAS float* ar = Akz + (16 * wl + jj) * 64 + 16 * wl;
#pragma unroll
                    for (int r4 = (jj + 1) / 4; r4 < 4; ++r4) { const f32x4 av = *(const LAS f32x4*)(ar + 4 * r4);
#pragma unroll
                        for (int e = 0; e < 4; ++e) { if (4 * r4 + e > jj) fnma(Y[4 * r4 + e], av[e], t); } } }
            }
        }
        __syncthreads();
        const LAS float* Dz = Dl + zoff;
        for (int P = 0; P < 4; ++P) {
            float X[4];
#pragma unroll
            for (int e = 0; e < 4; ++e) X[e] = (lane == 16 * P + 4 * wl + e) ? 1.f : 0.f;
            const int nj = 16 * P;
            if (nj > 0) {
                float tj = Tl[lane]; f32x4 a0 = *(const LAS f32x4*)(Akz + 16 * P + 4 * wl);
                for (int j = 0; j < nj; ++j) {
                    const int jn = (j + 1 < nj) ? j + 1 : j;
                    const float tn = Tl[jn * 64 + lane]; const f32x4 n0 = *(const LAS f32x4*)(Akz + jn * 64 + 16 * P + 4 * wl);
#pragma unroll
                    for (int e = 0; e < 4; ++e) fnma(X[e], a0[e], tj);
                    tj = tn; a0 = n0;
                }
            }
#pragma unroll
            for (int e = 0; e < 4; ++e) Xs[(4 * wl + e) * 64 + lane] = X[e];
            __syncthreads();
            {   float Tn[4] = {0.f, 0.f, 0.f, 0.f}; float xk[16]; f32x4 dv[4][4];
#pragma unroll
                for (int k = 0; k < 16; ++k) xk[k] = Xs[k * 64 + lane];
#pragma unroll
                for (int e = 0; e < 4; ++e)
#pragma unroll
                    for (int k4 = 0; k4 < 4; ++k4) dv[e][k4] = *(const LAS f32x4*)(Dz + (P * 16 + 4 * wl + e) * 16 + 4 * k4);
#pragma unroll
                for (int k = 0; k < 16; ++k)
#pragma unroll
                    for (int e = 0; e < 4; ++e) fpma(Tn[e], dv[e][k >> 2][k & 3], xk[k]);
#pragma unroll
                for (int e = 0; e < 4; ++e) Tl[(16 * P + 4 * wl + e) * 64 + lane] = Tn[e];
            }
            __syncthreads();
        }
        const float c1 = sb[lane], c2 = -c1 * seg[lane];
        float Tc[16];
#pragma unroll
        for (int i = 0; i < 16; ++i) Tc[i] = Tl[(16 * wl + i) * 64 + lane];
        __syncthreads();
#pragma unroll
        for (int i = 0; i < 16; ++i) { const unsigned w = pk2(Tc[i] * c1, Tc[i] * c2); Tb1[(16 * wl + i) * 72 + lane] = (bf16_t)(w & 0xffffu); Tb2[(16 * wl + i) * 72 + lane] = (bf16_t)(w >> 16); }
    }
    __syncthreads();
    { int l2 = threadIdx.x; asm volatile("" : "+v"(l2)); lane = l2 & 63; }
    const int fr2 = lane & 15, fq2 = lane >> 4;
#define fr fr2
#define fq fq2
    for (int i2 = 0; i2 < 8; ++i2) {
        const int which = i2 >> 2, mt = i2 & 3;
        const LAS bf16_t* Tp = (which ? Tb2 : Tb1) + (16 * mt + fr) * 72 + 8 * fq;
        const LAS bf16_t* Xa = (which ? Ks : Vs) + (8 * fq + (fr >> 2)) * 136 + 16 * wl + 4 * (fr & 3); const LAS bf16_t* Xb = Xa + 64;
        const bf16x8 t0 = *(const LAS bf16x8*)Tp;
        f32x4 acca = mfma16(cat4(tr_read(Xa), tr_read(Xa + 4 * 136)), t0, (f32x4){0.f, 0.f, 0.f, 0.f});
        f32x4 accb = mfma16(cat4(tr_read(Xb), tr_read(Xb + 4 * 136)), t0, (f32x4){0.f, 0.f, 0.f, 0.f});
        if (mt >= 2) { const bf16x8 t1 = *(const LAS bf16x8*)(Tp + 32);
            acca = mfma16(cat4(tr_read(Xa + 32 * 136), tr_read(Xa + 36 * 136)), t1, acca);
            accb = mfma16(cat4(tr_read(Xb + 32 * 136), tr_read(Xb + 36 * 136)), t1, accb); }
        bf16_t* dst = (which ? Wg : Ug) + ((size_t)item * 64 + 16 * mt + fr) * 128 + 16 * wl + 4 * fq;
        u32x2 wa, wb; wa.x = pk2(acca[0], acca[1]); wa.y = pk2(acca[2], acca[3]); wb.x = pk2(accb[0], accb[1]); wb.y = pk2(accb[2], accb[3]);
        *(u32x2*)dst = wa; *(u32x2*)(dst + 64) = wb;
    }
#undef fr
#undef fq
}

constexpr int SC4_BUF = 71168;
DI void scan_item(const unsigned char* ws_c, unsigned char* ws, LAS unsigned char* lds, int dirbh, int half, int tid, int wave, int lane) {
    const bf16_t* Qc = (const bf16_t*)(ws_c + OFF_QC); const bf16_t* Kc = (const bf16_t*)(ws_c + OFF_KC);
    const bf16_t* Wg = (const bf16_t*)(ws_c + OFF_W); const bf16_t* Ug = (const bf16_t*)(ws_c + OFF_U); const bf16_t* Ag = (const bf16_t*)(ws_c + OFF_A);
    const f32x2* GC = (const f32x2*)(ws_c + OFF_GC);
    const int dir = dirbh >> 4, b = (dirbh >> 3) & 1, h = dirbh & 7, e0 = 64 * half + 16 * (wave & 3), el = 16 * (wave & 3), fr = lane & 15, fq = lane >> 4;
    bf16_t* Og = (bf16_t*)(ws + (dir ? OFF_OB : OFF_OF));
    struct Stg { u32x4 w0, w1, q0, q1, k0, k1, a, u; f32x2 g; };
#define SC_LOAD(R, vt, nn) do { const int row = (vt) >> 3, s8 = (vt) & 7, row2 = (vt) >> 1, hf = (vt) & 1; const size_t ci = (size_t)dirbh * 128 + (nn); \
        const bf16_t* wsrc = Wg + (ci * 64 + row) * 128 + s8 * 16; R.w0 = *(const u32x4*)wsrc; R.w1 = *(const u32x4*)(wsrc + 8); \
        const size_t tok = (size_t)b * L + (dir ? (L - 1 - 64 * (nn) - row) : (64 * (nn) + row)); const size_t go = tok * 1024 + h * 128 + s8 * 16; \
        R.q0 = *(const u32x4*)(Qc + go); R.q1 = *(const u32x4*)(Qc + go + 8); R.k0 = *(const u32x4*)(Kc + go); R.k1 = *(const u32x4*)(Kc + go + 8); \
        R.a = *(const u32x4*)(Ag + (ci * 64 + row) * 64 + s8 * 8); \
        R.u = *(const u32x4*)(Ug + (ci * 64 + row) * 128 + 64 * half + s8 * 8); \
        if ((vt) < 64) R.g = GC[(size_t)dirbh * 8192 + 64 * (nn) + (vt)]; } while (0)
#define SC_STORE(R, vt, bufp) do { const int row = (vt) >> 3, s8 = (vt) & 7, row2 = (vt) >> 1, hf = (vt) & 1; \
        LAS bf16_t* Wl_ = (LAS bf16_t*)(bufp); LAS bf16_t* Ql_ = Wl_ + 64 * 136; LAS bf16_t* Kl_ = Ql_ + 64 * 136; LAS bf16_t* Al_ = Kl_ + 64 * 136; LAS bf16_t* Ul_ = Al_ + 64 * 72; LAS float* EG_ = (LAS float*)(Ul_ + 64 * 72); \
        *(LAS u32x4*)(Wl_ + row * 136 + s8 * 16) = R.w0; *(LAS u32x4*)(Wl_ + row * 136 + s8 * 16 + 8) = R.w1; \
        *(LAS u32x4*)(Ql_ + row * 136 + s8 * 16) = R.q0; *(LAS u32x4*)(Ql_ + row * 136 + s8 * 16 + 8) = R.q1; \
        *(LAS u32x4*)(Kl_ + row * 136 + s8 * 16) = R.k0; *(LAS u32x4*)(Kl_ + row * 136 + s8 * 16 + 8) = R.k1; \
        *(LAS u32x4*)(Al_ + row * 72 + s8 * 8) = R.a; \
        *(LAS u32x4*)(Ul_ + row * 72 + s8 * 8) = R.u; \
        if ((vt) < 64) { EG_[(vt)] = R.g[0]; EG_[64 + (vt)] = R.g[1]; } } while (0)
    __syncthreads();
    { Stg R; R.u = (u32x4){0u, 0u, 0u, 0u}; R.g = (f32x2){0.f, 0.f}; SC_LOAD(R, tid, 0); SC_STORE(R, tid, lds); }
    __syncthreads();
    if (wave >= 4) {
        const int v0 = tid - 256, v1 = tid; const bool two = true;
        Stg R0, R1; R0.u = (u32x4){0u, 0u, 0u, 0u}; R0.g = (f32x2){0.f, 0.f}; R1 = R0;
        SC_LOAD(R0, v0, 1); if (two) SC_LOAD(R1, v1, 1);
        for (int n = 0; n < 128; ++n) {
            LAS unsigned char* nxt = lds + ((n + 1) & 1) * SC4_BUF;
            if (n + 1 < 128) { SC_STORE(R0, v0, nxt); if (two) SC_STORE(R1, v1, nxt); }
            if (n + 2 < 128) { SC_LOAD(R0, v0, n + 2); if (two) SC_LOAD(R1, v1, n + 2); }
            __syncthreads();
        }
    } else {
    f32x4 S[8];
#pragma unroll
    for (int i = 0; i < 8; ++i) S[i] = (f32x4){0.f, 0.f, 0.f, 0.f};
    for (int n = 0; n < 128; ++n) {
        LAS unsigned char* cur = lds + (n & 1) * SC4_BUF;
        {
            const LAS bf16_t* Wl = (const LAS bf16_t*)cur; const LAS bf16_t* Ql = Wl + 64 * 136; const LAS bf16_t* Kl = Ql + 64 * 136; const LAS bf16_t* Al = Kl + 64 * 136; const LAS bf16_t* Ul = Al + 64 * 72;
            const LAS float* EG = (const LAS float*)(Ul + 64 * 72); const LAS float* DG = EG + 64;
            bf16x8 Sb[4];
#pragma unroll
            for (int ks = 0; ks < 4; ++ks) Sb[ks] = pack8(S[2 * ks], S[2 * ks + 1]);
            f32x4 vn[4], oq[4], oa[4];
#pragma unroll
            for (int mt = 0; mt < 4; ++mt) {
#pragma unroll
                for (int j = 0; j < 4; ++j) vn[mt][j] = bf2f(Ul[(16 * mt + 4 * fq + j) * 72 + el + fr]);
                oq[mt] = (f32x4){0.f, 0.f, 0.f, 0.f}; oa[mt] = (f32x4){0.f, 0.f, 0.f, 0.f};
#pragma unroll
                for (int ks = 0; ks < 4; ++ks) { const LAS bf16_t* wp = Wl + (16 * mt + fr) * 136 + 32 * ks + 4 * fq; const LAS bf16_t* qp = Ql + (16 * mt + fr) * 136 + 32 * ks + 4 * fq;
                    vn[mt] = mfma16(cat4(*(const LAS s16x4*)wp, *(const LAS s16x4*)(wp + 16)), Sb[ks], vn[mt]);
                    oq[mt] = mfma16(Sb[ks], cat4(*(const LAS s16x4*)qp, *(const LAS s16x4*)(qp + 16)), oq[mt]); }
            }
            bf16x8 vb[2], vpb[2];
#pragma unroll
            for (int k2 = 0; k2 < 2; ++k2) { vb[k2] = pack8(vn[2 * k2], vn[2 * k2 + 1]);
                f32x4 a = vn[2 * k2], bb = vn[2 * k2 + 1];
#pragma unroll
                for (int j = 0; j < 4; ++j) { a[j] *= DG[32 * k2 + 4 * fq + j]; bb[j] *= DG[32 * k2 + 16 + 4 * fq + j]; }
                vpb[k2] = pack8(a, bb); }
#pragma unroll
            for (int mt = 0; mt < 4; ++mt)
#pragma unroll
                for (int k2 = 0; k2 < 2; ++k2) { if (k2 == 0 || mt >= 2) { const LAS bf16_t* ap = Al + (16 * mt + fr) * 72 + 32 * k2 + 4 * fq;
                    oa[mt] = mfma16(vb[k2], cat4(*(const LAS s16x4*)ap, *(const LAS s16x4*)(ap + 16)), oa[mt]); } }
#pragma unroll
            for (int mt = 0; mt < 4; ++mt) { const int cc = 16 * mt + fr; const size_t tok = (size_t)b * L + (dir ? (L - 1 - 64 * n - cc) : (64 * n + cc));
                const float eg = EG[cc]; u32x2 w; w.x = pk2(eg * oq[mt][0] + oa[mt][0], eg * oq[mt][1] + oa[mt][1]); w.y = pk2(eg * oq[mt][2] + oa[mt][2], eg * oq[mt][3] + oa[mt][3]);
                *(u32x2*)(Og + tok * 1024 + h * 128 + e0 + 4 * fq) = w; }
            const float egl = EG[63];
#pragma unroll
            for (int dt = 0; dt < 8; ++dt) { S[dt] *= egl;
#pragma unroll
                for (int k2 = 0; k2 < 2; ++k2) { const LAS bf16_t* kp = Kl + (32 * k2 + 4 * fq + (fr >> 2)) * 136 + 16 * dt + 4 * (fr & 3);
                    S[dt] = mfma16(cat4(tr_read(kp), tr_read(kp + 16 * 136)), vpb[k2], S[dt]); } }
        }
        __syncthreads();
    }
    }
#undef SC_LOAD
#undef SC_STORE
}

DI void phase_gated_norm(const bf16_t* OF, const bf16_t* OB, const bf16_t* Z, const float* nw, bf16_t* Y, int wave, int lane) {
    const int gw = blockIdx.x * 8 + wave, NGW = gridDim.x * 8;
    for (int tk = gw; tk < T; tk += NGW) {
        const size_t o = (size_t)tk * 1024 + lane * 16;
        const u32x4 f0 = *(const u32x4*)(OF + o), f1 = *(const u32x4*)(OF + o + 8), b0 = *(const u32x4*)(OB + o), b1 = *(const u32x4*)(OB + o + 8), z0 = *(const u32x4*)(Z + o), z1 = *(const u32x4*)(Z + o + 8);
        const unsigned fw[8] = {f0.x, f0.y, f0.z, f0.w, f1.x, f1.y, f1.z, f1.w}, bw[8] = {b0.x, b0.y, b0.z, b0.w, b1.x, b1.y, b1.z, b1.w}, zw[8] = {z0.x, z0.y, z0.z, z0.w, z1.x, z1.y, z1.z, z1.w};
        float v[16]; float ss = 0.f;
#pragma unroll
        for (int i = 0; i < 8; ++i) { v[2 * i] = bflo(fw[i]) + bflo(bw[i]); v[2 * i + 1] = bfhi(fw[i]) + bfhi(bw[i]); ss += v[2 * i] * v[2 * i] + v[2 * i + 1] * v[2 * i + 1]; }
        ss += __shfl_xor(ss, 1); ss += __shfl_xor(ss, 2); ss += __shfl_xor(ss, 4);
        const float rstd = rsqrtf(ss * (1.f / 128.f) + EPS);
        const float* wp = nw + (lane & 7) * 16;
        unsigned ow[8];
#pragma unroll
        for (int i = 0; i < 8; ++i) ow[i] = pk2(v[2 * i] * rstd * wp[2 * i] * bflo(zw[i]), v[2 * i + 1] * rstd * wp[2 * i + 1] * bfhi(zw[i]));
        u32x4 o0 = {ow[0], ow[1], ow[2], ow[3]}, o1 = {ow[4], ow[5], ow[6], ow[7]};
        *(u32x4*)(Y + o) = o0; *(u32x4*)(Y + o + 8) = o1;
    }
}

#define XB_TMO      128
#define XB_XCNT(j)  (256  + 64 * (j))
#define XB_XSUB(j)  (1280 + 64 * (j))
#define XB_XGEN(j)  (2304 + 64 * (j))
#define XB_TOP      3328
#define XB_TOPGEN   3392
#define XCD_BAR_WORDS 3456
#define XB_SPIN_CAP (1u << 18)

__device__ __forceinline__ unsigned xb_ld(unsigned* p)              { return __hip_atomic_load(p, __ATOMIC_RELAXED, __HIP_MEMORY_SCOPE_AGENT); }
__device__ __forceinline__ unsigned xb_add(unsigned* p, unsigned v) { return __hip_atomic_fetch_add(p, v, __ATOMIC_RELAXED, __HIP_MEMORY_SCOPE_AGENT); }
__device__ __forceinline__ unsigned xb_xcc_id() { return (unsigned)__builtin_amdgcn_s_getreg((3 << 11) | 20) & 0xFu; }
#define XB_SPIN(cond, bar) do { unsigned _sp = 0; while (cond) { __builtin_amdgcn_s_sleep(1); \
    if ((++_sp & 255u) == 0u) { if (xb_ld(&(bar)[XB_TMO])) break; if (_sp > XB_SPIN_CAP) { atomicAdd(&(bar)[XB_TMO], 1u); break; } } } } while (0)

struct XcdBarrier {
    unsigned* bar; unsigned x;
    volatile LAS unsigned* st;
};

__device__ __forceinline__ XcdBarrier xcd_barrier_post(unsigned* bar, volatile LAS unsigned* st) {
    XcdBarrier b; b.bar = bar; b.x = xb_xcc_id(); b.st = st;
    if (threadIdx.x == 0) (void)xb_add(&bar[XB_XCNT(b.x)], 1u);
    return b;
}
__device__ __forceinline__ void xcd_barrier_complete(unsigned* bar, unsigned x, unsigned& nloc, unsigned& nx) {
    const unsigned G = gridDim.x * gridDim.y * gridDim.z;
    unsigned sum, cnt, mine, sp = 0u;
    for (;;) {
        sum = 0u; cnt = 0u; mine = 0u;
#pragma unroll
        for (unsigned j = 0; j < 16; ++j) { const unsigned c = xb_ld(&bar[XB_XCNT(j)]); sum += c; cnt += (c > 0u) ? 1u : 0u; mine = (j == x) ? c : mine; }
        if (sum == G) break;
        __builtin_amdgcn_s_sleep(1);
        if ((++sp & 255u) == 0u) { if (xb_ld(&bar[XB_TMO])) break; if (sp > XB_SPIN_CAP) { atomicAdd(&bar[XB_TMO], 1u); break; } }
    }
    nloc = mine > 0u ? mine : 1u; nx = cnt > 0u ? cnt : 1u;
}

__device__ __forceinline__ void xcd_barrier(const XcdBarrier& b) {
    asm volatile("s_waitcnt vmcnt(0)" ::: "memory");
    __syncthreads();
    if (threadIdx.x == 0) {
        unsigned* bar = b.bar;
        __builtin_amdgcn_s_waitcnt(0);
        unsigned nloc = b.st[0], nx = b.st[1];
        if (nloc == 0u) { xcd_barrier_complete(bar, b.x, nloc, nx); b.st[0] = nloc; b.st[1] = nx; }
        const unsigned old = xb_add(&bar[XB_XSUB(b.x)], 1u);
        const unsigned gen = old / nloc;
        if (old + 1u == (gen + 1u) * nloc) {
            __builtin_amdgcn_fence(__ATOMIC_RELEASE, "agent");
            asm volatile("s_waitcnt vmcnt(0)" ::: "memory");
            const unsigned og = xb_add(&bar[XB_TOP], 1u);
            const unsigned tg = og / nx;
            if (og + 1u == (tg + 1u) * nx) xb_add(&bar[XB_TOPGEN], 1u);
            else XB_SPIN(xb_ld(&bar[XB_TOPGEN]) == tg, bar);
            __builtin_amdgcn_fence(__ATOMIC_ACQUIRE, "agent");
            xb_add(&bar[XB_XGEN(b.x)], 1u);
            asm volatile("s_waitcnt vmcnt(0)" ::: "memory");
        } else {
            XB_SPIN(xb_ld(&bar[XB_XGEN(b.x)]) == gen, bar);
            __builtin_amdgcn_fence(__ATOMIC_ACQUIRE, "agent");
            asm volatile("s_waitcnt vmcnt(0)" ::: "memory");
        }
    }
    __syncthreads();
}


struct SplitOrder {
    int nM, nN, G, c, lim;
    __device__ bool next(int i, pg8::Unit& u) const {
        const long Lx = (long)i * G + c; if (Lx >= lim) return false;
        const int wgid = (int)Lx; const int nig = pg8::WGM * nN, gid = wgid / nig, fm = gid * pg8::WGM, gsz = (nM - fm) < pg8::WGM ? (nM - fm) : pg8::WGM;
        u.pm = fm + ((wgid % nig) % gsz); u.pn = (wgid % nig) / gsz; return true;
    }
    __device__ __forceinline__ void a_ready(const pg8::Unit&) const {}
    __device__ __forceinline__ void done(const pg8::Unit&) const {}
};
struct EpiSig2 {
    static constexpr bool PERM = true, AFTER_DRAIN = false;
    bf16_t* O1; bf16_t* O2;
    DI void operator()(EPI_ARGS) const {
        bf16_t* O = (u.pn < 8 ? O1 : O2) + (u.pn & 7) * 256;
        EPI_BEGIN
#pragma unroll
            for (int i = 0; i < 4; ++i) { v0[i] = sigmoidf_(v0[i]); v1[i] = sigmoidf_(v1[i]); }
            *(u32x4*)(O + (size_t)r * 2048 + cl) = pack_row8(v0, v1);
        EPI_END
    }
};
constexpr bool GEMM_ALIGN = true, GEMM_SP2 = true;
template <class Epi> DI void run_gemm(LAS unsigned char* lds, const bf16_t* A, const bf16_t* Bt, int N, int K, const Epi& E) {
    pg8::Gemm g{A, Bt, T, N, K}; pg8::StaticOrder S; S.init(T, N, (int)gridDim.x, (int)blockIdx.x);
    pg8::gemm_phase<Epi, pg8::StaticOrder, GEMM_ALIGN, GEMM_SP2>(lds, g, S, E);
}

#define REP_P0 1
#define REP_P1 1
#define REP_P3 1
#define REP_P6 1
#define REP_P9 1
#define REP_ATT 1
#define REP_PREP 1
#define REP_SCAN 1
__global__ void __launch_bounds__(512, 2) hybrid_fwd(Params p) {
    extern __shared__ __attribute__((aligned(16))) unsigned char lds_raw[];
    LAS unsigned char* lds = (LAS unsigned char*)lds_raw;
    cg::grid_group grid = cg::this_grid();
    int tid, lane, wave;
#define FRESH_IDS() do { int t_ = threadIdx.x; asm volatile("" : "+v"(t_)); tid = t_; lane = t_ & 63; wave = __builtin_amdgcn_readfirstlane(t_ >> 6); } while (0)
    FRESH_IDS();
    unsigned char* ws = p.ws;
    const float* MOD = (const float*)(ws + OFF_MOD);

    volatile LAS unsigned* xst = (volatile LAS unsigned*)(lds + LDS_BYTES - 16);
    if (tid < 2) xst[tid] = 0u;
    if (blockIdx.x == 0) { for (int i = tid; i < 4096; i += 512) __hip_atomic_store((unsigned*)ws + i, 0u, __ATOMIC_RELAXED, __HIP_MEMORY_SCOPE_AGENT); }
    for (int rep = 0; rep < REP_P0; ++rep) phase0(p, lds, tid, wave, lane);
    grid.sync(); FRESH_IDS();
    XcdBarrier xbar = xcd_barrier_post((unsigned*)ws, xst);
#define GRID_BAR() do { xcd_barrier(xbar); FRESH_IDS(); } while (0)
    for (int rep = 0; rep < REP_P1; ++rep) phase_modnorm(p.x, p.norm1_w, MOD, 0, 2048, (bf16_t*)(ws + OFF_H), wave, lane);
    GRID_BAR();
    { EpiIn E{(bf16_t*)(ws + OFF_QKV), (bf16_t*)(ws + OFF_Z), (bf16_t*)(ws + OFF_QSW), (bf16_t*)(ws + OFF_KVSW), (float*)(ws + OFF_BA), p.a_log, p.dt_bias};
      run_gemm(lds, (const bf16_t*)(ws + OFF_H), (const bf16_t*)(ws + OFF_WIN) + (size_t)4096 * 2048, 5888, 2048, E); }
    GRID_BAR();
    for (int rep = 0; rep < REP_P3; ++rep) phase_conv((const bf16_t*)(ws + OFF_QKV), p.conv_w, (bf16_t*)(ws + OFF_QC), (bf16_t*)(ws + OFF_KC), (bf16_t*)(ws + OFF_VC), wave, lane);
    phase_swa_normrope((bf16_t*)(ws + OFF_QSW), (bf16_t*)(ws + OFF_KVSW), p.qn_w, p.kn_w, lds, wave, lane);
    GRID_BAR();
    for (int rep = 0; rep < REP_ATT; ++rep) swa_block((const bf16_t*)(ws + OFF_QSW), (const bf16_t*)(ws + OFF_KVSW), p.sink, (bf16_t*)(ws + OFF_YSW), lds, tid, wave, lane);
    { PrepStage R; R.beta = 0.f; R.g = 0.f;
      if (blockIdx.x < 2048) prep_load(R, ws, blockIdx.x, tid, wave, lane);
      for (int it = blockIdx.x; it < 2048; it += gridDim.x) { const int nit = it + (int)gridDim.x; dn_prep_pair(ws, ws, lds, it, nit < 2048 ? nit : -1, R, tid, wave, lane); } }
    GRID_BAR();
    bf16_t* TG1 = (bf16_t*)p.out; bf16_t* TG2 = TG1 + (size_t)T * 2048;
    if (gridDim.x == 256) {
        const int bid = blockIdx.x;
        pg8::Gemm g{(const bf16_t*)(ws + OFF_H), (const bf16_t*)(ws + OFF_WIN), T, 4096, 2048}; EpiSig2 Eg{TG1, TG2};
        if (((bid >> 3) & 3) == 0) {
            for (int rep = 0; rep < REP_SCAN; ++rep) scan_item(ws, ws, lds, (bid >> 6) * 8 + (bid & 7), (bid >> 5) & 1, tid, wave, lane);
        } else {
            const int cv = bid - 8 * ((bid >> 5) + 1);
            SplitOrder S{64, 16, 192, cv, 1024};
            pg8::gemm_phase<EpiSig2, SplitOrder, GEMM_ALIGN, GEMM_SP2>(lds, g, S, Eg);
            asm volatile("s_waitcnt vmcnt(0)" ::: "memory"); __syncthreads();
            if (threadIdx.x == 0) { unsigned* cnt = (unsigned*)ws + 3584;
                __builtin_amdgcn_fence(__ATOMIC_RELEASE, "agent"); asm volatile("s_waitcnt vmcnt(0)" ::: "memory");
                __hip_atomic_fetch_add(cnt, 1u, __ATOMIC_RELAXED, __HIP_MEMORY_SCOPE_AGENT);
                unsigned sp = 0; while (__hip_atomic_load(cnt, __ATOMIC_RELAXED, __HIP_MEMORY_SCOPE_AGENT) < 192u && ++sp < (1u << 24)) __builtin_amdgcn_s_sleep(2);
                __builtin_amdgcn_fence(__ATOMIC_ACQUIRE, "agent"); asm volatile("s_waitcnt vmcnt(0)" ::: "memory"); }
            __syncthreads(); FRESH_IDS();
            { pg8::Gemm gb{(const bf16_t*)(ws + OFF_YSW), (const bf16_t*)(ws + OFF_WSW), T, 2048, 1024}; const SplitOrder Sb = cv < 64 ? SplitOrder{64, 8, 64, 384 + cv, 512} : SplitOrder{64, 8, 128, cv - 64, 384};
              EpiMerge<false> Eb{TG2, nullptr, TG2}; pg8::gemm_phase<EpiMerge<false>, SplitOrder, GEMM_ALIGN, GEMM_SP2>(lds, gb, Sb, Eb); }
        }
    } else {
        for (int d = blockIdx.x; d < 64; d += gridDim.x) scan_item(ws, ws, lds, d >> 1, d & 1, tid, wave, lane);
        { EpiSig Eg{TG1, 2048}; run_gemm(lds, (const bf16_t*)(ws + OFF_H), (const bf16_t*)(ws + OFF_WIN), 2048, 2048, Eg); }
        { EpiSig Eg{TG2, 2048}; run_gemm(lds, (const bf16_t*)(ws + OFF_H), (const bf16_t*)(ws + OFF_WIN) + (size_t)2048 * 2048, 2048, 2048, Eg); }
        { EpiMerge<false> Eb{TG2, nullptr, TG2}; run_gemm(lds, (const bf16_t*)(ws + OFF_YSW), (const bf16_t*)(ws + OFF_WSW), 2048, 1024, Eb); }
    }
    GRID_BAR();
    for (int rep = 0; rep < REP_P6; ++rep) phase_gated_norm((const bf16_t*)(ws + OFF_OF), (const bf16_t*)(ws + OFF_OB), (const bf16_t*)(ws + OFF_Z), p.dn_norm_w, (bf16_t*)(ws + OFF_YDN), wave, lane);
    GRID_BAR();
    { EpiMerge<true> Ea{TG1, TG2, (bf16_t*)(ws + OFF_MRG)};
      run_gemm(lds, (const bf16_t*)(ws + OFF_YDN), (const bf16_t*)(ws + OFF_WDN), 2048, 1024, Ea); }
    GRID_BAR();
    { EpiRes E{p.x, MOD + 4096, p.out};
      run_gemm(lds, (const bf16_t*)(ws + OFF_MRG), (const bf16_t*)(ws + OFF_WOUT), 2048, 2048, E); }
    GRID_BAR();
    for (int rep = 0; rep < REP_P9; ++rep) { phase_modnorm(p.out, p.norm2_w, MOD, 6144, 8192, (bf16_t*)(ws + OFF_H), wave, lane);
    phase_mlp_weights(p, lds, wave, lane); }
    GRID_BAR();
    { EpiRelu2 E{(bf16_t*)(ws + OFF_UU), 8192};
      run_gemm(lds, (const bf16_t*)(ws + OFF_H), (const bf16_t*)(ws + OFF_WMI), 8192, 2048, E); }
    GRID_BAR();
    { EpiRes E{p.out, MOD + 10240, p.out};
      run_gemm(lds, (const bf16_t*)(ws + OFF_UU), (const bf16_t*)(ws + OFF_WMO), 2048, 8192, E); }
}

extern "C" void kernel_launch(void* const* d_in, const int* in_sizes, int n_in, void* d_out, int out_size, void* d_ws, size_t ws_size, hipStream_t stream) {
    static int grid_blocks = 0;
    if (grid_blocks == 0) {
        if (n_in != 19 || out_size != T * D || ws_size < WS_END) { fprintf(stderr, "kernel_launch: unexpected shapes (n_in %d out %d ws %zu)\n", n_in, out_size, ws_size); grid_blocks = -1; return; }
        int dev = 0, cus = 0, per_cu = 0;
        hipGetDevice(&dev); hipDeviceGetAttribute(&cus, hipDeviceAttributeMultiprocessorCount, dev);
        hipFuncSetAttribute((const void*)hybrid_fwd, hipFuncAttributeMaxDynamicSharedMemorySize, LDS_BYTES);
        hipOccupancyMaxActiveBlocksPerMultiprocessor(&per_cu, (const void*)hybrid_fwd, 512, LDS_BYTES);
        if (per_cu < 1) { fprintf(stderr, "kernel_launch: occupancy query says %d blocks/CU\n", per_cu); per_cu = 1; }
        (void)hipGetLastError();
        grid_blocks = cus * per_cu;
    }
    if (grid_blocks < 0) return;
    Params p{};
    p.x = (const float*)d_in[0]; p.c = (const float*)d_in[1]; p.w_ada = (const float*)d_in[2]; p.b_ada = (const float*)d_in[3]; p.norm1_w = (const float*)d_in[4];
    p.w_in = (const float*)d_in[5]; p.conv_w = (const float*)d_in[6]; p.a_log = (const float*)d_in[7]; p.dt_bias = (const float*)d_in[8]; p.dn_norm_w = (const float*)d_in[9];
    p.w_dn = (const float*)d_in[10]; p.qn_w = (const float*)d_in[11]; p.kn_w = (const float*)d_in[12]; p.sink = (const float*)d_in[13]; p.w_sw = (const float*)d_in[14];
    p.w_out = (const float*)d_in[15]; p.norm2_w = (const float*)d_in[16]; p.w_mi = (const float*)d_in[17]; p.w_mo = (const float*)d_in[18];
    p.out = (float*)d_out; p.ws = (unsigned char*)d_ws;
    void* args[] = {&p};
    hipError_t e = hipLaunchCooperativeKernel((const void*)hybrid_fwd, dim3(grid_blocks), dim3(512), args, LDS_BYTES, stream);
    if (e != hipSuccess) fprintf(stderr, "cooperative launch failed: %s (grid %d)\n", hipGetErrorString(e), grid_blocks);
}
```

```cpp
#include <hip/hip_runtime.h>
#include <hip/hip_cooperative_groups.h>
#include <cstdio>
#include <cstdint>
namespace cg = cooperative_groups;

namespace pg8 {
#define PG8_LAS __attribute__((address_space(3)))
typedef unsigned short bf16_t;
typedef short bf16x8 __attribute__((ext_vector_type(8)));
typedef float f32x4 __attribute__((ext_vector_type(4)));
typedef unsigned u32x4 __attribute__((ext_vector_type(4)));
constexpr int BM = 256, BK = 64, HALF = 128, HTB = HALF * BK * 2  , STAGE_BYTES = 8 * HTB, NXCD = 8, WGM = 4;

__host__ __device__ __forceinline__ int lds_byte(int r, int c) { const int st = (r >> 4) * 2 + (c >> 5), rr = r & 15, cc = c & 31, ob = rr * 64 + cc * 2; return st * 1024 + (ob ^ (((ob >> 9) & 1) << 5)); }
__host__ __device__ __forceinline__ void stage_rc(int b, int& R, int& C) { const int st = b / 1024, sb = b % 1024, swz = sb ^ (((sb >> 9) & 1) << 5); R = (st >> 1) * 16 + swz / 64; C = (st & 1) * 32 + (swz % 64) / 2; }
__host__ __device__ __forceinline__ int perm32(int rho) { const int n = rho >> 4, i = rho & 15; return 8 * (i >> 2) + 4 * n + (i & 3); }

struct Unit { int pm, pn; };
struct Gemm { const bf16_t* A; const bf16_t* Bt; int M, N, K; };

struct StaticOrder {
    int nM, nN, nwg, G, c;
    __host__ __device__ void init(int M, int N, int G_, int c_) { nM = M / BM; nN = N / BM; nwg = nM * nN; G = G_; c = c_; }
    __host__ __device__ bool next(int i, Unit& u) const {
        const long L = (long)i * G + c; if (L >= nwg) return false;
        int wgid = (int)L; { const int q = nwg / NXCD, r = nwg % NXCD, xcd = wgid % NXCD, off = wgid / NXCD; wgid = (xcd < r ? xcd * (q + 1) : r * (q + 1) + (xcd - r) * q) + off; }
        const int nig = WGM * nN, gid = wgid / nig, fm = gid * WGM, gsz = (nM - fm) < WGM ? (nM - fm) : WGM;
        u.pm = fm + ((wgid % nig) % gsz); u.pn = (wgid % nig) / gsz; return true;
    }
    __device__ __forceinline__ void a_ready(const Unit&) const {}
    __device__ __forceinline__ void done(const Unit&) const {}
};
typedef float f32x2v __attribute__((ext_vector_type(2)));
typedef __bf16 bf16x2v __attribute__((ext_vector_type(2)));
__device__ __forceinline__ unsigned cvt_pk_bf16(float lo, float hi) { const f32x2v v = {lo, hi}; return __builtin_bit_cast(unsigned, __builtin_convertvector(v, bf16x2v)); }

template <class Epi, class Sched, bool ALIGN_EPI = false, bool SP2 = false>
__device__ __forceinline__ void gemm_phase(PG8_LAS unsigned char* lds, const Gemm g, const Sched& S, const Epi& E) {
    int tid_l = threadIdx.x; asm volatile("" : "+v"(tid_l));
    const int tid = tid_l, wid = __builtin_amdgcn_readfirstlane(tid >> 6), lane = tid & 63, wr = wid >> 2, wc = wid & 3, fr = lane & 15, fq = lane >> 4;
    const int K = g.K, nt = K / BK;
    unsigned voffA[2], voffB[2];
#pragma unroll
    for (int i = 0; i < 2; ++i) { int R, C; stage_rc(tid * 16 + i * 8192, R, C); const int Rb = Epi::PERM ? ((R & ~31) + perm32(R & 31)) : R;
        voffA[i] = (unsigned)(R * K + C) * 2u; voffB[i] = (unsigned)(Rb * K + C) * 2u; }
    const size_t kstep = (size_t)(BK * 2);
    const size_t hstep = (size_t)HALF * K * 2;
    const size_t tstep = 2 * hstep;
    const unsigned ldsw = (unsigned)wid * 1024u;
    const int aoff = lds_byte(wr * 64 + fr, fq * 8), boff = lds_byte(wc * 32 + fr, fq * 8);
#define PG8_SA(b, h) (((b) * 2 + (h)) * HTB)
#define PG8_SB(b, h) ((4 + (b) * 2 + (h)) * HTB)
#define PG8_STAGE(bufoff, gbase, voff) do { _Pragma("unroll") for (int _i = 0; _i < 2; ++_i) \
        __builtin_amdgcn_global_load_lds((const unsigned*)((const char*)(gbase) + (voff)[_i]), (PG8_LAS unsigned*)(lds + (bufoff) + ldsw + _i * 8192), 16, 0, 0); } while (0)
#define PG8_LDA(dst, b, h) do { _Pragma("unroll") for (int m = 0; m < 4; ++m) _Pragma("unroll") for (int k = 0; k < 2; ++k) dst[m][k] = *(const PG8_LAS bf16x8*)(lds + PG8_SA(b, h) + aoff + m * 2048 + k * 1024); } while (0)
#define PG8_LDB(dst, b, h) do { _Pragma("unroll") for (int n = 0; n < 2; ++n) _Pragma("unroll") for (int k = 0; k < 2; ++k) dst[n][k] = *(const PG8_LAS bf16x8*)(lds + PG8_SB(b, h) + boff + n * 2048 + k * 1024); } while (0)
#define PG8_MMA(ai, bj, At, Bt) do { __builtin_amdgcn_s_setprio(1); _Pragma("unroll") for (int m = 0; m < 4; ++m) _Pragma("unroll") for (int n = 0; n < 2; ++n) _Pragma("unroll") for (int k = 0; k < 2; ++k) \
        acc[ai][bj][m][n] = __builtin_amdgcn_mfma_f32_16x16x32_bf16(Bt[n][k], At[m][k], acc[ai][bj][m][n], 0, 0, 0); __builtin_amdgcn_s_setprio(0); } while (0)
#define PG8_WAIT_V(n) asm volatile("s_waitcnt vmcnt(" #n ")" ::: "memory")
#define PG8_WAIT_L(n) asm volatile("s_waitcnt lgkmcnt(" #n ")" ::: "memory")
#define PG8_BAR __builtin_amdgcn_s_barrier()
#define PG8_SCHED __builtin_amdgcn_sched_barrier(0)
    Unit cur, nxt; int ui = 0;
    if (!S.next(0, cur)) return;
    f32x4 acc[2][2][4][2];
#pragma unroll
    for (int a = 0; a < 2; ++a)
#pragma unroll
        for (int b = 0; b < 2; ++b)
#pragma unroll
            for (int m = 0; m < 4; ++m)
#pragma unroll
                for (int n = 0; n < 2; ++n) acc[a][b][m][n] = (f32x4){0.f, 0.f, 0.f, 0.f};
    bf16x8 At[4][2], B0[2][2], B1[2][2];
    const char* cA = (const char*)g.A + (size_t)cur.pm * tstep; const char* cB = (const char*)g.Bt + (size_t)cur.pn * tstep;
    S.a_ready(cur);
    if constexpr (SP2) {
        PG8_STAGE(PG8_SB(0, 0), cB, voffB); PG8_STAGE(PG8_SB(0, 1), cB + hstep, voffB); PG8_STAGE(PG8_SA(0, 0), cA, voffA); PG8_STAGE(PG8_SA(0, 1), cA + hstep, voffA);
        if (wr == 1) PG8_BAR;
        PG8_WAIT_V(2); PG8_BAR;
        PG8_STAGE(PG8_SB(1, 0), cB + kstep, voffB); PG8_STAGE(PG8_SA(1, 0), cA + kstep, voffA); PG8_STAGE(PG8_SB(1, 1), cB + hstep + kstep, voffB);
        PG8_WAIT_V(6); PG8_BAR;
    } else {
        PG8_STAGE(PG8_SB(0, 0), cB, voffB); PG8_STAGE(PG8_SA(0, 0), cA, voffA); PG8_STAGE(PG8_SB(0, 1), cB + hstep, voffB); PG8_STAGE(PG8_SA(0, 1), cA + hstep, voffA);
        if (wr == 1) PG8_BAR;
        PG8_WAIT_V(4); PG8_BAR;
        PG8_STAGE(PG8_SB(1, 0), cB + kstep, voffB); PG8_STAGE(PG8_SA(1, 0), cA + kstep, voffA); PG8_STAGE(PG8_SB(1, 1), cB + hstep + kstep, voffB);
        PG8_WAIT_V(6); PG8_BAR;
    }
    for (;;) {
        const bool has_next = S.next(ui + 1, nxt);
        const char* nA = has_next ? (const char*)g.A + (size_t)nxt.pm * tstep : cA; const char* nB = has_next ? (const char*)g.Bt + (size_t)nxt.pn * tstep : cB;
        for (int t = 0; t < nt; t += 2) {
            const bool last = (t == nt - 2);
            const char* a1 = cA + (size_t)(t + 1) * kstep;
            const char* a2 = last ? nA : cA + (size_t)(t + 2) * kstep; const char* b2 = last ? nB : cB + (size_t)(t + 2) * kstep;
            const char* a3 = a2 + kstep; const char* b3 = b2 + kstep;
            if (last && has_next) S.a_ready(nxt);
            if constexpr (SP2) {
            PG8_LDB(B0, 0, 0); PG8_LDB(B1, 0, 1); PG8_SCHED; PG8_LDA(At, 0, 0); PG8_STAGE(PG8_SA(1, 1), a1 + hstep, voffA);
            PG8_WAIT_V(8); PG8_WAIT_L(0); PG8_BAR; PG8_MMA(0, 0, At, B0); PG8_MMA(0, 1, At, B1); PG8_BAR; PG8_SCHED;
            PG8_LDA(At, 0, 1); PG8_STAGE(PG8_SB(0, 0), b2, voffB); PG8_STAGE(PG8_SB(0, 1), b2 + hstep, voffB); PG8_STAGE(PG8_SA(0, 0), a2, voffA);
            PG8_WAIT_V(8); PG8_WAIT_L(0); PG8_BAR; PG8_MMA(1, 0, At, B0); PG8_MMA(1, 1, At, B1); PG8_BAR; PG8_SCHED;
            PG8_LDB(B0, 1, 0); PG8_LDB(B1, 1, 1); PG8_SCHED; PG8_LDA(At, 1, 0); PG8_STAGE(PG8_SA(0, 1), a2 + hstep, voffA);
            PG8_WAIT_V(8); PG8_WAIT_L(0); PG8_BAR; PG8_MMA(0, 0, At, B0); PG8_MMA(0, 1, At, B1); PG8_BAR; PG8_SCHED;
            PG8_LDA(At, 1, 1); PG8_STAGE(PG8_SB(1, 0), b3, voffB); PG8_STAGE(PG8_SB(1, 1), b3 + hstep, voffB); PG8_STAGE(PG8_SA(1, 0), a3, voffA);
            PG8_WAIT_V(8); PG8_WAIT_L(0); PG8_BAR; PG8_MMA(1, 0, At, B0); PG8_MMA(1, 1, At, B1); PG8_BAR; PG8_SCHED;
            } else {
            PG8_LDB(B0, 0, 0); PG8_SCHED; PG8_LDA(At, 0, 0); PG8_STAGE(PG8_SA(1, 1), a1 + hstep, voffA);
            PG8_WAIT_L(8); PG8_BAR; PG8_WAIT_L(0); PG8_MMA(0, 0, At, B0); PG8_BAR; PG8_SCHED;
            PG8_LDB(B1, 0, 1); PG8_STAGE(PG8_SB(0, 0), b2, voffB);
            PG8_BAR; PG8_WAIT_L(0); PG8_MMA(0, 1, At, B1); PG8_BAR;
            PG8_LDA(At, 0, 1); PG8_STAGE(PG8_SA(0, 0), a2, voffA);
            PG8_BAR; PG8_WAIT_L(0); PG8_MMA(1, 0, At, B0); PG8_BAR; PG8_SCHED;
            PG8_STAGE(PG8_SB(0, 1), b2 + hstep, voffB);
            PG8_WAIT_V(6); PG8_BAR; PG8_MMA(1, 1, At, B1); PG8_BAR;
            PG8_LDB(B0, 1, 0); PG8_SCHED; PG8_LDA(At, 1, 0); PG8_STAGE(PG8_SA(0, 1), a2 + hstep, voffA);
            PG8_WAIT_L(8); PG8_BAR; PG8_WAIT_L(0); PG8_MMA(0, 0, At, B0); PG8_BAR; PG8_SCHED;
            PG8_LDB(B1, 1, 1); PG8_STAGE(PG8_SB(1, 0), b3, voffB);
            PG8_BAR; PG8_WAIT_L(0); PG8_MMA(0, 1, At, B1); PG8_BAR;
            PG8_LDA(At, 1, 1); PG8_STAGE(PG8_SA(1, 0), a3, voffA);
            PG8_BAR; PG8_WAIT_L(0); PG8_MMA(1, 0, At, B0); PG8_BAR; PG8_SCHED;
            PG8_STAGE(PG8_SB(1, 1), b3 + hstep, voffB);
            PG8_WAIT_V(6); PG8_BAR; PG8_MMA(1, 1, At, B1); PG8_BAR;
            }
        }
        if constexpr (ALIGN_EPI) { if (wr == 0) PG8_BAR; }
        if constexpr (!Epi::AFTER_DRAIN) { E(acc, cur, wr, wc, fr, fq); S.done(cur); }
        if (!has_next) break;
#pragma unroll
        for (int a = 0; a < 2; ++a)
#pragma unroll
            for (int b = 0; b < 2; ++b)
#pragma unroll
                for (int m = 0; m < 4; ++m)
#pragma unroll
                    for (int n = 0; n < 2; ++n) acc[a][b][m][n] = (f32x4){0.f, 0.f, 0.f, 0.f};
        cur = nxt; cA = nA; cB = nB; ++ui;
        if constexpr (ALIGN_EPI) { if (wr == 1) PG8_BAR; }
    }
    PG8_WAIT_V(0);
    if constexpr (!ALIGN_EPI) { if (wr == 0) PG8_BAR; }
    PG8_BAR;
    if constexpr (Epi::AFTER_DRAIN) { E.fused(acc, cur, wr, wc, fr, fq, lds, wid, lane); S.done(cur); }
#undef PG8_SA
#undef PG8_SB
#undef PG8_STAGE
#undef PG8_LDA
#undef PG8_LDB
#undef PG8_MMA
#undef PG8_WAIT_V
#undef PG8_WAIT_L
#undef PG8_BAR
#undef PG8_SCHED
}
}

#define DI __device__ __forceinline__
#define LAS __attribute__((address_space(3)))
using pg8::bf16_t; using pg8::bf16x8; using pg8::f32x4; using pg8::u32x4;
typedef unsigned u32x2 __attribute__((ext_vector_type(2)));
typedef short s16x4 __attribute__((ext_vector_type(4)));
typedef float f32x2 __attribute__((ext_vector_type(2)));

constexpr int T = 16384, L = 8192, D = 2048;
constexpr float EPS = 1e-6f;
constexpr size_t MiB = 1u << 20;
constexpr size_t OFF_MOD = 65536, OFF_BA = 1 * MiB, OFF_GC = 3 * MiB, OFF_EGL = 5 * MiB,
    OFF_WDN = 8 * MiB, OFF_WSW = 12 * MiB, OFF_WOUT = 16 * MiB, OFF_WIN = 24 * MiB, OFF_H = 64 * MiB, OFF_Z = 128 * MiB, OFF_QSW = 160 * MiB, OFF_KVSW = 192 * MiB,
    OFF_QKV = 208 * MiB, OFF_QC = 304 * MiB, OFF_KC = 336 * MiB, OFF_VC = 368 * MiB, OFF_YSW = 400 * MiB,
    OFF_W = 208 * MiB, OFF_A = 272 * MiB, OFF_U = 432 * MiB, OFF_OF = 368 * MiB, OFF_OB = 160 * MiB, OFF_YDN = 208 * MiB, OFF_TG = 240 * MiB, OFF_MRG = 304 * MiB,
    OFF_WMI = 128 * MiB, OFF_WMO = 160 * MiB, OFF_UU = 208 * MiB, WS_END = 496 * MiB;
constexpr int LDS_BYTES = 160 * 1024;

struct Params {
    const float *x, *c, *w_ada, *b_ada, *norm1_w, *w_in, *conv_w, *a_log, *dt_bias, *dn_norm_w, *w_dn, *qn_w, *kn_w, *sink, *w_sw, *w_out, *norm2_w, *w_mi, *w_mo;
    float* out; unsigned char* ws;
};

DI float bflo(unsigned u) { return __uint_as_float(u << 16); }
DI float bfhi(unsigned u) { return __uint_as_float(u & 0xffff0000u); }
DI float bf2f(unsigned short u) { return __uint_as_float(((unsigned)u) << 16); }
DI unsigned short f2bf(float f) { unsigned u = __float_as_uint(f); return (unsigned short)((u + 0x7fffu + ((u >> 16) & 1u)) >> 16); }
DI unsigned pk2(float lo, float hi) { return pg8::cvt_pk_bf16(lo, hi); }
DI float wave_sum(float v) {
#pragma unroll
    for (int o = 1; o < 64; o <<= 1) v += __shfl_xor(v, o);
    return v;
}
DI float sigmoidf_(float x) { return 1.f / (1.f + __expf(-x)); }
DI float siluf_(float x) { return x / (1.f + __expf(-x)); }
DI f32x4 mfma16(bf16x8 a, bf16x8 b, f32x4 c) { return __builtin_amdgcn_mfma_f32_16x16x32_bf16(a, b, c, 0, 0, 0); }
DI bf16x8 pack8(f32x4 a, f32x4 b) { u32x4 p; p.x = pk2(a[0], a[1]); p.y = pk2(a[2], a[3]); p.z = pk2(b[0], b[1]); p.w = pk2(b[2], b[3]); return __builtin_bit_cast(bf16x8, p); }
DI bf16x8 cat4(s16x4 lo, s16x4 hi) { return __builtin_shufflevector(lo, hi, 0, 1, 2, 3, 4, 5, 6, 7); }
#define LDS_WAIT() asm volatile("s_waitcnt lgkmcnt(0)" ::: "memory")
DI void fpma(float& acc, float a, float t) { asm("v_fma_f32 %0, %1, %2, %0" : "+v"(acc) : "v"(a), "v"(t)); }
DI void fnma(float& acc, float a, float t) { asm("v_fma_f32 %0, -%1, %2, %0" : "+v"(acc) : "v"(a), "v"(t)); }
DI s16x4 tr_read(const LAS bf16_t* p) { return __builtin_amdgcn_ds_read_tr16_b64_v4i16((LAS s16x4*)p); }

DI void transpose_item(const float* W, int K, int N, bf16_t* WT, int k0, int n0, int dst_row0, int ncols, LAS float* scr, int lane) {
    const int sub = lane >> 4, c4 = lane & 15;
    f32x4 v[16];
    if (4 * c4 < ncols) {
#pragma unroll
        for (int i = 0; i < 16; ++i) v[i] = *(const f32x4*)(W + (size_t)(k0 + 4 * i + sub) * N + n0 + 4 * c4);
#pragma unroll
        for (int i = 0; i < 16; ++i) { LAS float* d = scr + (4 * i + sub) * 65 + 4 * c4; d[0] = v[i][0]; d[1] = v[i][1]; d[2] = v[i][2]; d[3] = v[i][3]; }
    }
    LDS_WAIT();
    const int c = lane & 7;
#pragma unroll
    for (int j = 0; j < 8; ++j) { const int n = (lane >> 3) + 8 * j; const LAS float* s = scr + (8 * c) * 65 + n;
        if (n < ncols) { u32x4 o; o.x = pk2(s[0 * 65], s[1 * 65]); o.y = pk2(s[2 * 65], s[3 * 65]); o.z = pk2(s[4 * 65], s[5 * 65]); o.w = pk2(s[6 * 65], s[7 * 65]);
            *(u32x4*)(WT + (size_t)(dst_row0 + n) * K + k0 + 8 * c) = o; } }
    LDS_WAIT();
}
DI void win_tile(int t, int& n0, int& dst, int& ncols) {
    if (t < 64) { n0 = 64 * t; dst = 4096 + n0; ncols = 64; }
    else if (t < 88) { n0 = 4128 + 64 * (t - 64); dst = 8192 + 64 * (t - 64); ncols = 64; }
    else if (t < 152) { n0 = 5664 + 64 * (t - 88); dst = 64 * (t - 88); ncols = 64; }
    else { n0 = 4096; dst = 9728; ncols = 32; }
}

DI void phase0(const Params& p, LAS unsigned char* lds, int tid, int wave, int lane) {
    unsigned char* ws = p.ws;
    if (blockIdx.x < 192) {
        LAS float* sc = (LAS float*)lds; LAS float* red = sc + 4096;
        for (int i = tid; i < 4096; i += 512) sc[i] = siluf_(p.c[i]);
        __syncthreads();
        const int col = blockIdx.x * 64 + lane; float a0 = 0.f, a1 = 0.f;
        const float* wp = p.w_ada + (size_t)(wave * 256) * 12288 + col;
#pragma unroll 32
        for (int k = 0; k < 256; ++k) { const float w = wp[(size_t)k * 12288]; a0 += sc[wave * 256 + k] * w; a1 += sc[2048 + wave * 256 + k] * w; }
        red[(wave * 2 + 0) * 64 + lane] = a0; red[(wave * 2 + 1) * 64 + lane] = a1;
        __syncthreads();
        if (wave < 2) { float s = 0.f;
#pragma unroll
            for (int w = 0; w < 8; ++w) s += red[(w * 2 + wave) * 64 + lane];
            ((float*)(ws + OFF_MOD))[wave * 12288 + col] = s + p.b_ada[col]; }
        __syncthreads();
    }
    LAS float* scr = (LAS float*)(lds + wave * 16640);
    const int gw = blockIdx.x * 8 + wave, NGW = gridDim.x * 8;
    constexpr int I_IN = 32 * 153, I_DN = 16 * 32, I_OUT = 32 * 32;
    for (int it = gw; it < I_IN + 2 * I_DN + I_OUT; it += NGW) {
        int r = it;
        if (r < I_IN) { int n0, dst, nc; win_tile(r % 153, n0, dst, nc); transpose_item(p.w_in, 2048, 9760, (bf16_t*)(ws + OFF_WIN), 64 * (r / 153), n0, dst, nc, scr, lane); continue; } r -= I_IN;
        if (r < I_DN) { transpose_item(p.w_dn, 1024, 2048, (bf16_t*)(ws + OFF_WDN), 64 * (r / 32), 64 * (r % 32), 64 * (r % 32), 64, scr, lane); continue; } r -= I_DN;
        if (r < I_DN) { transpose_item(p.w_sw, 1024, 2048, (bf16_t*)(ws + OFF_WSW), 64 * (r / 32), 64 * (r % 32), 64 * (r % 32), 64, scr, lane); continue; } r -= I_DN;
        transpose_item(p.w_out, 2048, 2048, (bf16_t*)(ws + OFF_WOUT), 64 * (r / 32), 64 * (r % 32), 64 * (r % 32), 64, scr, lane);
    }
    { u32x4* z = (u32x4*)((bf16_t*)(ws + OFF_WIN) + (size_t)9760 * 2048); const u32x4 zero = {0u, 0u, 0u, 0u};
      for (int i = blockIdx.x * 512 + tid; i < 57344; i += gridDim.x * 512) z[i] = zero; }
}
DI void phase_mlp_weights(const Params& p, LAS unsigned char* lds, int wave, int lane) {
    LAS float* scr = (LAS float*)(lds + wave * 16640);
    const int gw = blockIdx.x * 8 + wave, NGW = gridDim.x * 8;
    constexpr int I_MI = 32 * 128, I_MO = 128 * 32;
    for (int it = gw; it < I_MI + I_MO; it += NGW) {
        int r = it;
        if (r < I_MI) { transpose_item(p.w_mi, 2048, 8192, (bf16_t*)(p.ws + OFF_WMI), 64 * (r / 128), 64 * (r % 128), 64 * (r % 128), 64, scr, lane); continue; } r -= I_MI;
        transpose_item(p.w_mo, 8192, 2048, (bf16_t*)(p.ws + OFF_WMO), 64 * (r / 32), 64 * (r % 32), 64 * (r % 32), 64, scr, lane);
    }
}

DI void phase_modnorm(const float* x, const float* normw, const float* mod, int shift_off, int scale_off, bf16_t* H, int wave, int lane) {
    const int gw = blockIdx.x * 8 + wave, NGW = gridDim.x * 8;
    for (int m0 = 2 * gw; m0 < T; m0 += 2 * NGW) {
        const int b = m0 >> 13;
        const f32x4* xr = (const f32x4*)(x + (size_t)m0 * D) + lane;
        f32x4 v[2][8]; float s[2] = {0.f, 0.f};
#pragma unroll
        for (int r = 0; r < 2; ++r)
#pragma unroll
            for (int j = 0; j < 8; ++j) v[r][j] = xr[r * (D / 4) + 64 * j];
#pragma unroll
        for (int r = 0; r < 2; ++r)
#pragma unroll
            for (int j = 0; j < 8; ++j) s[r] += (v[r][j][0] * v[r][j][0] + v[r][j][1] * v[r][j][1]) + (v[r][j][2] * v[r][j][2] + v[r][j][3] * v[r][j][3]);
        const float rstd0 = rsqrtf(wave_sum(s[0]) * (1.f / D) + EPS), rstd1 = rsqrtf(wave_sum(s[1]) * (1.f / D) + EPS);
        u32x2* o = (u32x2*)(H + (size_t)m0 * D) + lane;
#pragma unroll
        for (int j = 0; j < 8; ++j) { const int col = 256 * j + 4 * lane;
            const f32x4 nw = *(const f32x4*)(normw + col), sc = *(const f32x4*)(mod + b * 12288 + scale_off + col), sh = *(const f32x4*)(mod + b * 12288 + shift_off + col);
            f32x4 a;
#pragma unroll
            for (int i = 0; i < 4; ++i) a[i] = nw[i] * (1.f + sc[i]);
            u32x2 w0, w1;
            w0.x = pk2(v[0][j][0] * rstd0 * a[0] + sh[0], v[0][j][1] * rstd0 * a[1] + sh[1]); w0.y = pk2(v[0][j][2] * rstd0 * a[2] + sh[2], v[0][j][3] * rstd0 * a[3] + sh[3]);
            w1.x = pk2(v[1][j][0] * rstd1 * a[0] + sh[0], v[1][j][1] * rstd1 * a[1] + sh[1]); w1.y = pk2(v[1][j][2] * rstd1 * a[2] + sh[2], v[1][j][3] * rstd1 * a[3] + sh[3]);
            o[64 * j] = w0; o[D / 4 + 64 * j] = w1; }
    }
}

#define EPI_ARGS const f32x4 (&acc)[2][2][4][2], const pg8::Unit& u, int wr, int wc, int fr, int fq
#define EPI_BEGIN _Pragma("unroll") for (int ai = 0; ai < 2; ++ai) _Pragma("unroll") for (int m = 0; m < 4; ++m) { const int r = u.pm * 256 + ai * 128 + wr * 64 + m * 16 + fr; \
    _Pragma("unroll") for (int bj = 0; bj < 2; ++bj) { const int cl = bj * 128 + wc * 32 + 8 * fq; f32x4 v0 = acc[ai][bj][m][0], v1 = acc[ai][bj][m][1];
#define EPI_END } }
DI u32x4 pack_row8(f32x4 a, f32x4 b) { u32x4 o; o.x = pk2(a[0], a[1]); o.y = pk2(a[2], a[3]); o.z = pk2(b[0], b[1]); o.w = pk2(b[2], b[3]); return o; }

struct EpiIn {
    static constexpr bool PERM = true, AFTER_DRAIN = false;
    bf16_t *qkv, *z, *qsw, *kvsw; float* ba; const float* a_log; const float* dt_bias;
    DI void operator()(EPI_ARGS) const {
        const int pn = u.pn;
        if (pn < 22) {
            bf16_t* base; int ldc, c0; bool act = false;
            if (pn < 12) { base = qkv; ldc = 3072; c0 = pn * 256; }
            else if (pn < 16) { base = z; ldc = 1024; c0 = (pn - 12) * 256; act = true; }
            else if (pn < 20) { base = qsw; ldc = 1024; c0 = (pn - 16) * 256; }
            else { base = kvsw; ldc = 512; c0 = (pn - 20) * 256; }
            EPI_BEGIN
                if (act) {
#pragma unroll
                    for (int i = 0; i < 4; ++i) { v0[i] = siluf_(v0[i]); v1[i] = siluf_(v1[i]); } }
                *(u32x4*)(base + (size_t)r * ldc + c0 + cl) = pack_row8(v0, v1);
            EPI_END
        } else if (wc == 0) {
            const int j0 = (fq & 1) * 8;
            f32x4 al0 = {0, 0, 0, 0}, al1 = al0, db0 = al0, db1 = al0;
            if (fq >= 2) { al0 = *(const f32x4*)(a_log + j0); al1 = *(const f32x4*)(a_log + j0 + 4); db0 = *(const f32x4*)(dt_bias + j0); db1 = *(const f32x4*)(dt_bias + j0 + 4); }
#pragma unroll
            for (int ai = 0; ai < 2; ++ai)
#pragma unroll
                for (int m = 0; m < 4; ++m) { const int r = u.pm * 256 + ai * 128 + wr * 64 + m * 16 + fr;
                    f32x4 v0 = acc[ai][0][m][0], v1 = acc[ai][0][m][1];
                    if (fq < 2) {
#pragma unroll
                        for (int i = 0; i < 4; ++i) { v0[i] = sigmoidf_(v0[i]); v1[i] = sigmoidf_(v1[i]); }
                    } else {
#pragma unroll
                        for (int i = 0; i < 4; ++i) {
                            float a = v0[i] + db0[i]; float sp = fmaxf(a, 0.f) + log1pf(__expf(-fabsf(a))); v0[i] = -__expf(al0[i]) * sp;
                            a = v1[i] + db1[i]; sp = fmaxf(a, 0.f) + log1pf(__expf(-fabsf(a))); v1[i] = -__expf(al1[i]) * sp; }
                    }
                    *(f32x4*)(ba + (size_t)r * 32 + 8 * fq) = v0; *(f32x4*)(ba + (size_t)r * 32 + 8 * fq + 4) = v1; }
        }
    }
};
struct EpiSig {
    static constexpr bool PERM = true, AFTER_DRAIN = false;
    bf16_t* O; int ldc;
    DI void operator()(EPI_ARGS) const {
        EPI_BEGIN
#pragma unroll
            for (int i = 0; i < 4; ++i) { v0[i] = sigmoidf_(v0[i]); v1[i] = sigmoidf_(v1[i]); }
            *(u32x4*)(O + (size_t)r * ldc + u.pn * 256 + cl) = pack_row8(v0, v1);
        EPI_END
    }
};
template <bool ADD> struct EpiMerge {
    static constexpr bool PERM = true, AFTER_DRAIN = false;
    const bf16_t* TG; const bf16_t* ADDEND; bf16_t* OUT;
    DI void operator()(EPI_ARGS) const {
        EPI_BEGIN
            const size_t off = (size_t)r * 2048 + u.pn * 256 + cl;
            const u32x4 g = *(const u32x4*)(TG + off);
            v0[0] *= bflo(g.x); v0[1] *= bfhi(g.x); v0[2] *= bflo(g.y); v0[3] *= bfhi(g.y); v1[0] *= bflo(g.z); v1[1] *= bfhi(g.z); v1[2] *= bflo(g.w); v1[3] *= bfhi(g.w);
            if (ADD) { const u32x4 o = *(const u32x4*)(ADDEND + off);
                v0[0] += bflo(o.x); v0[1] += bfhi(o.x); v0[2] += bflo(o.y); v0[3] += bfhi(o.y); v1[0] += bflo(o.z); v1[1] += bfhi(o.z); v1[2] += bflo(o.w); v1[3] += bfhi(o.w); }
            *(u32x4*)(OUT + off) = pack_row8(v0, v1);
        EPI_END
    }
};
struct EpiRes {
    static constexpr bool PERM = true, AFTER_DRAIN = false;
    const float* res; const float* gate; float* out;
    DI void operator()(EPI_ARGS) const {
        const float* gp = gate + (u.pm >> 5) * 12288 + u.pn * 256;
        EPI_BEGIN
            const size_t off = (size_t)r * 2048 + u.pn * 256 + cl;
            const f32x4 g0 = *(const f32x4*)(gp + cl), g1 = *(const f32x4*)(gp + cl + 4);
            const f32x4 x0 = *(const f32x4*)(res + off), x1 = *(const f32x4*)(res + off + 4);
            *(f32x4*)(out + off) = x0 + g0 * v0; *(f32x4*)(out + off + 4) = x1 + g1 * v1;
        EPI_END
    }
};
struct EpiRelu2 {
    static constexpr bool PERM = true, AFTER_DRAIN = false;
    bf16_t* O; int ldc;
    DI void operator()(EPI_ARGS) const {
        EPI_BEGIN
#pragma unroll
            for (int i = 0; i < 4; ++i) { float a = fmaxf(v0[i], 0.f); v0[i] = a * a; a = fmaxf(v1[i], 0.f); v1[i] = a * a; }
            *(u32x4*)(O + (size_t)r * ldc + u.pn * 256 + cl) = pack_row8(v0, v1);
        EPI_END
    }
};

DI void phase_conv(const bf16_t* qkv, const float* conv_w, bf16_t* Qc, bf16_t* Kc, bf16_t* Vc, int wave, int lane) {
    const int gw = blockIdx.x * 8 + wave, NGW = gridDim.x * 8;
    for (int it = gw; it < 6 * 1024; it += NGW) {
        const int g = it % 6, run = it / 6, t0 = run * 16, tl0 = t0 & 8191, ch = g * 512 + 8 * lane;
        u32x4 rows[20];
#pragma unroll
        for (int i = 0; i < 20; ++i) { const int tl = tl0 - 2 + i; rows[i] = (tl >= 0 && tl < 8192) ? *(const u32x4*)(qkv + (size_t)(t0 - 2 + i) * 3072 + ch) : (u32x4){0u, 0u, 0u, 0u}; }
        f32x4 wl[5], wh[5];
#pragma unroll
        for (int j = 0; j < 5; ++j) { wl[j] = *(const f32x4*)(conv_w + j * 3072 + ch); wh[j] = *(const f32x4*)(conv_w + j * 3072 + ch + 4); }
        bf16_t* dst = (g < 2 ? Qc : (g < 4 ? Kc : Vc)) + (size_t)t0 * 1024 + (g & 1) * 512 + 8 * lane;
        const float post = g < 2 ? 0.08838834764831845f : 1.f;
#pragma unroll
        for (int i = 0; i < 16; ++i) {
            float a[8] = {0.f, 0.f, 0.f, 0.f, 0.f, 0.f, 0.f, 0.f};
#pragma unroll
            for (int j = 0; j < 5; ++j) { const u32x4 r = rows[i + j];
                a[0] += wl[j][0] * bflo(r.x); a[1] += wl[j][1] * bfhi(r.x); a[2] += wl[j][2] * bflo(r.y); a[3] += wl[j][3] * bfhi(r.y);
                a[4] += wh[j][0] * bflo(r.z); a[5] += wh[j][1] * bfhi(r.z); a[6] += wh[j][2] * bflo(r.w); a[7] += wh[j][3] * bfhi(r.w); }
            float ss = 0.f;
#pragma unroll
            for (int e = 0; e < 8; ++e) { a[e] = siluf_(a[e]); ss += a[e] * a[e]; }
            if (g < 4) { ss += __shfl_xor(ss, 1); ss += __shfl_xor(ss, 2); ss += __shfl_xor(ss, 4); ss += __shfl_xor(ss, 8);
                const float sc = rsqrtf(ss + EPS) * post;
#pragma unroll
                for (int e = 0; e < 8; ++e) a[e] *= sc; }
            u32x4 o; o.x = pk2(a[0], a[1]); o.y = pk2(a[2], a[3]); o.z = pk2(a[4], a[5]); o.w = pk2(a[6], a[7]);
            *(u32x4*)(dst + (size_t)i * 1024) = o;
        }
    }
}
DI void normrope16(bf16_t* ptr, const float* nw, const LAS f32x2* tab, float scale, int lane) {
    u32x4 a = *(const u32x4*)ptr, b = *(const u32x4*)(ptr + 8);
    float v[16];
    v[0] = bflo(a.x); v[1] = bfhi(a.x); v[2] = bflo(a.y); v[3] = bfhi(a.y); v[4] = bflo(a.z); v[5] = bfhi(a.z); v[6] = bflo(a.w); v[7] = bfhi(a.w);
    v[8] = bflo(b.x); v[9] = bfhi(b.x); v[10] = bflo(b.y); v[11] = bfhi(b.y); v[12] = bflo(b.z); v[13] = bfhi(b.z); v[14] = bflo(b.w); v[15] = bfhi(b.w);
    float ss = 0.f;
#pragma unroll
    for (int i = 0; i < 16; ++i) ss += v[i] * v[i];
    ss += __shfl_xor(ss, 1); ss += __shfl_xor(ss, 2); ss += __shfl_xor(ss, 4);
    const float rstd = rsqrtf(ss * (1.f / 128.f) + EPS);
    const int sub = lane & 7;
#pragma unroll
    for (int i = 0; i < 16; ++i) v[i] = v[i] * rstd * nw[sub * 16 + i];
#pragma unroll
    for (int i = 0; i < 16; ++i) { const float pr = __shfl_xor(v[i], 1); const f32x2 cs = tab[i];
        if (sub == 0) v[i] = v[i] * cs[0] - pr * cs[1]; else if (sub == 1) v[i] = v[i] * cs[0] + pr * cs[1]; }
    u32x4 o0, o1;
    o0.x = pk2(v[0] * scale, v[1] * scale); o0.y = pk2(v[2] * scale, v[3] * scale); o0.z = pk2(v[4] * scale, v[5] * scale); o0.w = pk2(v[6] * scale, v[7] * scale);
    o1.x = pk2(v[8] * scale, v[9] * scale); o1.y = pk2(v[10] * scale, v[11] * scale); o1.z = pk2(v[12] * scale, v[13] * scale); o1.w = pk2(v[14] * scale, v[15] * scale);
    *(u32x4*)ptr = o0; *(u32x4*)(ptr + 8) = o1;
}
DI void phase_swa_normrope(bf16_t* QSW, bf16_t* KVSW, const float* qn_w, const float* kn_w, LAS unsigned char* lds, int wave, int lane) {
    const int gw = blockIdx.x * 8 + wave, NGW = gridDim.x * 8;
    LAS f32x2* tab = (LAS f32x2*)(lds + wave * 128);
    for (int tk = gw; tk < T; tk += NGW) {
        const int pos = tk & 8191;
        if (lane < 16) {
            const float invf = exp2f(-(float)lane * (18.931568569324174f / 16.f));
            const float ang = (float)pos * invf;
            const double ad = (double)ang; const double kq = __builtin_rint(ad * 0.15915494309189535); const float rr = (float)(ad - kq * 6.283185307179586);
            f32x2 cs; cs[0] = __cosf(rr); cs[1] = __sinf(rr); tab[lane] = cs;
        }
        LDS_WAIT();
        normrope16(QSW + (size_t)tk * 1024 + lane * 16, qn_w, tab, 0.08838834764831845f, lane);
        if (lane < 16) normrope16(KVSW + (size_t)tk * 512 + lane * 16, kn_w, tab, 1.f, lane);
        LDS_WAIT();
    }
}

DI void swa_block(const bf16_t* QSW, const bf16_t* KVSW, const float* sink, bf16_t* Ysw, LAS unsigned char* lds, int tid, int wave, int lane) {
    const int fr = lane & 15, fq = lane >> 4, r = tid >> 2, sg = tid & 3, qi = 16 * wave + fr;
    LAS bf16_t* Kl = (LAS bf16_t*)lds; LAS bf16_t* VTl = Kl + 128 * 136;
    int it = blockIdx.x; if (it >= 1024) return;
    int kb = (((it >> 3) & 63) == 0) ? 1 : 0;
    u32x4 kk[4], vv[4]; bf16x8 qf[4], qn[4];
#define ATT_LOADKV(item_, kb_) do { const int hkv_ = ((item_) & 7) >> 2, nb_ = ((item_) >> 3) & 63, b_ = (item_) >> 9; const size_t tok_ = (size_t)b_ * L + 128 * (nb_ - 1 + (kb_)) + r; \
        const u32x4* ks_ = (const u32x4*)(KVSW + tok_ * 512 + hkv_ * 128 + sg * 32); const u32x4* vs_ = (const u32x4*)(KVSW + tok_ * 512 + 256 + hkv_ * 128 + sg * 32); \
        _Pragma("unroll") for (int i = 0; i < 4; ++i) { kk[i] = ks_[i]; vv[i] = vs_[i]; } } while (0)
#define ATT_LOADQ(dst, item_) do { const int hq_ = (item_) & 7, nb_ = ((item_) >> 3) & 63, b_ = (item_) >> 9; const size_t tq_ = (size_t)b_ * L + 128 * nb_ + qi; \
        _Pragma("unroll") for (int ks = 0; ks < 4; ++ks) dst[ks] = *(const bf16x8*)(QSW + tq_ * 1024 + hq_ * 128 + 32 * ks + 8 * fq); } while (0)
    ATT_LOADKV(it, kb); ATT_LOADQ(qf, it);
#pragma unroll
    for (int ks = 0; ks < 4; ++ks) qn[ks] = qf[ks];
    float mrun = 0.f, lrun = 0.f; f32x4 ot[8];
    bool first = true;
    for (;;) {
        const int hq = it & 7, nb = (it >> 3) & 63, b = it >> 9;
        __syncthreads();
#pragma unroll
        for (int i = 0; i < 4; ++i) { *(LAS u32x4*)(Kl + r * 136 + sg * 32 + 8 * i) = kk[i]; *(LAS u32x4*)(VTl + r * 136 + sg * 32 + 8 * i) = vv[i]; }
        __syncthreads();
        const bool last_kb = (kb == 2) || (nb + kb >= 64);
        int nit = it, nkb = kb + 1;
        if (last_kb) { nit = it + gridDim.x; nkb = (((nit >> 3) & 63) == 0) ? 1 : 0; }
        const bool more = nit < 1024;
        if (more) { ATT_LOADKV(nit, nkb); if (last_kb) ATT_LOADQ(qn, nit); }
        if (first) { mrun = sink[hq]; lrun = (fq == 0) ? 1.f : 0.f;
#pragma unroll
            for (int i = 0; i < 8; ++i) ot[i] = (f32x4){0.f, 0.f, 0.f, 0.f}; }
        f32x4 st[8];
#pragma unroll
        for (int mt = 0; mt < 8; ++mt) { st[mt] = (f32x4){0.f, 0.f, 0.f, 0.f};
#pragma unroll
            for (int ks = 0; ks < 4; ++ks) { const bf16x8 a = *(const LAS bf16x8*)(Kl + (16 * mt + fr) * 136 + 32 * ks + 8 * fq); st[mt] = mfma16(a, qf[ks], st[mt]); } }
        float mx = -INFINITY;
#pragma unroll
        for (int mt = 0; mt < 8; ++mt)
#pragma unroll
            for (int j = 0; j < 4; ++j) { const int kj = 16 * mt + 4 * fq + j; const bool valid = (kb == 0) ? (kj >= qi) : ((kb == 2) ? (kj <= qi) : true);
                const float sv = valid ? st[mt][j] : -INFINITY; st[mt][j] = sv; mx = fmaxf(mx, sv); }
        mx = fmaxf(mx, __shfl_xor(mx, 16)); mx = fmaxf(mx, __shfl_xor(mx, 32));
        const float mnew = fmaxf(mrun, mx), alpha = __expf(mrun - mnew);
        float ls = 0.f;
#pragma unroll
        for (int mt = 0; mt < 8; ++mt)
#pragma unroll
            for (int j = 0; j < 4; ++j) { const float pe = __expf(st[mt][j] - mnew); st[mt][j] = pe; ls += pe; }
        lrun = lrun * alpha + ls; mrun = mnew;
#pragma unroll
        for (int dt = 0; dt < 8; ++dt) ot[dt] *= alpha;
        bf16x8 pb[4];
#pragma unroll
        for (int ks = 0; ks < 4; ++ks) pb[ks] = pack8(st[2 * ks], st[2 * ks + 1]);
#pragma unroll
        for (int dt = 0; dt < 8; ++dt)
#pragma unroll
            for (int ks = 0; ks < 4; ++ks) { const LAS bf16_t* vp = VTl + (32 * ks + 4 * fq + (fr >> 2)) * 136 + 16 * dt + 4 * (fr & 3);
                const bf16x8 av = cat4(tr_read(vp), tr_read(vp + 16 * 136)); ot[dt] = mfma16(av, pb[ks], ot[dt]); }
        first = false;
        if (last_kb) {
            float lt = lrun; lt += __shfl_xor(lt, 16); lt += __shfl_xor(lt, 32);
            const float inv = 1.f / lt; const size_t tokq = (size_t)b * L + 128 * nb + qi;
#pragma unroll
            for (int dt = 0; dt < 8; ++dt) { u32x2 o; o.x = pk2(ot[dt][0] * inv, ot[dt][1] * inv); o.y = pk2(ot[dt][2] * inv, ot[dt][3] * inv);
                *(u32x2*)(Ysw + tokq * 1024 + hq * 128 + 16 * dt + 4 * fq) = o; }
#pragma unroll
            for (int ks = 0; ks < 4; ++ks) qf[ks] = qn[ks];
            first = true;
        }
        if (!more) break;
        it = nit; kb = nkb;
    }
#undef ATT_LOADKV
#undef ATT_LOADQ
}

constexpr int PREP_SET = 70400;
struct PrepStage { u32x4 kk[4], qq[4], vv[4]; float beta, g; };
DI void prep_load(PrepStage& R, const unsigned char* ws_c, int pair, int tid, int wave, int lane) {
    const bf16_t* Qc = (const bf16_t*)(ws_c + OFF_QC); const bf16_t* Kc = (const bf16_t*)(ws_c + OFF_KC); const bf16_t* Vc = (const bf16_t*)(ws_c + OFF_VC);
    const float* BA = (const float*)(ws_c + OFF_BA);
    const int grp = wave >> 2, wl = wave & 3, lt = tid & 255, item = 2 * pair + grp;
    const int n = item & 127, dirbh = item >> 7, dir = dirbh >> 4, b = (dirbh >> 3) & 1, h = dirbh & 7;
    const int c = lt >> 2, part = lt & 3;
    const size_t tok = (size_t)b * L + (dir ? (L - 1 - 64 * n - c) : (64 * n + c));
    const size_t go = tok * 1024 + h * 128 + part * 32;
#pragma unroll
    for (int i = 0; i < 4; ++i) { R.kk[i] = *(const u32x4*)(Kc + go + 8 * i); R.qq[i] = *(const u32x4*)(Qc + go + 8 * i); R.vv[i] = *(const u32x4*)(Vc + go + 8 * i); }
    if (wl == 0) { const size_t tk = (size_t)b * L + (dir ? (L - 1 - 64 * n - lane) : (64 * n + lane));
        R.beta = BA[tk * 32 + dir * 8 + h]; R.g = BA[tk * 32 + 16 + dir * 8 + h]; }
}
DI void dn_prep_pair(const unsigned char* ws_c, unsigned char* ws, LAS unsigned char* lds, int pair, int npair, PrepStage& R, int tid, int wave, int lane) {
    const bf16_t* Qc = (const bf16_t*)(ws_c + OFF_QC); const bf16_t* Kc = (const bf16_t*)(ws_c + OFF_KC); const bf16_t* Vc = (const bf16_t*)(ws_c + OFF_VC);
    const float* BA = (const float*)(ws_c + OFF_BA);
    bf16_t* Wg = (bf16_t*)(ws + OFF_W); bf16_t* Ug = (bf16_t*)(ws + OFF_U); bf16_t* Ag = (bf16_t*)(ws + OFF_A);
    f32x2* GC = (f32x2*)(ws + OFF_GC); float* EGL = (float*)(ws + OFF_EGL);
    { int l0 = threadIdx.x; asm volatile("" : "+v"(l0)); tid = l0; lane = l0 & 63; }
    const int grp = wave >> 2, wl = wave & 3, lt = tid & 255, item = 2 * pair + grp;
    const int n = item & 127, dirbh = item >> 7, dir = dirbh >> 4, b = (dirbh >> 3) & 1, h = dirbh & 7, fr = lane & 15, fq = lane >> 4;
    LAS unsigned char* base = lds + grp * PREP_SET;
    LAS bf16_t* Ks = (LAS bf16_t*)base; LAS bf16_t* Vs = Ks + 64 * 136; LAS float* Akk = (LAS float*)(base + 34816);
    LAS bf16_t* Qs = (LAS bf16_t*)(base + 51200);
    LAS bf16_t* Tb1 = (LAS bf16_t*)(base + 51200); LAS bf16_t* Tb2 = Tb1 + 64 * 72;
    LAS float* sg = (LAS float*)(base + 69632); LAS float* sb = sg + 64; LAS float* seg = sg + 128;
    __syncthreads();
    { const int c = lt >> 2, part = lt & 3;
      if (wl == 0) {
          const float beta = R.beta; float g = R.g;
#pragma unroll
          for (int off = 1; off < 64; off <<= 1) { const float t = __shfl_up(g, off); if (lane >= off) g += t; }
          const float eg = __expf(g), gl = __shfl(g, 63), dg = __expf(gl - g);
          sg[lane] = g; sb[lane] = beta; seg[lane] = eg;
          f32x2 w; w[0] = eg; w[1] = dg; GC[(size_t)dirbh * 8192 + 64 * n + lane] = w;
          if (lane == 63) EGL[dirbh * 128 + n] = eg;
      }
#pragma unroll
      for (int i = 0; i < 4; ++i) { *(LAS u32x4*)(Ks + c * 136 + part * 32 + 8 * i) = R.kk[i]; *(LAS u32x4*)(Qs + c * 136 + part * 32 + 8 * i) = R.qq[i]; *(LAS u32x4*)(Vs + c * 136 + part * 32 + 8 * i) = R.vv[i]; }
    }
    if (npair >= 0) prep_load(R, ws_c, npair, tid, wave, lane);
    __syncthreads();
    {
        const int nt = wl;
        bf16x8 sf[4];
#pragma unroll
        for (int ks = 0; ks < 4; ++ks) sf[ks] = *(const LAS bf16x8*)(Ks + (16 * nt + fr) * 136 + 8 * fq + 32 * ks);
        f32x4 sgs;
#pragma unroll
        for (int j = 0; j < 4; ++j) sgs[j] = sg[16 * nt + 4 * fq + j];
        for (int mt = 0; mt < 4; ++mt) {
            const int cc = 16 * mt + fr; const float gc = sg[cc], bc = sb[cc];
            f32x4 ak = {0.f, 0.f, 0.f, 0.f}, aq = {0.f, 0.f, 0.f, 0.f};
            if (nt <= mt) {
                const LAS bf16_t* Kp = Ks + cc * 136 + 8 * fq; const LAS bf16_t* Qp = Qs + cc * 136 + 8 * fq;
#pragma unroll
                for (int ks = 0; ks < 4; ++ks) { ak = mfma16(sf[ks], *(const LAS bf16x8*)(Kp + 32 * ks), ak); aq = mfma16(sf[ks], *(const LAS bf16x8*)(Qp + 32 * ks), aq); }
            }
            f32x4 ok, oq;
#pragma unroll
            for (int j = 0; j < 4; ++j) { const int s_ = 16 * nt + 4 * fq + j; const float e_ = __expf(fminf(gc - sgs[j], 0.f));
                ok[j] = (s_ < cc) ? bc * ak[j] * e_ : 0.f; oq[j] = (s_ <= cc) ? aq[j] * e_ : 0.f; }
            if (nt <= mt) { LAS float* ap = Akk + (16 * nt + 4 * fq) * 64 + cc;
                ap[0] = ok[0]; ap[64] = ok[1]; ap[128] = ok[2]; ap[192] = ok[3]; }
            u32x2 w; w.x = pk2(oq[0], oq[1]); w.y = pk2(oq[2], oq[3]); *(u32x2*)(Ag + (size_t)item * 4096 + cc * 64 + 16 * nt + 4 * fq) = w;
        }
    }
    __syncthreads();
    {
        int zoff = 0; asm volatile("" : "+v"(zoff));
        const LAS float* Akz = Akk + zoff;
        LAS float* Tl = (LAS float*)(base + 51200);
        LAS float* Xs = (LAS float*)(lds + 2 * PREP_SET + grp * 4096);
        LAS float* Dl = (LAS float*)(lds + 2 * PREP_SET + 8192 + grp * 4096);
        {   float Y[16];
#pragma unroll
            for (int r = 0; r < 16; ++r) Y[r] = (lane == r) ? 1.f : 0.f;
#pragma unroll
            for (int jj = 0; jj < 16; ++jj) {
                const float t = Y[jj]; if (lane < 16) Dl[(wl * 16 + jj) * 16 + lane] = t;
                if (jj < 15) { const LAS float* ar = Akz + (16 * wl + jj) * 64 + 16 * wl;
#pragma unroll
                    for (int r4 = (jj + 1) / 4; r4 < 4; ++r4) { const f32x4 av = *(const LAS f32x4*)(ar + 4 * r4);
#pragma unroll
                        for (int e = 0; e < 4; ++e) { if (4 * r4 + e > jj) fnma(Y[4 * r4 + e], av[e], t); } } }
            }
        }
        __syncthreads();
        const LAS float* Dz = Dl + zoff;
        for (int P = 0; P < 4; ++P) {
            float X[4];
#pragma unroll
            for (int e = 0; e < 4; ++e) X[e] = (lane == 16 * P + 4 * wl + e) ? 1.f : 0.f;
            const int nj = 16 * P;
            if (nj > 0) {
                float tj = Tl[lane]; f32x4 a0 = *(const LAS f32x4*)(Akz + 16 * P + 4 * wl);
                for (int j = 0; j < nj; ++j) {
                    const int jn = (j + 1 < nj) ? j + 1 : j;
                    const float tn = Tl[jn * 64 + lane]; const f32x4 n0 = *(const LAS f32x4*)(Akz + jn * 64 + 16 * P + 4 * wl);
#pragma unroll
                    for (int e = 0; e < 4; ++e) fnma(X[e], a0[e], tj);
                    tj = tn; a0 = n0;
                }
            }
#pragma unroll
            for (int e = 0; e < 4; ++e) Xs[(4 * wl + e) * 64 + lane] = X[e];
            __syncthreads();
            {   float Tn[4] = {0.f, 0.f, 0.f, 0.f}; float xk[16]; f32x4 dv[4][4];
#pragma unroll
                for (int k = 0; k < 16; ++k) xk[k] = Xs[k * 64 + lane];
#pragma unroll
                for (int e = 0; e < 4; ++e)
#pragma unroll
                    for (int k4 = 0; k4 < 4; ++k4) dv[e][k4] = *(const LAS f32x4*)(Dz + (P * 16 + 4 * wl + e) * 16 + 4 * k4);
#pragma unroll
                for (int k = 0; k < 16; ++k)
#pragma unroll
                    for (int e = 0; e < 4; ++e) fpma(Tn[e], dv[e][k >> 2][k & 3], xk[k]);
#pragma unroll
                for (int e = 0; e < 4; ++e) Tl[(16 * P + 4 * wl + e) * 64 + lane] = Tn[e];
            }
            __syncthreads();
        }
        const float c1 = sb[lane], c2 = -c1 * seg[lane];
        float Tc[16];
#pragma unroll
        for (int i = 0; i < 16; ++i) Tc[i] = Tl[(16 * wl + i) * 64 + lane];
        __syncthreads();
#pragma unroll
        for (int i = 0; i < 16; ++i) { const unsigned w = pk2(Tc[i] * c1, Tc[i] * c2); Tb1[(16 * wl + i) * 72 + lane] = (bf16_t)(w & 0xffffu); Tb2[(16 * wl + i) * 72 + lane] = (bf16_t)(w >> 16); }
    }
    __syncthreads();
    { int l2 = threadIdx.x; asm volatile("" : "+v"(l2)); lane = l2 & 63; }
    const int fr2 = lane & 15, fq2 = lane >> 4;
#define fr fr2
#define fq fq2
    for (int i2 = 0; i2 < 8; ++i2) {
        const int which = i2 >> 2, mt = i2 & 3;
        const LAS bf16_t* Tp = (which ? Tb2 : Tb1) + (16 * mt + fr) * 72 + 8 * fq;
        const LAS bf16_t* Xa = (which ? Ks : Vs) + (8 * fq + (fr >> 2)) * 136 + 16 * wl + 4 * (fr & 3); const LAS bf16_t* Xb = Xa + 64;
        const bf16x8 t0 = *(const LAS bf16x8*)Tp;
        f32x4 acca = mfma16(cat4(tr_read(Xa), tr_read(Xa + 4 * 136)), t0, (f32x4){0.f, 0.f, 0.f, 0.f});
        f32x4 accb = mfma16(cat4(tr_read(Xb), tr_read(Xb + 4 * 136)), t0, (f32x4){0.f, 0.f, 0.f, 0.f});
        if (mt >= 2) { const bf16x8 t1 = *(const LAS bf16x8*)(Tp + 32);
            acca = mfma16(cat4(tr_read(Xa + 32 * 136), tr_read(Xa + 36 * 136)), t1, acca);
            accb = mfma16(cat4(tr_read(Xb + 32 * 136), tr_read(Xb + 36 * 136)), t1, accb); }
        bf16_t* dst = (which ? Wg : Ug) + ((size_t)item * 64 + 16 * mt + fr) * 128 + 16 * wl + 4 * fq;
        u32x2 wa, wb; wa.x = pk2(acca[0], acca[1]); wa.y = pk2(acca[2], acca[3]); wb.x = pk2(accb[0], accb[1]); wb.y = pk2(accb[2], accb[3]);
        *(u32x2*)dst = wa; *(u32x2*)(dst + 64) = wb;
    }
#undef fr
#undef fq
}

constexpr int SC4_BUF = 71168;
DI void scan_item(const unsigned char* ws_c, unsigned char* ws, LAS unsigned char* lds, int dirbh, int half, int tid, int wave, int lane) {
    const bf16_t* Qc = (const bf16_t*)(ws_c + OFF_QC); const bf16_t* Kc = (const bf16_t*)(ws_c + OFF_KC);
    const bf16_t* Wg = (const bf16_t*)(ws_c + OFF_W); const bf16_t* Ug = (const bf16_t*)(ws_c + OFF_U); const bf16_t* Ag = (const bf16_t*)(ws_c + OFF_A);
    const f32x2* GC = (const f32x2*)(ws_c + OFF_GC);
    const int dir = dirbh >> 4, b = (dirbh >> 3) & 1, h = dirbh & 7, e0 = 64 * half + 16 * (wave & 3), el = 16 * (wave & 3), fr = lane & 15, fq = lane >> 4;
    bf16_t* Og = (bf16_t*)(ws + (dir ? OFF_OB : OFF_OF));
    struct Stg { u32x4 w0, w1, q0, q1, k0, k1, a, u; f32x2 g; };
#define SC_LOAD(R, vt, nn) do { const int row = (vt) >> 3, s8 = (vt) & 7, row2 = (vt) >> 1, hf = (vt) & 1; const size_t ci = (size_t)dirbh * 128 + (nn); \
        const bf16_t* wsrc = Wg + (ci * 64 + row) * 128 + s8 * 16; R.w0 = *(const u32x4*)wsrc; R.w1 = *(const u32x4*)(wsrc + 8); \
        const size_t tok = (size_t)b * L + (dir ? (L - 1 - 64 * (nn) - row) : (64 * (nn) + row)); const size_t go = tok * 1024 + h * 128 + s8 * 16; \
        R.q0 = *(const u32x4*)(Qc + go); R.q1 = *(const u32x4*)(Qc + go + 8); R.k0 = *(const u32x4*)(Kc + go); R.k1 = *(const u32x4*)(Kc + go + 8); \
        R.a = *(const u32x4*)(Ag + (ci * 64 + row) * 64 + s8 * 8); \
        R.u = *(const u32x4*)(Ug + (ci * 64 + row) * 128 + 64 * half + s8 * 8); \
        if ((vt) < 64) R.g = GC[(size_t)dirbh * 8192 + 64 * (nn) + (vt)]; } while (0)
#define SC_STORE(R, vt, bufp) do { const int row = (vt) >> 3, s8 = (vt) & 7, row2 = (vt) >> 1, hf = (vt) & 1; \
        LAS bf16_t* Wl_ = (LAS bf16_t*)(bufp); LAS bf16_t* Ql_ = Wl_ + 64 * 136; LAS bf16_t* Kl_ = Ql_ + 64 * 136; LAS bf16_t* Al_ = Kl_ + 64 * 136; LAS bf16_t* Ul_ = Al_ + 64 * 72; LAS float* EG_ = (LAS float*)(Ul_ + 64 * 72); \
        *(LAS u32x4*)(Wl_ + row * 136 + s8 * 16) = R.w0; *(LAS u32x4*)(Wl_ + row * 136 + s8 * 16 + 8) = R.w1; \
        *(LAS u32x4*)(Ql_ + row * 136 + s8 * 16) = R.q0; *(LAS u32x4*)(Ql_ + row * 136 + s8 * 16 + 8) = R.q1; \
        *(LAS u32x4*)(Kl_ + row * 136 + s8 * 16) = R.k0; *(LAS u32x4*)(Kl_ + row * 136 + s8 * 16 + 8) = R.k1; \
        *(LAS u32x4*)(Al_ + row * 72 + s8 * 8) = R.a; \
        *(LAS u32x4*)(Ul_ + row * 72 + s8 * 8) = R.u; \
        if ((vt) < 64) { EG_[(vt)] = R.g[0]; EG_[64 + (vt)] = R.g[1]; } } while (0)
    __syncthreads();
    { Stg R; R.u = (u32x4){0u, 0u, 0u, 0u}; R.g = (f32x2){0.f, 0.f}; SC_LOAD(R, tid, 0); SC_STORE(R, tid, lds); }
    __syncthreads();
    if (wave >= 4) {
        const int v0 = tid - 256, v1 = tid; const bool two = true;
        Stg R0, R1; R0.u = (u32x4){0u, 0u, 0u, 0u}; R0.g = (f32x2){0.f, 0.f}; R1 = R0;
        SC_LOAD(R0, v0, 1); if (two) SC_LOAD(R1, v1, 1);
        for (int n = 0; n < 128; ++n) {
            LAS unsigned char* nxt = lds + ((n + 1) & 1) * SC4_BUF;
            if (n + 1 < 128) { SC_STORE(R0, v0, nxt); if (two) SC_STORE(R1, v1, nxt); }
            if (n + 2 < 128) { SC_LOAD(R0, v0, n + 2); if (two) SC_LOAD(R1, v1, n + 2); }
            __syncthreads();
        }
    } else {
    f32x4 S[8];
#pragma unroll
    for (int i = 0; i < 8; ++i) S[i] = (f32x4){0.f, 0.f, 0.f, 0.f};
    for (int n = 0; n < 128; ++n) {
        LAS unsigned char* cur = lds + (n & 1) * SC4_BUF;
        {
            const LAS bf16_t* Wl = (const LAS bf16_t*)cur; const LAS bf16_t* Ql = Wl + 64 * 136; const LAS bf16_t* Kl = Ql + 64 * 136; const LAS bf16_t* Al = Kl + 64 * 136; const LAS bf16_t* Ul = Al + 64 * 72;
            const LAS float* EG = (const LAS float*)(Ul + 64 * 72); const LAS float* DG = EG + 64;
            bf16x8 Sb[4];
#pragma unroll
            for (int ks = 0; ks < 4; ++ks) Sb[ks] = pack8(S[2 * ks], S[2 * ks + 1]);
            f32x4 vn[4], oq[4], oa[4];
#pragma unroll
            for (int mt = 0; mt < 4; ++mt) {
#pragma unroll
                for (int j = 0; j < 4; ++j) vn[mt][j] = bf2f(Ul[(16 * mt + 4 * fq + j) * 72 + el + fr]);
                oq[mt] = (f32x4){0.f, 0.f, 0.f, 0.f}; oa[mt] = (f32x4){0.f, 0.f, 0.f, 0.f};
#pragma unroll
                for (int ks = 0; ks < 4; ++ks) { const LAS bf16_t* wp = Wl + (16 * mt + fr) * 136 + 32 * ks + 4 * fq; const LAS bf16_t* qp = Ql + (16 * mt + fr) * 136 + 32 * ks + 4 * fq;
                    vn[mt] = mfma16(cat4(*(const LAS s16x4*)wp, *(const LAS s16x4*)(wp + 16)), Sb[ks], vn[mt]);
                    oq[mt] = mfma16(Sb[ks], cat4(*(const LAS s16x4*)qp, *(const LAS s16x4*)(qp + 16)), oq[mt]); }
            }
            bf16x8 vb[2], vpb[2];
#pragma unroll
            for (int k2 = 0; k2 < 2; ++k2) { vb[k2] = pack8(vn[2 * k2], vn[2 * k2 + 1]);
                f32x4 a = vn[2 * k2], bb = vn[2 * k2 + 1];
#pragma unroll
                for (int j = 0; j < 4; ++j) { a[j] *= DG[32 * k2 + 4 * fq + j]; bb[j] *= DG[32 * k2 + 16 + 4 * fq + j]; }
                vpb[k2] = pack8(a, bb); }
#pragma unroll
            for (int mt = 0; mt < 4; ++mt)
#pragma unroll
                for (int k2 = 0; k2 < 2; ++k2) { if (k2 == 0 || mt >= 2) { const LAS bf16_t* ap = Al + (16 * mt + fr) * 72 + 32 * k2 + 4 * fq;
                    oa[mt] = mfma16(vb[k2], cat4(*(const LAS s16x4*)ap, *(const LAS s16x4*)(ap + 16)), oa[mt]); } }
#pragma unroll
            for (int mt = 0; mt < 4; ++mt) { const int cc = 16 * mt + fr; const size_t tok = (size_t)b * L + (dir ? (L - 1 - 64 * n - cc) : (64 * n + cc));
                const float eg = EG[cc]; u32x2 w; w.x = pk2(eg * oq[mt][0] + oa[mt][0], eg * oq[mt][1] + oa[mt][1]); w.y = pk2(eg * oq[mt][2] + oa[mt][2], eg * oq[mt][3] + oa[mt][3]);
                *(u32x2*)(Og + tok * 1024 + h * 128 + e0 + 4 * fq) = w; }
            const float egl = EG[63];
#pragma unroll
            for (int dt = 0; dt < 8; ++dt) { S[dt] *= egl;
#pragma unroll
                for (int k2 = 0; k2 < 2; ++k2) { const LAS bf16_t* kp = Kl + (32 * k2 + 4 * fq + (fr >> 2)) * 136 + 16 * dt + 4 * (fr & 3);
                    S[dt] = mfma16(cat4(tr_read(kp), tr_read(kp + 16 * 136)), vpb[k2], S[dt]); } }
        }
        __syncthreads();
    }
    }
#undef SC_LOAD
#undef SC_STORE
}

DI void phase_gated_norm(const bf16_t* OF, const bf16_t* OB, const bf16_t* Z, const float* nw, bf16_t* Y, int wave, int lane) {
    const int gw = blockIdx.x * 8 + wave, NGW = gridDim.x * 8;
    for (int tk = gw; tk < T; tk += NGW) {
        const size_t o = (size_t)tk * 1024 + lane * 16;
        const u32x4 f0 = *(const u32x4*)(OF + o), f1 = *(const u32x4*)(OF + o + 8), b0 = *(const u32x4*)(OB + o), b1 = *(const u32x4*)(OB + o + 8), z0 = *(const u32x4*)(Z + o), z1 = *(const u32x4*)(Z + o + 8);
        const unsigned fw[8] = {f0.x, f0.y, f0.z, f0.w, f1.x, f1.y, f1.z, f1.w}, bw[8] = {b0.x, b0.y, b0.z, b0.w, b1.x, b1.y, b1.z, b1.w}, zw[8] = {z0.x, z0.y, z0.z, z0.w, z1.x, z1.y, z1.z, z1.w};
        float v[16]; float ss = 0.f;
#pragma unroll
        for (int i = 0; i < 8; ++i) { v[2 * i] = bflo(fw[i]) + bflo(bw[i]); v[2 * i + 1] = bfhi(fw[i]) + bfhi(bw[i]); ss += v[2 * i] * v[2 * i] + v[2 * i + 1] * v[2 * i + 1]; }
        ss += __shfl_xor(ss, 1); ss += __shfl_xor(ss, 2); ss += __shfl_xor(ss, 4);
        const float rstd = rsqrtf(ss * (1.f / 128.f) + EPS);
        const float* wp = nw + (lane & 7) * 16;
        unsigned ow[8];
#pragma unroll
        for (int i = 0; i < 8; ++i) ow[i] = pk2(v[2 * i] * rstd * wp[2 * i] * bflo(zw[i]), v[2 * i + 1] * rstd * wp[2 * i + 1] * bfhi(zw[i]));
        u32x4 o0 = {ow[0], ow[1], ow[2], ow[3]}, o1 = {ow[4], ow[5], ow[6], ow[7]};
        *(u32x4*)(Y + o) = o0; *(u32x4*)(Y + o + 8) = o1;
    }
}

#define XB_TMO      128
#define XB_XCNT(j)  (256  + 64 * (j))
#define XB_XSUB(j)  (1280 + 64 * (j))
#define XB_XGEN(j)  (2304 + 64 * (j))
#define XB_TOP      3328
#define XB_TOPGEN   3392
#define XCD_BAR_WORDS 3456
#define XB_SPIN_CAP (1u << 18)

__device__ __forceinline__ unsigned xb_ld(unsigned* p)              { return __hip_atomic_load(p, __ATOMIC_RELAXED, __HIP_MEMORY_SCOPE_AGENT); }
__device__ __forceinline__ unsigned xb_add(unsigned* p, unsigned v) { return __hip_atomic_fetch_add(p, v, __ATOMIC_RELAXED, __HIP_MEMORY_SCOPE_AGENT); }
__device__ __forceinline__ unsigned xb_xcc_id() { return (unsigned)__builtin_amdgcn_s_getreg((3 << 11) | 20) & 0xFu; }
#define XB_SPIN(cond, bar) do { unsigned _sp = 0; while (cond) { __builtin_amdgcn_s_sleep(1); \
    if ((++_sp & 255u) == 0u) { if (xb_ld(&(bar)[XB_TMO])) break; if (_sp > XB_SPIN_CAP) { atomicAdd(&(bar)[XB_TMO], 1u); break; } } } } while (0)

struct XcdBarrier {
    unsigned* bar; unsigned x;
    volatile LAS unsigned* st;
};

__device__ __forceinline__ XcdBarrier xcd_barrier_post(unsigned* bar, volatile LAS unsigned* st) {
    XcdBarrier b; b.bar = bar; b.x = xb_xcc_id(); b.st = st;
    if (threadIdx.x == 0) (void)xb_add(&bar[XB_XCNT(b.x)], 1u);
    return b;
}
__device__ __forceinline__ void xcd_barrier_complete(unsigned* bar, unsigned x, unsigned& nloc, unsigned& nx) {
    const unsigned G = gridDim.x * gridDim.y * gridDim.z;
    unsigned sum, cnt, mine, sp = 0u;
    for (;;) {
        sum = 0u; cnt = 0u; mine = 0u;
#pragma unroll
        for (unsigned j = 0; j < 16; ++j) { const unsigned c = xb_ld(&bar[XB_XCNT(j)]); sum += c; cnt += (c > 0u) ? 1u : 0u; mine = (j == x) ? c : mine; }
        if (sum == G) break;
        __builtin_amdgcn_s_sleep(1);
        if ((++sp & 255u) == 0u) { if (xb_ld(&bar[XB_TMO])) break; if (sp > XB_SPIN_CAP) { atomicAdd(&bar[XB_TMO], 1u); break; } }
    }
    nloc = mine > 0u ? mine : 1u; nx = cnt > 0u ? cnt : 1u;
}

__device__ __forceinline__ void xcd_barrier(const XcdBarrier& b) {
    asm volatile("s_waitcnt vmcnt(0)" ::: "memory");
    __syncthreads();
    if (threadIdx.x == 0) {
        unsigned* bar = b.bar;
        __builtin_amdgcn_s_waitcnt(0);
        unsigned nloc = b.st[0], nx = b.st[1];
        if (nloc == 0u) { xcd_barrier_complete(bar, b.x, nloc, nx); b.st[0] = nloc; b.st[1] = nx; }
        const unsigned old = xb_add(&bar[XB_XSUB(b.x)], 1u);
        const unsigned gen = old / nloc;
        if (old + 1u == (gen + 1u) * nloc) {
            __builtin_amdgcn_fence(__ATOMIC_RELEASE, "agent");
            asm volatile("s_waitcnt vmcnt(0)" ::: "memory");
            const unsigned og = xb_add(&bar[XB_TOP], 1u);
            const unsigned tg = og / nx;
            if (og + 1u == (tg + 1u) * nx) xb_add(&bar[XB_TOPGEN], 1u);
            else XB_SPIN(xb_ld(&bar[XB_TOPGEN]) == tg, bar);
            __builtin_amdgcn_fence(__ATOMIC_ACQUIRE, "agent");
            xb_add(&bar[XB_XGEN(b.x)], 1u);
            asm volatile("s_waitcnt vmcnt(0)" ::: "memory");
        } else {
            XB_SPIN(xb_ld(&bar[XB_XGEN(b.x)]) == gen, bar);
            __builtin_amdgcn_fence(__ATOMIC_ACQUIRE, "agent");
            asm volatile("s_waitcnt vmcnt(0)" ::: "memory");
        }
    }
    __syncthreads();
}


struct SplitOrder {
    int nM, nN, G, c, lim;
    __device__ bool next(int i, pg8::Unit& u) const {
        const long Lx = (long)i * G + c; if (Lx >= lim) return false;
        const int wgid = (int)Lx; const int nig = pg8::WGM * nN, gid = wgid / nig, fm = gid * pg8::WGM, gsz = (nM - fm) < pg8::WGM ? (nM - fm) : pg8::WGM;
        u.pm = fm + ((wgid % nig) % gsz); u.pn = (wgid % nig) / gsz; return true;
    }
    __device__ __forceinline__ void a_ready(const pg8::Unit&) const {}
    __device__ __forceinline__ void done(const pg8::Unit&) const {}
};
struct EpiSig2 {
    static constexpr bool PERM = true, AFTER_DRAIN = false;
    bf16_t* O1; bf16_t* O2;
    DI void operator()(EPI_ARGS) const {
        bf16_t* O = (u.pn < 8 ? O1 : O2) + (u.pn & 7) * 256;
        EPI_BEGIN
#pragma unroll
            for (int i = 0; i < 4; ++i) { v0[i] = sigmoidf_(v0[i]); v1[i] = sigmoidf_(v1[i]); }
            *(u32x4*)(O + (size_t)r * 2048 + cl) = pack_row8(v0, v1);
        EPI_END
    }
};
constexpr bool GEMM_ALIGN = true, GEMM_SP2 = true;
template <class Epi> DI void run_gemm(LAS unsigned char* lds, const bf16_t* A, const bf16_t* Bt, int N, int K, const Epi& E) {
    pg8::Gemm g{A, Bt, T, N, K}; pg8::StaticOrder S; S.init(T, N, (int)gridDim.x, (int)blockIdx.x);
    pg8::gemm_phase<Epi, pg8::StaticOrder, GEMM_ALIGN, GEMM_SP2>(lds, g, S, E);
}

#define REP_P0 1
#define REP_P1 1
#define REP_P3 1
#define REP_P6 1
#define REP_P9 1
#define REP_ATT 1
#define REP_PREP 1
#define REP_SCAN 1
__global__ void __launch_bounds__(512, 2) hybrid_fwd(Params p) {
    extern __shared__ __attribute__((aligned(16))) unsigned char lds_raw[];
    LAS unsigned char* lds = (LAS unsigned char*)lds_raw;
    cg::grid_group grid = cg::this_grid();
    int tid, lane, wave;
#define FRESH_IDS() do { int t_ = threadIdx.x; asm volatile("" : "+v"(t_)); tid = t_; lane = t_ & 63; wave = __builtin_amdgcn_readfirstlane(t_ >> 6); } while (0)
    FRESH_IDS();
    unsigned char* ws = p.ws;
    const float* MOD = (const float*)(ws + OFF_MOD);

    volatile LAS unsigned* xst = (volatile LAS unsigned*)(lds + LDS_BYTES - 16);
    if (tid < 2) xst[tid] = 0u;
    if (blockIdx.x == 0) { for (int i = tid; i < 4096; i += 512) __hip_atomic_store((unsigned*)ws + i, 0u, __ATOMIC_RELAXED, __HIP_MEMORY_SCOPE_AGENT); }
    for (int rep = 0; rep < REP_P0; ++rep) phase0(p, lds, tid, wave, lane);
    grid.sync(); FRESH_IDS();
    XcdBarrier xbar = xcd_barrier_post((unsigned*)ws, xst);
#define GRID_BAR() do { xcd_barrier(xbar); FRESH_IDS(); } while (0)
    for (int rep = 0; rep < REP_P1; ++rep) phase_modnorm(p.x, p.norm1_w, MOD, 0, 2048, (bf16_t*)(ws + OFF_H), wave, lane);
    GRID_BAR();
    { EpiIn E{(bf16_t*)(ws + OFF_QKV), (bf16_t*)(ws + OFF_Z), (bf16_t*)(ws + OFF_QSW), (bf16_t*)(ws + OFF_KVSW), (float*)(ws + OFF_BA), p.a_log, p.dt_bias};
      run_gemm(lds, (const bf16_t*)(ws + OFF_H), (const bf16_t*)(ws + OFF_WIN) + (size_t)4096 * 2048, 5888, 2048, E); }
    GRID_BAR();
    for (int rep = 0; rep < REP_P3; ++rep) phase_conv((const bf16_t*)(ws + OFF_QKV), p.conv_w, (bf16_t*)(ws + OFF_QC), (bf16_t*)(ws + OFF_KC), (bf16_t*)(ws + OFF_VC), wave, lane);
    phase_swa_normrope((bf16_t*)(ws + OFF_QSW), (bf16_t*)(ws + OFF_KVSW), p.qn_w, p.kn_w, lds, wave, lane);
    GRID_BAR();
    for (int rep = 0; rep < REP_ATT; ++rep) swa_block((const bf16_t*)(ws + OFF_QSW), (const bf16_t*)(ws + OFF_KVSW), p.sink, (bf16_t*)(ws + OFF_YSW), lds, tid, wave, lane);
    { PrepStage R; R.beta = 0.f; R.g = 0.f;
      if (blockIdx.x < 2048) prep_load(R, ws, blockIdx.x, tid, wave, lane);
      for (int it = blockIdx.x; it < 2048; it += gridDim.x) { const int nit = it + (int)gridDim.x; dn_prep_pair(ws, ws, lds, it, nit < 2048 ? nit : -1, R, tid, wave, lane); } }
    GRID_BAR();
    bf16_t* TG1 = (bf16_t*)p.out; bf16_t* TG2 = TG1 + (size_t)T * 2048;
    if (gridDim.x == 256) {
        const int bid = blockIdx.x;
        pg8::Gemm g{(const bf16_t*)(ws + OFF_H), (const bf16_t*)(ws + OFF_WIN), T, 4096, 2048}; EpiSig2 Eg{TG1, TG2};
        if (((bid >> 3) & 3) == 0) {
            for (int rep = 0; rep < REP_SCAN; ++rep) scan_item(ws, ws, lds, (bid >> 6) * 8 + (bid & 7), (bid >> 5) & 1, tid, wave, lane);
        } else {
            const int cv = bid - 8 * ((bid >> 5) + 1);
            SplitOrder S{64, 16, 192, cv, 1024};
            pg8::gemm_phase<EpiSig2, SplitOrder, GEMM_ALIGN, GEMM_SP2>(lds, g, S, Eg);
            asm volatile("s_waitcnt vmcnt(0)" ::: "memory"); __syncthreads();
            if (threadIdx.x == 0) { unsigned* cnt = (unsigned*)ws + 3584;
                __builtin_amdgcn_fence(__ATOMIC_RELEASE, "agent"); asm volatile("s_waitcnt vmcnt(0)" ::: "memory");
                __hip_atomic_fetch_add(cnt, 1u, __ATOMIC_RELAXED, __HIP_MEMORY_SCOPE_AGENT);
                unsigned sp = 0; while (__hip_atomic_load(cnt, __ATOMIC_RELAXED, __HIP_MEMORY_SCOPE_AGENT) < 192u && ++sp < (1u << 24)) __builtin_amdgcn_s_sleep(2);
                __builtin_amdgcn_fence(__ATOMIC_ACQUIRE, "agent"); asm volatile("s_waitcnt vmcnt(0)" ::: "memory"); }
            __syncthreads(); FRESH_IDS();
            { pg8::Gemm gb{(const bf16_t*)(ws + OFF_YSW), (const bf16_t*)(ws + OFF_WSW), T, 2048, 1024}; const SplitOrder Sb = cv < 64 ? SplitOrder{64, 8, 64, 384 + cv, 512} : SplitOrder{64, 8, 128, cv - 64, 384};
              EpiMerge<false> Eb{TG2, nullptr, TG2}; pg8::gemm_phase<EpiMerge<false>, SplitOrder, GEMM_ALIGN, GEMM_SP2>(lds, gb, Sb, Eb); }
        }
    } else {
        for (int d = blockIdx.x; d < 64; d += gridDim.x) scan_item(ws, ws, lds, d >> 1, d & 1, tid, wave, lane);
        { EpiSig Eg{TG1, 2048}; run_gemm(lds, (const bf16_t*)(ws + OFF_H), (const bf16_t*)(ws + OFF_WIN), 2048, 2048, Eg); }
        { EpiSig Eg{TG2, 2048}; run_gemm(lds, (const bf16_t*)(ws + OFF_H), (const bf16_t*)(ws + OFF_WIN) + (size_t)2048 * 2048, 2048, 2048, Eg); }
        { EpiMerge<false> Eb{TG2, nullptr, TG2}; run_gemm(lds, (const bf16_t*)(ws + OFF_YSW), (const bf16_t*)(ws + OFF_WSW), 2048, 1024, Eb); }
    }
    GRID_BAR();
    for (int rep = 0; rep < REP_P6; ++rep) phase_gated_norm((const bf16_t*)(ws + OFF_OF), (const bf16_t*)(ws + OFF_OB), (const bf16_t*)(ws + OFF_Z), p.dn_norm_w, (bf16_t*)(ws + OFF_YDN), wave, lane);
    GRID_BAR();
    { EpiMerge<true> Ea{TG1, TG2, (bf16_t*)(ws + OFF_MRG)};
      run_gemm(lds, (const bf16_t*)(ws + OFF_YDN), (const bf16_t*)(ws + OFF_WDN), 2048, 1024, Ea); }
    GRID_BAR();
    { EpiRes E{p.x, MOD + 4096, p.out};
      run_gemm(lds, (const bf16_t*)(ws + OFF_MRG), (const bf16_t*)(ws + OFF_WOUT), 2048, 2048, E); }
    GRID_BAR();
    for (int rep = 0; rep < REP_P9; ++rep) { phase_modnorm(p.out, p.norm2_w, MOD, 6144, 8192, (bf16_t*)(ws + OFF_H), wave, lane);
    phase_mlp_weights(p, lds, wave, lane); }
    GRID_BAR();
    { EpiRelu2 E{(bf16_t*)(ws + OFF_UU), 8192};
      run_gemm(lds, (const bf16_t*)(ws + OFF_H), (const bf16_t*)(ws + OFF_WMI), 8192, 2048, E); }
    GRID_BAR();
    { EpiRes E{p.out, MOD + 10240, p.out};
      run_gemm(lds, (const bf16_t*)(ws + OFF_UU), (const bf16_t*)(ws + OFF_WMO), 2048, 8192, E); }
}

extern "C" void kernel_launch(void* const* d_in, const int* in_sizes, int n_in, void* d_out, int out_size, void* d_ws, size_t ws_size, hipStream_t stream) {
    static int grid_blocks = 0;
    if (grid_blocks == 0) {
        if (n_in != 19 || out_size != T * D || ws_size < WS_END) { fprintf(stderr, "kernel_launch: unexpected shapes (n_in %d out %d ws %zu)\n", n_in, out_size, ws_size); grid_blocks = -1; return; }
        int dev = 0, cus = 0, per_cu = 0;
        hipGetDevice(&dev); hipDeviceGetAttribute(&cus, hipDeviceAttributeMultiprocessorCount, dev);
        hipFuncSetAttribute((const void*)hybrid_fwd, hipFuncAttributeMaxDynamicSharedMemorySize, LDS_BYTES);
        hipOccupancyMaxActiveBlocksPerMultiprocessor(&per_cu, (const void*)hybrid_fwd, 512, LDS_BYTES);
        if (per_cu < 1) { fprintf(stderr, "kernel_launch: occupancy query says %d blocks/CU\n", per_cu); per_cu = 1; }
        (void)hipGetLastError();
        grid_blocks = cus * per_cu;
    }
    if (grid_blocks < 0) return;
    Params p{};
    p.x = (const float*)d_in[0]; p.c = (const float*)d_in[1]; p.w_ada = (const float*)d_in[2]; p.b_ada = (const float*)d_in[3]; p.norm1_w = (const float*)d_in[4];
    p.w_in = (const float*)d_in[5]; p.conv_w = (const float*)d_in[6]; p.a_log = (const float*)d_in[7]; p.dt_bias = (const float*)d_in[8]; p.dn_norm_w = (const float*)d_in[9];
    p.w_dn = (const float*)d_in[10]; p.qn_w = (const float*)d_in[11]; p.kn_w = (const float*)d_in[12]; p.sink = (const float*)d_in[13]; p.w_sw = (const float*)d_in[14];
    p.w_out = (const float*)d_in[15]; p.norm2_w = (const float*)d_in[16]; p.w_mi = (const float*)d_in[17]; p.w_mo = (const float*)d_in[18];
    p.out = (float*)d_out; p.ws = (unsigned char*)d_ws;
    void* args[] = {&p};
    hipError_t e = hipLaunchCooperativeKernel((const void*)hybrid_fwd, dim3(grid_blocks), dim3(512), args, LDS_BYTES, stream);
    if (e != hipSuccess) fprintf(stderr, "cooperative launch failed: %s (grid %d)\n", hipGetErrorString(e), grid_blocks);
}
```

```cpp
#include <hip/hip_runtime.h>
#include <hip/hip_cooperative_groups.h>
#include <cstdio>
#include <cstdint>
namespace cg = cooperative_groups;

namespace pg8 {
#define PG8_LAS __attribute__((address_space(3)))
typedef unsigned short bf16_t;
typedef short bf16x8 __attribute__((ext_vector_type(8)));
typedef float f32x4 __attribute__((ext_vector_type(4)));
typedef unsigned u32x4 __attribute__((ext_vector_type(4)));
constexpr int BM = 256, BK = 64, HALF = 128, HTB = HALF * BK * 2  , STAGE_BYTES = 8 * HTB, NXCD = 8, WGM = 4;

__host__ __device__ __forceinline__ int lds_byte(int r, int c) { const int st = (r >> 4) * 2 + (c >> 5), rr = r & 15, cc = c & 31, ob = rr * 64 + cc * 2; return st * 1024 + (ob ^ (((ob >> 9) & 1) << 5)); }
__host__ __device__ __forceinline__ void stage_rc(int b, int& R, int& C) { const int st = b / 1024, sb = b % 1024, swz = sb ^ (((sb >> 9) & 1) << 5); R = (st >> 1) * 16 + swz / 64; C = (st & 1) * 32 + (swz % 64) / 2; }
__host__ __device__ __forceinline__ int perm32(int rho) { const int n = rho >> 4, i = rho & 15; return 8 * (i >> 2) + 4 * n + (i & 3); }

struct Unit { int pm, pn; };
struct Gemm { const bf16_t* A; const bf16_t* Bt; int M, N, K; };

struct StaticOrder {
    int nM, nN, nwg, G, c;
    __host__ __device__ void init(int M, int N, int G_, int c_) { nM = M / BM; nN = N / BM; nwg = nM * nN; G = G_; c = c_; }
    __host__ __device__ bool next(int i, Unit& u) const {
        const long L = (long)i * G + c; if (L >= nwg) return false;
        int wgid = (int)L; { const int q = nwg / NXCD, r = nwg % NXCD, xcd = wgid % NXCD, off = wgid / NXCD; wgid = (xcd < r ? xcd * (q + 1) : r * (q + 1) + (xcd - r) * q) + off; }
        const int nig = WGM * nN, gid = wgid / nig, fm = gid * WGM, gsz = (nM - fm) < WGM ? (nM - fm) : WGM;
        u.pm = fm + ((wgid % nig) % gsz); u.pn = (wgid % nig) / gsz; return true;
    }
    __device__ __forceinline__ void a_ready(const Unit&) const {}
    __device__ __forceinline__ void done(const Unit&) const {}
};
typedef float f32x2v __attribute__((ext_vector_type(2)));
typedef __bf16 bf16x2v __attribute__((ext_vector_type(2)));
__device__ __forceinline__ unsigned cvt_pk_bf16(float lo, float hi) { const f32x2v v = {lo, hi}; return __builtin_bit_cast(unsigned, __builtin_convertvector(v, bf16x2v)); }

template <class Epi, class Sched, bool ALIGN_EPI = false, bool SP2 = false>
__device__ __forceinline__ void gemm_phase(PG8_LAS unsigned char* lds, const Gemm g, const Sched& S, const Epi& E) {
    int tid_l = threadIdx.x; asm volatile("" : "+v"(tid_l));
    const int tid = tid_l, wid = __builtin_amdgcn_readfirstlane(tid >> 6), lane = tid & 63, wr = wid >> 2, wc = wid & 3, fr = lane & 15, fq = lane >> 4;
    const int K = g.K, nt = K / BK;
    unsigned voffA[2], voffB[2];
#pragma unroll
    for (int i = 0; i < 2; ++i) { int R, C; stage_rc(tid * 16 + i * 8192, R, C); const int Rb = Epi::PERM ? ((R & ~31) + perm32(R & 31)) : R;
        voffA[i] = (unsigned)(R * K + C) * 2u; voffB[i] = (unsigned)(Rb * K + C) * 2u; }
    const size_t kstep = (size_t)(BK * 2);
    const size_t hstep = (size_t)HALF * K * 2;
    const size_t tstep = 2 * hstep;
    const unsigned ldsw = (unsigned)wid * 1024u;
    const int aoff = lds_byte(wr * 64 + fr, fq * 8), boff = lds_byte(wc * 32 + fr, fq * 8);
#define PG8_SA(b, h) (((b) * 2 + (h)) * HTB)
#define PG8_SB(b, h) ((4 + (b) * 2 + (h)) * HTB)
#define PG8_STAGE(bufoff, gbase, voff) do { _Pragma("unroll") for (int _i = 0; _i < 2; ++_i) \
        __builtin_amdgcn_global_load_lds((const unsigned*)((const char*)(gbase) + (voff)[_i]), (PG8_LAS unsigned*)(lds + (bufoff) + ldsw + _i * 8192), 16, 0, 0); } while (0)
#define PG8_LDA(dst, b, h) do { _Pragma("unroll") for (int m = 0; m < 4; ++m) _Pragma("unroll") for (int k = 0; k < 2; ++k) dst[m][k] = *(const PG8_LAS bf16x8*)(lds + PG8_SA(b, h) + aoff + m * 2048 + k * 1024); } while (0)
#define PG8_LDB(dst, b, h) do { _Pragma("unroll") for (int n = 0; n < 2; ++n) _Pragma("unroll") for (int k = 0; k < 2; ++k) dst[n][k] = *(const PG8_LAS bf16x8*)(lds + PG8_SB(b, h) + boff + n * 2048 + k * 1024); } while (0)
#define PG8_MMA(ai, bj, At, Bt) do { __builtin_amdgcn_s_setprio(1); _Pragma("unroll") for (int m = 0; m < 4; ++m) _Pragma("unroll") for (int n = 0; n < 2; ++n) _Pragma("unroll") for (int k = 0; k < 2; ++k) \
        acc[ai][bj][m][n] = __builtin_amdgcn_mfma_f32_16x16x32_bf16(Bt[n][k], At[m][k], acc[ai][bj][m][n], 0, 0, 0); __builtin_amdgcn_s_setprio(0); } while (0)
#define PG8_WAIT_V(n) asm volatile("s_waitcnt vmcnt(" #n ")" ::: "memory")
#define PG8_WAIT_L(n) asm volatile("s_waitcnt lgkmcnt(" #n ")" ::: "memory")
#define PG8_BAR __builtin_amdgcn_s_barrier()
#define PG8_SCHED __builtin_amdgcn_sched_barrier(0)
    Unit cur, nxt; int ui = 0;
    if (!S.next(0, cur)) return;
    f32x4 acc[2][2][4][2];
#pragma unroll
    for (int a = 0; a < 2; ++a)
#pragma unroll
        for (int b = 0; b < 2; ++b)
#pragma unroll
            for (int m = 0; m < 4; ++m)
#pragma unroll
                for (int n = 0; n < 2; ++n) acc[a][b][m][n] = (f32x4){0.f, 0.f, 0.f, 0.f};
    bf16x8 At[4][2], B0[2][2], B1[2][2];
    const char* cA = (const char*)g.A + (size_t)cur.pm * tstep; const char* cB = (const char*)g.Bt + (size_t)cur.pn * tstep;
    S.a_ready(cur);
    if constexpr (SP2) {
        PG8_STAGE(PG8_SB(0, 0), cB, voffB); PG8_STAGE(PG8_SB(0, 1), cB + hstep, voffB); PG8_STAGE(PG8_SA(0, 0), cA, voffA); PG8_STAGE(PG8_SA(0, 1), cA + hstep, voffA);
        if (wr == 1) PG8_BAR;
        PG8_WAIT_V(2); PG8_BAR;
        PG8_STAGE(PG8_SB(1, 0), cB + kstep, voffB); PG8_STAGE(PG8_SA(1, 0), cA + kstep, voffA); PG8_STAGE(PG8_SB(1, 1), cB + hstep + kstep, voffB);
        PG8_WAIT_V(6); PG8_BAR;
    } else {
        PG8_STAGE(PG8_SB(0, 0), cB, voffB); PG8_STAGE(PG8_SA(0, 0), cA, voffA); PG8_STAGE(PG8_SB(0, 1), cB + hstep, voffB); PG8_STAGE(PG8_SA(0, 1), cA + hstep, voffA);
        if (wr == 1) PG8_BAR;
        PG8_WAIT_V(4); PG8_BAR;
        PG8_STAGE(PG8_SB(1, 0), cB + kstep, voffB); PG8_STAGE(PG8_SA(1, 0), cA + kstep, voffA); PG8_STAGE(PG8_SB(1, 1), cB + hstep + kstep, voffB);
        PG8_WAIT_V(6); PG8_BAR;
    }
    for (;;) {
        const bool has_next = S.next(ui + 1, nxt);
        const char* nA = has_next ? (const char*)g.A + (size_t)nxt.pm * tstep : cA; const char* nB = has_next ? (const char*)g.Bt + (size_t)nxt.pn * tstep : cB;
        for (int t = 0; t < nt; t += 2) {
            const bool last = (t == nt - 2);
            const char* a1 = cA + (size_t)(t + 1) * kstep;
            const char* a2 = last ? nA : cA + (size_t)(t + 2) * kstep; const char* b2 = last ? nB : cB + (size_t)(t + 2) * kstep;
            const char* a3 = a2 + kstep; const char* b3 = b2 + kstep;
            if (last && has_next) S.a_ready(nxt);
            if constexpr (SP2) {
            PG8_LDB(B0, 0, 0); PG8_LDB(B1, 0, 1); PG8_SCHED; PG8_LDA(At, 0, 0); PG8_STAGE(PG8_SA(1, 1), a1 + hstep, voffA);
            PG8_WAIT_V(8); PG8_WAIT_L(0); PG8_BAR; PG8_MMA(0, 0, At, B0); PG8_MMA(0, 1, At, B1); PG8_BAR; PG8_SCHED;
            PG8_LDA(At, 0, 1); PG8_STAGE(PG8_SB(0, 0), b2, voffB); PG8_STAGE(PG8_SB(0, 1), b2 + hstep, voffB); PG8_STAGE(PG8_SA(0, 0), a2, voffA);
            PG8_WAIT_V(8); PG8_WAIT_L(0); PG8_BAR; PG8_MMA(1, 0, At, B0); PG8_MMA(1, 1, At, B1); PG8_BAR; PG8_SCHED;
            PG8_LDB(B0, 1, 0); PG8_LDB(B1, 1, 1); PG8_SCHED; PG8_LDA(At, 1, 0); PG8_STAGE(PG8_SA(0, 1), a2 + hstep, voffA);
            PG8_WAIT_V(8); PG8_WAIT_L(0); PG8_BAR; PG8_MMA(0, 0, At, B0); PG8_MMA(0, 1, At, B1); PG8_BAR; PG8_SCHED;
            PG8_LDA(At, 1, 1); PG8_STAGE(PG8_SB(1, 0), b3, voffB); PG8_STAGE(PG8_SB(1, 1), b3 + hstep, voffB); PG8_STAGE(PG8_SA(1, 0), a3, voffA);
            PG8_WAIT_V(8); PG8_WAIT_L(0); PG8_BAR; PG8_MMA(1, 0, At, B0); PG8_MMA(1, 1, At, B1); PG8_BAR; PG8_SCHED;
            } else {
            PG8_LDB(B0, 0, 0); PG8_SCHED; PG8_LDA(At, 0, 0); PG8_STAGE(PG8_SA(1, 1), a1 + hstep, voffA);
            PG8_WAIT_L(8); PG8_BAR; PG8_WAIT_L(0); PG8_MMA(0, 0, At, B0); PG8_BAR; PG8_SCHED;
            PG8_LDB(B1, 0, 1); PG8_STAGE(PG8_SB(0, 0), b2, voffB);
            PG8_BAR; PG8_WAIT_L(0); PG8_MMA(0, 1, At, B1); PG8_BAR;
            PG8_LDA(At, 0, 1); PG8_STAGE(PG8_SA(0, 0), a2, voffA);
            PG8_BAR; PG8_WAIT_L(0); PG8_MMA(1, 0, At, B0); PG8_BAR; PG8_SCHED;
            PG8_STAGE(PG8_SB(0, 1), b2 + hstep, voffB);
            PG8_WAIT_V(6); PG8_BAR; PG8_MMA(1, 1, At, B1); PG8_BAR;
            PG8_LDB(B0, 1, 0); PG8_SCHED; PG8_LDA(At, 1, 0); PG8_STAGE(PG8_SA(0, 1), a2 + hstep, voffA);
            PG8_WAIT_L(8); PG8_BAR; PG8_WAIT_L(0); PG8_MMA(0, 0, At, B0); PG8_BAR; PG8_SCHED;
            PG8_LDB(B1, 1, 1); PG8_STAGE(PG8_SB(1, 0), b3, voffB);
            PG8_BAR; PG8_WAIT_L(0); PG8_MMA(0, 1, At, B1); PG8_BAR;
            PG8_LDA(At, 1, 1); PG8_STAGE(PG8_SA(1, 0), a3, voffA);
            PG8_BAR; PG8_WAIT_L(0); PG8_MMA(1, 0, At, B0); PG8_BAR; PG8_SCHED;
            PG8_STAGE(PG8_SB(1, 1), b3 + hstep, voffB);
            PG8_WAIT_V(6); PG8_BAR; PG8_MMA(1, 1, At, B1); PG8_BAR;
            }
        }
        if constexpr (ALIGN_EPI) { if (wr == 0) PG8_BAR; }
        if constexpr (!Epi::AFTER_DRAIN) { E(acc, cur, wr, wc, fr, fq); S.done(cur); }
        if (!has_next) break;
#pragma unroll
        for (int a = 0; a < 2; ++a)
#pragma unroll
            for (int b = 0; b < 2; ++b)
#pragma unroll
                for (int m = 0; m < 4; ++m)
#pragma unroll
                    for (int n = 0; n < 2; ++n) acc[a][b][m][n] = (f32x4){0.f, 0.f, 0.f, 0.f};
        cur = nxt; cA = nA; cB = nB; ++ui;
        if constexpr (ALIGN_EPI) { if (wr == 1) PG8_BAR; }
    }
    PG8_WAIT_V(0);
    if constexpr (!ALIGN_EPI) { if (wr == 0) PG8_BAR; }
    PG8_BAR;
    if constexpr (Epi::AFTER_DRAIN) { E.fused(acc, cur, wr, wc, fr, fq, lds, wid, lane); S.done(cur); }
#undef PG8_SA
#undef PG8_SB
#undef PG8_STAGE
#undef PG8_LDA
#undef PG8_LDB
#undef PG8_MMA
#undef PG8_WAIT_V
#undef PG8_WAIT_L
#undef PG8_BAR
#undef PG8_SCHED
}
}

#define DI __device__ __forceinline__
#define LAS __attribute__((address_space(3)))
using pg8::bf16_t; using pg8::bf16x8; using pg8::f32x4; using pg8::u32x4;
typedef unsigned u32x2 __attribute__((ext_vector_type(2)));
typedef short s16x4 __attribute__((ext_vector_type(4)));
typedef float f32x2 __attribute__((ext_vector_type(2)));

constexpr int T = 16384, L = 8192, D = 2048;
constexpr float EPS = 1e-6f;
constexpr size_t MiB = 1u << 20;
constexpr size_t OFF_MOD = 65536, OFF_BA = 1 * MiB, OFF_GC = 3 * MiB, OFF_EGL = 5 * MiB,
    OFF_WDN = 8 * MiB, OFF_WSW = 12 * MiB, OFF_WOUT = 16 * MiB, OFF_WIN = 24 * MiB, OFF_H = 64 * MiB, OFF_Z = 128 * MiB, OFF_QSW = 160 * MiB, OFF_KVSW = 192 * MiB,
    OFF_QKV = 208 * MiB, OFF_QC = 304 * MiB, OFF_KC = 336 * MiB, OFF_VC = 368 * MiB, OFF_YSW = 400 * MiB,
    OFF_W = 208 * MiB, OFF_A = 272 * MiB, OFF_U = 432 * MiB, OFF_OF = 368 * MiB, OFF_OB = 160 * MiB, OFF_YDN = 208 * MiB, OFF_TG = 240 * MiB, OFF_MRG = 304 * MiB,
    OFF_WMI = 128 * MiB, OFF_WMO = 160 * MiB, OFF_UU = 208 * MiB, WS_END = 496 * MiB;
constexpr int LDS_BYTES = 160 * 1024;

struct Params {
    const float *x, *c, *w_ada, *b_ada, *norm1_w, *w_in, *conv_w, *a_log, *dt_bias, *dn_norm_w, *w_dn, *qn_w, *kn_w, *sink, *w_sw, *w_out, *norm2_w, *w_mi, *w_mo;
    float* out; unsigned char* ws;
};

DI float bflo(unsigned u) { return __uint_as_float(u << 16); }
DI float bfhi(unsigned u) { return __uint_as_float(u & 0xffff0000u); }
DI float bf2f(unsigned short u) { return __uint_as_float(((unsigned)u) << 16); }
DI unsigned short f2bf(float f) { unsigned u = __float_as_uint(f); return (unsigned short)((u + 0x7fffu + ((u >> 16) & 1u)) >> 16); }
DI unsigned pk2(float lo, float hi) { return pg8::cvt_pk_bf16(lo, hi); }
DI float wave_sum(float v) {
#pragma unroll
    for (int o = 1; o < 64; o <<= 1) v += __shfl_xor(v, o);
    return v;
}
DI float sigmoidf_(float x) { return 1.f / (1.f + __expf(-x)); }
DI float siluf_(float x) { return x / (1.f + __expf(-x)); }
DI f32x4 mfma16(bf16x8 a, bf16x8 b, f32x4 c) { return __builtin_amdgcn_mfma_f32_16x16x32_bf16(a, b, c, 0, 0, 0); }
DI bf16x8 pack8(f32x4 a, f32x4 b) { u32x4 p; p.x = pk2(a[0], a[1]); p.y = pk2(a[2], a[3]); p.z = pk2(b[0], b[1]); p.w = pk2(b[2], b[3]); return __builtin_bit_cast(bf16x8, p); }
DI bf16x8 cat4(s16x4 lo, s16x4 hi) { return __builtin_shufflevector(lo, hi, 0, 1, 2, 3, 4, 5, 6, 7); }
#define LDS_WAIT() asm volatile("s_waitcnt lgkmcnt(0)" ::: "memory")
DI void fpma(float& acc, float a, float t) { asm("v_fma_f32 %0, %1, %2, %0" : "+v"(acc) : "v"(a), "v"(t)); }
DI void fnma(float& acc, float a, float t) { asm("v_fma_f32 %0, -%1, %2, %0" : "+v"(acc) : "v"(a), "v"(t)); }
DI s16x4 tr_read(const LAS bf16_t* p) { return __builtin_amdgcn_ds_read_tr16_b64_v4i16((LAS s16x4*)p); }

DI void transpose_item(const float* W, int K, int N, bf16_t* WT, int k0, int n0, int dst_row0, int ncols, LAS float* scr, int lane) {
    const int sub = lane >> 4, c4 = lane & 15;
    f32x4 v[16];
    if (4 * c4 < ncols) {
#pragma unroll
        for (int i = 0; i < 16; ++i) v[i] = *(const f32x4*)(W + (size_t)(k0 + 4 * i + sub) * N + n0 + 4 * c4);
#pragma unroll
        for (int i = 0; i < 16; ++i) { LAS float* d = scr + (4 * i + sub) * 65 + 4 * c4; d[0] = v[i][0]; d[1] = v[i][1]; d[2] = v[i][2]; d[3] = v[i][3]; }
    }
    LDS_WAIT();
    const int c = lane & 7;
#pragma unroll
    for (int j = 0; j < 8; ++j) { const int n = (lane >> 3) + 8 * j; const LAS float* s = scr + (8 * c) * 65 + n;
        if (n < ncols) { u32x4 o; o.x = pk2(s[0 * 65], s[1 * 65]); o.y = pk2(s[2 * 65], s[3 * 65]); o.z = pk2(s[4 * 65], s[5 * 65]); o.w = pk2(s[6 * 65], s[7 * 65]);
            *(u32x4*)(WT + (size_t)(dst_row0 + n) * K + k0 + 8 * c) = o; } }
    LDS_WAIT();
}
DI void win_tile(int t, int& n0, int& dst, int& ncols) {
    if (t < 64) { n0 = 64 * t; dst = 4096 + n0; ncols = 64; }
    else if (t < 88) { n0 = 4128 + 64 * (t - 64); dst = 8192 + 64 * (t - 64); ncols = 64; }
    else if (t < 152) { n0 = 5664 + 64 * (t - 88); dst = 64 * (t - 88); ncols = 64; }
    else { n0 = 4096; dst = 9728; ncols = 32; }
}

DI void phase0(const Params& p, LAS unsigned char* lds, int tid, int wave, int lane) {
    unsigned char* ws = p.ws;
    if (blockIdx.x < 192) {
        LAS float* sc = (LAS float*)lds; LAS float* red = sc + 4096;
        for (int i = tid; i < 4096; i += 512) sc[i] = siluf_(p.c[i]);
        __syncthreads();
        const int col = blockIdx.x * 64 + lane; float a0 = 0.f, a1 = 0.f;
        const float* wp = p.w_ada + (size_t)(wave * 256) * 12288 + col;
#pragma unroll 32
        for (int k = 0; k < 256; ++k) { const float w = wp[(size_t)k * 12288]; a0 += sc[wave * 256 + k] * w; a1 += sc[2048 + wave * 256 + k] * w; }
        red[(wave * 2 + 0) * 64 + lane] = a0; red[(wave * 2 + 1) * 64 + lane] = a1;
        __syncthreads();
        if (wave < 2) { float s = 0.f;
#pragma unroll
            for (int w = 0; w < 8; ++w) s += red[(w * 2 + wave) * 64 + lane];
            ((float*)(ws + OFF_MOD))[wave * 12288 + col] = s + p.b_ada[col]; }
        __syncthreads();
    }
    LAS float* scr = (LAS float*)(lds + wave * 16640);
    const int gw = blockIdx.x * 8 + wave, NGW = gridDim.x * 8;
    constexpr int I_IN = 32 * 153, I_DN = 16 * 32, I_OUT = 32 * 32;
    for (int it = gw; it < I_IN + 2 * I_DN + I_OUT; it += NGW) {
        int r = it;
        if (r < I_IN) { int n0, dst, nc; win_tile(r % 153, n0, dst, nc); transpose_item(p.w_in, 2048, 9760, (bf16_t*)(ws + OFF_WIN), 64 * (r / 153), n0, dst, nc, scr, lane); continue; } r -= I_IN;
        if (r < I_DN) { transpose_item(p.w_dn, 1024, 2048, (bf16_t*)(ws + OFF_WDN), 64 * (r / 32), 64 * (r % 32), 64 * (r % 32), 64, scr, lane); continue; } r -= I_DN;
        if (r < I_DN) { transpose_item(p.w_sw, 1024, 2048, (bf16_t*)(ws + OFF_WSW), 64 * (r / 32), 64 * (r % 32), 64 * (r % 32), 64, scr, lane); continue; } r -= I_DN;
        transpose_item(p.w_out, 2048, 2048, (bf16_t*)(ws + OFF_WOUT), 64 * (r / 32), 64 * (r % 32), 64 * (r % 32), 64, scr, lane);
    }
    { u32x4* z = (u32x4*)((bf16_t*)(ws + OFF_WIN) + (size_t)9760 * 2048); const u32x4 zero = {0u, 0u, 0u, 0u};
      for (int i = blockIdx.x * 512 + tid; i < 57344; i += gridDim.x * 512) z[i] = zero; }
}
DI void phase_mlp_weights(const Params& p, LAS unsigned char* lds, int wave, int lane) {
    LAS float* scr = (LAS float*)(lds + wave * 16640);
    const int gw = blockIdx.x * 8 + wave, NGW = gridDim.x * 8;
    constexpr int I_MI = 32 * 128, I_MO = 128 * 32;
    for (int it = gw; it < I_MI + I_MO; it += NGW) {
        int r = it;
        if (r < I_MI) { transpose_item(p.w_mi, 2048, 8192, (bf16_t*)(p.ws + OFF_WMI), 64 * (r / 128), 64 * (r % 128), 64 * (r % 128), 64, scr, lane); continue; } r -= I_MI;
        transpose_item(p.w_mo, 8192, 2048, (bf16_t*)(p.ws + OFF_WMO), 64 * (r / 32), 64 * (r % 32), 64 * (r % 32), 64, scr, lane);
    }
}

DI void phase_modnorm(const float* x, const float* normw, const float* mod, int shift_off, int scale_off, bf16_t* H, int wave, int lane) {
    const int gw = blockIdx.x * 8 + wave, NGW = gridDim.x * 8;
    for (int m0 = 2 * gw; m0 < T; m0 += 2 * NGW) {
        const int b = m0 >> 13;
        const f32x4* xr = (const f32x4*)(x + (size_t)m0 * D) + lane;
        f32x4 v[2][8]; float s[2] = {0.f, 0.f};
#pragma unroll
        for (int r = 0; r < 2; ++r)
#pragma unroll
            for (int j = 0; j < 8; ++j) v[r][j] = xr[r * (D / 4) + 64 * j];
#pragma unroll
        for (int r = 0; r < 2; ++r)
#pragma unroll
            for (int j = 0; j < 8; ++j) s[r] += (v[r][j][0] * v[r][j][0] + v[r][j][1] * v[r][j][1]) + (v[r][j][2] * v[r][j][2] + v[r][j][3] * v[r][j][3]);
        const float rstd0 = rsqrtf(wave_sum(s[0]) * (1.f / D) + EPS), rstd1 = rsqrtf(wave_sum(s[1]) * (1.f / D) + EPS);
        u32x2* o = (u32x2*)(H + (size_t)m0 * D) + lane;
#pragma unroll
        for (int j = 0; j < 8; ++j) { const int col = 256 * j + 4 * lane;
            const f32x4 nw = *(const f32x4*)(normw + col), sc = *(const f32x4*)(mod + b * 12288 + scale_off + col), sh = *(const f32x4*)(mod + b * 12288 + shift_off + col);
            f32x4 a;
#pragma unroll
            for (int i = 0; i < 4; ++i) a[i] = nw[i] * (1.f + sc[i]);
            u32x2 w0, w1;
            w0.x = pk2(v[0][j][0] * rstd0 * a[0] + sh[0], v[0][j][1] * rstd0 * a[1] + sh[1]); w0.y = pk2(v[0][j][2] * rstd0 * a[2] + sh[2], v[0][j][3] * rstd0 * a[3] + sh[3]);
            w1.x = pk2(v[1][j][0] * rstd1 * a[0] + sh[0], v[1][j][1] * rstd1 * a[1] + sh[1]); w1.y = pk2(v[1][j][2] * rstd1 * a[2] + sh[2], v[1][j][3] * rstd1 * a[3] + sh[3]);
            o[64 * j] = w0; o[D / 4 + 64 * j] = w1; }
    }
}

#define EPI_ARGS const f32x4 (&acc)[2][2][4][2], const pg8::Unit& u, int wr, int wc, int fr, int fq
#define EPI_BEGIN _Pragma("unroll") for (int ai = 0; ai < 2; ++ai) _Pragma("unroll") for (int m = 0; m < 4; ++m) { const int r = u.pm * 256 + ai * 128 + wr * 64 + m * 16 + fr; \
    _Pragma("unroll") for (int bj = 0; bj < 2; ++bj) { const int cl = bj * 128 + wc * 32 + 8 * fq; f32x4 v0 = acc[ai][bj][m][0], v1 = acc[ai][bj][m][1];
#define EPI_END } }
DI u32x4 pack_row8(f32x4 a, f32x4 b) { u32x4 o; o.x = pk2(a[0], a[1]); o.y = pk2(a[2], a[3]); o.z = pk2(b[0], b[1]); o.w = pk2(b[2], b[3]); return o; }

struct EpiIn {
    static constexpr bool PERM = true, AFTER_DRAIN = false;
    bf16_t *qkv, *z, *qsw, *kvsw; float* ba; const float* a_log; const float* dt_bias;
    DI void operator()(EPI_ARGS) const {
        const int pn = u.pn;
        if (pn < 22) {
            bf16_t* base; int ldc, c0; bool act = false;
            if (pn < 12) { base = qkv; ldc = 3072; c0 = pn * 256; }
            else if (pn < 16) { base = z; ldc = 1024; c0 = (pn - 12) * 256; act = true; }
            else if (pn < 20) { base = qsw; ldc = 1024; c0 = (pn - 16) * 256; }
            else { base = kvsw; ldc = 512; c0 = (pn - 20) * 256; }
            EPI_BEGIN
                if (act) {
#pragma unroll
                    for (int i = 0; i < 4; ++i) { v0[i] = siluf_(v0[i]); v1[i] = siluf_(v1[i]); } }
                *(u32x4*)(base + (size_t)r * ldc + c0 + cl) = pack_row8(v0, v1);
            EPI_END
        } else if (wc == 0) {
            const int j0 = (fq & 1) * 8;
            f32x4 al0 = {0, 0, 0, 0}, al1 = al0, db0 = al0, db1 = al0;
            if (fq >= 2) { al0 = *(const f32x4*)(a_log + j0); al1 = *(const f32x4*)(a_log + j0 + 4); db0 = *(const f32x4*)(dt_bias + j0); db1 = *(const f32x4*)(dt_bias + j0 + 4); }
#pragma unroll
            for (int ai = 0; ai < 2; ++ai)
#pragma unroll
                for (int m = 0; m < 4; ++m) { const int r = u.pm * 256 + ai * 128 + wr * 64 + m * 16 + fr;
                    f32x4 v0 = acc[ai][0][m][0], v1 = acc[ai][0][m][1];
                    if (fq < 2) {
#pragma unroll
                        for (int i = 0; i < 4; ++i) { v0[i] = sigmoidf_(v0[i]); v1[i] = sigmoidf_(v1[i]); }
                    } else {
#pragma unroll
                        for (int i = 0; i < 4; ++i) {
                            float a = v0[i] + db0[i]; float sp = fmaxf(a, 0.f) + log1pf(__expf(-fabsf(a))); v0[i] = -__expf(al0[i]) * sp;
                            a = v1[i] + db1[i]; sp = fmaxf(a, 0.f) + log1pf(__expf(-fabsf(a))); v1[i] = -__expf(al1[i]) * sp; }
                    }
                    *(f32x4*)(ba + (size_t)r * 32 + 8 * fq) = v0; *(f32x4*)(ba + (size_t)r * 32 + 8 * fq + 4) = v1; }
        }
    }
};
struct EpiSig {
    static constexpr bool PERM = true, AFTER_DRAIN = false;
    bf16_t* O; int ldc;
    DI void operator()(EPI_ARGS) const {
        EPI_BEGIN
#pragma unroll
            for (int i = 0; i < 4; ++i) { v0[i] = sigmoidf_(v0[i]); v1[i] = sigmoidf_(v1[i]); }
            *(u32x4*)(O + (size_t)r * ldc + u.pn * 256 + cl) = pack_row8(v0, v1);
        EPI_END
    }
};
template <bool ADD> struct EpiMerge {
    static constexpr bool PERM = true, AFTER_DRAIN = false;
    const bf16_t* TG; const bf16_t* ADDEND; bf16_t* OUT;
    DI void operator()(EPI_ARGS) const {
        EPI_BEGIN
            const size_t off = (size_t)r * 2048 + u.pn * 256 + cl;
            const u32x4 g = *(const u32x4*)(TG + off);
            v0[0] *= bflo(g.x); v0[1] *= bfhi(g.x); v0[2] *= bflo(g.y); v0[3] *= bfhi(g.y); v1[0] *= bflo(g.z); v1[1] *= bfhi(g.z); v1[2] *= bflo(g.w); v1[3] *= bfhi(g.w);
            if (ADD) { const u32x4 o = *(const u32x4*)(ADDEND + off);
                v0[0] += bflo(o.x); v0[1] += bfhi(o.x); v0[2] += bflo(o.y); v0[3] += bfhi(o.y); v1[0] += bflo(o.z); v1[1] += bfhi(o.z); v1[2] += bflo(o.w); v1[3] += bfhi(o.w); }
            *(u32x4*)(OUT + off) = pack_row8(v0, v1);
        EPI_END
    }
};
struct EpiRes {
    static constexpr bool PERM = true, AFTER_DRAIN = false;
    const float* res; const float* gate; float* out;
    DI void operator()(EPI_ARGS) const {
        const float* gp = gate + (u.pm >> 5) * 12288 + u.pn * 256;
        EPI_BEGIN
            const size_t off = (size_t)r * 2048 + u.pn * 256 + cl;
            const f32x4 g0 = *(const f32x4*)(gp + cl), g1 = *(const f32x4*)(gp + cl + 4);
            const f32x4 x0 = *(const f32x4*)(res + off), x1 = *(const f32x4*)(res + off + 4);
            *(f32x4*)(out + off) = x0 + g0 * v0; *(f32x4*)(out + off + 4) = x1 + g1 * v1;
        EPI_END
    }
};
struct EpiRelu2 {
    static constexpr bool PERM = true, AFTER_DRAIN = false;
    bf16_t* O; int ldc;
    DI void operator()(EPI_ARGS) const {
        EPI_BEGIN
#pragma unroll
            for (int i = 0; i < 4; ++i) { float a = fmaxf(v0[i], 0.f); v0[i] = a * a; a = fmaxf(v1[i], 0.f); v1[i] = a * a; }
            *(u32x4*)(O + (size_t)r * ldc + u.pn * 256 + cl) = pack_row8(v0, v1);
        EPI_END
    }
};

DI void phase_conv(const bf16_t* qkv, const float* conv_w, bf16_t* Qc, bf16_t* Kc, bf16_t* Vc, int wave, int lane) {
    const int gw = blockIdx.x * 8 + wave, NGW = gridDim.x * 8;
    for (int it = gw; it < 6 * 1024; it += NGW) {
        const int g = it % 6, run = it / 6, t0 = run * 16, tl0 = t0 & 8191, ch = g * 512 + 8 * lane;
        u32x4 rows[20];
#pragma unroll
        for (int i = 0; i < 20; ++i) { const int tl = tl0 - 2 + i; rows[i] = (tl >= 0 && tl < 8192) ? *(const u32x4*)(qkv + (size_t)(t0 - 2 + i) * 3072 + ch) : (u32x4){0u, 0u, 0u, 0u}; }
        f32x4 wl[5], wh[5];
#pragma unroll
        for (int j = 0; j < 5; ++j) { wl[j] = *(const f32x4*)(conv_w + j * 3072 + ch); wh[j] = *(const f32x4*)(conv_w + j * 3072 + ch + 4); }
        bf16_t* dst = (g < 2 ? Qc : (g < 4 ? Kc : Vc)) + (size_t)t0 * 1024 + (g & 1) * 512 + 8 * lane;
        const float post = g < 2 ? 0.08838834764831845f : 1.f;
#pragma unroll
        for (int i = 0; i < 16; ++i) {
            float a[8] = {0.f, 0.f, 0.f, 0.f, 0.f, 0.f, 0.f, 0.f};
#pragma unroll
            for (int j = 0; j < 5; ++j) { const u32x4 r = rows[i + j];
                a[0] += wl[j][0] * bflo(r.x); a[1] += wl[j][1] * bfhi(r.x); a[2] += wl[j][2] * bflo(r.y); a[3] += wl[j][3] * bfhi(r.y);
                a[4] += wh[j][0] * bflo(r.z); a[5] += wh[j][1] * bfhi(r.z); a[6] += wh[j][2] * bflo(r.w); a[7] += wh[j][3] * bfhi(r.w); }
            float ss = 0.f;
#pragma unroll
            for (int e = 0; e < 8; ++e) { a[e] = siluf_(a[e]); ss += a[e] * a[e]; }
            if (g < 4) { ss += __shfl_xor(ss, 1); ss += __shfl_xor(ss, 2); ss += __shfl_xor(ss, 4); ss += __shfl_xor(ss, 8);
                const float sc = rsqrtf(ss + EPS) * post;
#pragma unroll
                for (int e = 0; e < 8; ++e) a[e] *= sc; }
            u32x4 o; o.x = pk2(a[0], a[1]); o.y = pk2(a[2], a[3]); o.z = pk2(a[4], a[5]); o.w = pk2(a[6], a[7]);
            *(u32x4*)(dst + (size_t)i * 1024) = o;
        }
    }
}
DI void normrope16(bf16_t* ptr, const float* nw, const LAS f32x2* tab, float scale, int lane) {
    u32x4 a = *(const u32x4*)ptr, b = *(const u32x4*)(ptr + 8);
    float v[16];
    v[0] = bflo(a.x); v[1] = bfhi(a.x); v[2] = bflo(a.y); v[3] = bfhi(a.y); v[4] = bflo(a.z); v[5] = bfhi(a.z); v[6] = bflo(a.w); v[7] = bfhi(a.w);
    v[8] = bflo(b.x); v[9] = bfhi(b.x); v[10] = bflo(b.y); v[11] = bfhi(b.y); v[12] = bflo(b.z); v[13] = bfhi(b.z); v[14] = bflo(b.w); v[15] = bfhi(b.w);
    float ss = 0.f;
#pragma unroll
    for (int i = 0; i < 16; ++i) ss += v[i] * v[i];
    ss += __shfl_xor(ss, 1); ss += __shfl_xor(ss, 2); ss += __shfl_xor(ss, 4);
    const float rstd = rsqrtf(ss * (1.f / 128.f) + EPS);
    const int sub = lane & 7;
#pragma unroll
    for (int i = 0; i < 16; ++i) v[i] = v[i] * rstd * nw[sub * 16 + i];
#pragma unroll
    for (int i = 0; i < 16; ++i) { const float pr = __shfl_xor(v[i], 1); const f32x2 cs = tab[i];
        if (sub == 0) v[i] = v[i] * cs[0] - pr * cs[1]; else if (sub == 1) v[i] = v[i] * cs[0] + pr * cs[1]; }
    u32x4 o0, o1;
    o0.x = pk2(v[0] * scale, v[1] * scale); o0.y = pk2(v[2] * scale, v[3] * scale); o0.z = pk2(v[4] * scale, v[5] * scale); o0.w = pk2(v[6] * scale, v[7] * scale);
    o1.x = pk2(v[8] * scale, v[9] * scale); o1.y = pk2(v[10] * scale, v[11] * scale); o1.z = pk2(v[12] * scale, v[13] * scale); o1.w = pk2(v[14] * scale, v[15] * scale);
    *(u32x4*)ptr = o0; *(u32x4*)(ptr + 8) = o1;
}
DI void phase_swa_normrope(bf16_t* QSW, bf16_t* KVSW, const float* qn_w, const float* kn_w, LAS unsigned char* lds, int wave, int lane) {
    const int gw = blockIdx.x * 8 + wave, NGW = gridDim.x * 8;
    LAS f32x2* tab = (LAS f32x2*)(lds + wave * 128);
    for (int tk = gw; tk < T; tk += NGW) {
        const int pos = tk & 8191;
        if (lane < 16) {
            const float invf = exp2f(-(float)lane * (18.931568569324174f / 16.f));
            const float ang = (float)pos * invf;
            const double ad = (double)ang; const double kq = __builtin_rint(ad * 0.15915494309189535); const float rr = (float)(ad - kq * 6.283185307179586);
            f32x2 cs; cs[0] = __cosf(rr); cs[1] = __sinf(rr); tab[lane] = cs;
        }
        LDS_WAIT();
        normrope16(QSW + (size_t)tk * 1024 + lane * 16, qn_w, tab, 0.08838834764831845f, lane);
        if (lane < 16) normrope16(KVSW + (size_t)tk * 512 + lane * 16, kn_w, tab, 1.f, lane);
        LDS_WAIT();
    }
}

DI void swa_block(const bf16_t* QSW, const bf16_t* KVSW, const float* sink, bf16_t* Ysw, LAS unsigned char* lds, int tid, int wave, int lane) {
    const int fr = lane & 15, fq = lane >> 4, r = tid >> 2, sg = tid & 3, qi = 16 * wave + fr;
    LAS bf16_t* Kl = (LAS bf16_t*)lds; LAS bf16_t* VTl = Kl + 128 * 136;
    int it = blockIdx.x; if (it >= 1024) return;
    int kb = (((it >> 3) & 63) == 0) ? 1 : 0;
    u32x4 kk[4], vv[4]; bf16x8 qf[4], qn[4];
#define ATT_LOADKV(item_, kb_) do { const int hkv_ = ((item_) & 7) >> 2, nb_ = ((item_) >> 3) & 63, b_ = (item_) >> 9; const size_t tok_ = (size_t)b_ * L + 128 * (nb_ - 1 + (kb_)) + r; \
        const u32x4* ks_ = (const u32x4*)(KVSW + tok_ * 512 + hkv_ * 128 + sg * 32); const u32x4* vs_ = (const u32x4*)(KVSW + tok_ * 512 + 256 + hkv_ * 128 + sg * 32); \
        _Pragma("unroll") for (int i = 0; i < 4; ++i) { kk[i] = ks_[i]; vv[i] = vs_[i]; } } while (0)
#define ATT_LOADQ(dst, item_) do { const int hq_ = (item_) & 7, nb_ = ((item_) >> 3) & 63, b_ = (item_) >> 9; const size_t tq_ = (size_t)b_ * L + 128 * nb_ + qi; \
        _Pragma("unroll") for (int ks = 0; ks < 4; ++ks) dst[ks] = *(const bf16x8*)(QSW + tq_ * 1024 + hq_ * 128 + 32 * ks + 8 * fq); } while (0)
    ATT_LOADKV(it, kb); ATT_LOADQ(qf, it);
#pragma unroll
    for (int ks = 0; ks < 4; ++ks) qn[ks] = qf[ks];
    float mrun = 0.f, lrun = 0.f; f32x4 ot[8];
    bool first = true;
    for (;;) {
        const int hq = it & 7, nb = (it >> 3) & 63, b = it >> 9;
        __syncthreads();
#pragma unroll
        for (int i = 0; i < 4; ++i) { *(LAS u32x4*)(Kl + r * 136 + sg * 32 + 8 * i) = kk[i]; *(LAS u32x4*)(VTl + r * 136 + sg * 32 + 8 * i) = vv[i]; }
        __syncthreads();
        const bool last_kb = (kb == 2) || (nb + kb >= 64);
        int nit = it, nkb = kb + 1;
        if (last_kb) { nit = it + gridDim.x; nkb = (((nit >> 3) & 63) == 0) ? 1 : 0; }
        const bool more = nit < 1024;
        if (more) { ATT_LOADKV(nit, nkb); if (last_kb) ATT_LOADQ(qn, nit); }
        if (first) { mrun = sink[hq]; lrun = (fq == 0) ? 1.f : 0.f;
#pragma unroll
            for (int i = 0; i < 8; ++i) ot[i] = (f32x4){0.f, 0.f, 0.f, 0.f}; }
        f32x4 st[8];
#pragma unroll
        for (int mt = 0; mt < 8; ++mt) { st[mt] = (f32x4){0.f, 0.f, 0.f, 0.f};
#pragma unroll
            for (int ks = 0; ks < 4; ++ks) { const bf16x8 a = *(const LAS bf16x8*)(Kl + (16 * mt + fr) * 136 + 32 * ks + 8 * fq); st[mt] = mfma16(a, qf[ks], st[mt]); } }
        float mx = -INFINITY;
#pragma unroll
        for (int mt = 0; mt < 8; ++mt)
#pragma unroll
            for (int j = 0; j < 4; ++j) { const int kj = 16 * mt + 4 * fq + j; const bool valid = (kb == 0) ? (kj >= qi) : ((kb == 2) ? (kj <= qi) : true);
                const float sv = valid ? st[mt][j] : -INFINITY; st[mt][j] = sv; mx = fmaxf(mx, sv); }
        mx = fmaxf(mx, __shfl_xor(mx, 16)); mx = fmaxf(mx, __shfl_xor(mx, 32));
        const float mnew = fmaxf(mrun, mx), alpha = __expf(mrun - mnew);
        float ls = 0.f;
#pragma unroll
        for (int mt = 0; mt < 8; ++mt)
#pragma unroll
            for (int j = 0; j < 4; ++j) { const float pe = __expf(st[mt][j] - mnew); st[mt][j] = pe; ls += pe; }
        lrun = lrun * alpha + ls; mrun = mnew;
#pragma unroll
        for (int dt = 0; dt < 8; ++dt) ot[dt] *= alpha;
        bf16x8 pb[4];
#pragma unroll
        for (int ks = 0; ks < 4; ++ks) pb[ks] = pack8(st[2 * ks], st[2 * ks + 1]);
#pragma unroll
        for (int dt = 0; dt < 8; ++dt)
#pragma unroll
            for (int ks = 0; ks < 4; ++ks) { const LAS bf16_t* vp = VTl + (32 * ks + 4 * fq + (fr >> 2)) * 136 + 16 * dt + 4 * (fr & 3);
                const bf16x8 av = cat4(tr_read(vp), tr_read(vp + 16 * 136)); ot[dt] = mfma16(av, pb[ks], ot[dt]); }
        first = false;
        if (last_kb) {
            float lt = lrun; lt += __shfl_xor(lt, 16); lt += __shfl_xor(lt, 32);
            const float inv = 1.f / lt; const size_t tokq = (size_t)b * L + 128 * nb + qi;
#pragma unroll
            for (int dt = 0; dt < 8; ++dt) { u32x2 o; o.x = pk2(ot[dt][0] * inv, ot[dt][1] * inv); o.y = pk2(ot[dt][2] * inv, ot[dt][3] * inv);
                *(u32x2*)(Ysw + tokq * 1024 + hq * 128 + 16 * dt + 4 * fq) = o; }
#pragma unroll
            for (int ks = 0; ks < 4; ++ks) qf[ks] = qn[ks];
            first = true;
        }
        if (!more) break;
        it = nit; kb = nkb;
    }
#undef ATT_LOADKV
#undef ATT_LOADQ
}

constexpr int PREP_SET = 70400;
struct PrepStage { u32x4 kk[4], qq[4], vv[4]; float beta, g; };
DI void prep_load(PrepStage& R, const unsigned char* ws_c, int pair, int tid, int wave, int lane) {
    const bf16_t* Qc = (const bf16_t*)(ws_c + OFF_QC); const bf16_t* Kc = (const bf16_t*)(ws_c + OFF_KC); const bf16_t* Vc = (const bf16_t*)(ws_c + OFF_VC);
    const float* BA = (const float*)(ws_c + OFF_BA);
    const int grp = wave >> 2, wl = wave & 3, lt = tid & 255, item = 2 * pair + grp;
    const int n = item & 127, dirbh = item >> 7, dir = dirbh >> 4, b = (dirbh >> 3) & 1, h = dirbh & 7;
    const int c = lt >> 2, part = lt & 3;
    const size_t tok = (size_t)b * L + (dir ? (L - 1 - 64 * n - c) : (64 * n + c));
    const size_t go = tok * 1024 + h * 128 + part * 32;
#pragma unroll
    for (int i = 0; i < 4; ++i) { R.kk[i] = *(const u32x4*)(Kc + go + 8 * i); R.qq[i] = *(const u32x4*)(Qc + go + 8 * i); R.vv[i] = *(const u32x4*)(Vc + go + 8 * i); }
    if (wl == 0) { const size_t tk = (size_t)b * L + (dir ? (L - 1 - 64 * n - lane) : (64 * n + lane));
        R.beta = BA[tk * 32 + dir * 8 + h]; R.g = BA[tk * 32 + 16 + dir * 8 + h]; }
}
DI void dn_prep_pair(const unsigned char* ws_c, unsigned char* ws, LAS unsigned char* lds, int pair, int npair, PrepStage& R, int tid, int wave, int lane) {
    const bf16_t* Qc = (const bf16_t*)(ws_c + OFF_QC); const bf16_t* Kc = (const bf16_t*)(ws_c + OFF_KC); const bf16_t* Vc = (const bf16_t*)(ws_c + OFF_VC);
    const float* BA = (const float*)(ws_c + OFF_BA);
    bf16_t* Wg = (bf16_t*)(ws + OFF_W); bf16_t* Ug = (bf16_t*)(ws + OFF_U); bf16_t* Ag = (bf16_t*)(ws + OFF_A);
    f32x2* GC = (f32x2*)(ws + OFF_GC); float* EGL = (float*)(ws + OFF_EGL);
    { int l0 = threadIdx.x; asm volatile("" : "+v"(l0)); tid = l0; lane = l0 & 63; }
    const int grp = wave >> 2, wl = wave & 3, lt = tid & 255, item = 2 * pair + grp;
    const int n = item & 127, dirbh = item >> 7, dir = dirbh >> 4, b = (dirbh >> 3) & 1, h = dirbh & 7, fr = lane & 15, fq = lane >> 4;
    LAS unsigned char* base = lds + grp * PREP_SET;
    LAS bf16_t* Ks = (LAS bf16_t*)base; LAS bf16_t* Vs = Ks + 64 * 136; LAS float* Akk = (LAS float*)(base + 34816);
    LAS bf16_t* Qs = (LAS bf16_t*)(base + 51200);
    LAS bf16_t* Tb1 = (LAS bf16_t*)(base + 51200); LAS bf16_t* Tb2 = Tb1 + 64 * 72;
    LAS float* sg = (LAS float*)(base + 69632); LAS float* sb = sg + 64; LAS float* seg = sg + 128;
    __syncthreads();
    { const int c = lt >> 2, part = lt & 3;
      if (wl == 0) {
          const float beta = R.beta; float g = R.g;
#pragma unroll
          for (int off = 1; off < 64; off <<= 1) { const float t = __shfl_up(g, off); if (lane >= off) g += t; }
          const float eg = __expf(g), gl = __shfl(g, 63), dg = __expf(gl - g);
          sg[lane] = g; sb[lane] = beta; seg[lane] = eg;
          f32x2 w; w[0] = eg; w[1] = dg; GC[(size_t)dirbh * 8192 + 64 * n + lane] = w;
          if (lane == 63) EGL[dirbh * 128 + n] = eg;
      }
#pragma unroll
      for (int i = 0; i < 4; ++i) { *(LAS u32x4*)(Ks + c * 136 + part * 32 + 8 * i) = R.kk[i]; *(LAS u32x4*)(Qs + c * 136 + part * 32 + 8 * i) = R.qq[i]; *(LAS u32x4*)(Vs + c * 136 + part * 32 + 8 * i) = R.vv[i]; }
    }
    if (npair >= 0) prep_load(R, ws_c, npair, tid, wave, lane);
    __syncthreads();
    {
        const int nt = wl;
        bf16x8 sf[4];
#pragma unroll
        for (int ks = 0; ks < 4; ++ks) sf[ks] = *(const LAS bf16x8*)(Ks + (16 * nt + fr) * 136 + 8 * fq + 32 * ks);
        f32x4 sgs;
#pragma unroll
        for (int j = 0; j < 4; ++j) sgs[j] = sg[16 * nt + 4 * fq + j];
        for (int mt = 0; mt < 4; ++mt) {
            const int cc = 16 * mt + fr; const float gc = sg[cc], bc = sb[cc];
            f32x4 ak = {0.f, 0.f, 0.f, 0.f}, aq = {0.f, 0.f, 0.f, 0.f};
            if (nt <= mt) {
                const LAS bf16_t* Kp = Ks + cc * 136 + 8 * fq; const LAS bf16_t* Qp = Qs + cc * 136 + 8 * fq;
#pragma unroll
                for (int ks = 0; ks < 4; ++ks) { ak = mfma16(sf[ks], *(const LAS bf16x8*)(Kp + 32 * ks), ak); aq = mfma16(sf[ks], *(const LAS bf16x8*)(Qp + 32 * ks), aq); }
            }
            f32x4 ok, oq;
#pragma unroll
            for (int j = 0; j < 4; ++j) { const int s_ = 16 * nt + 4 * fq + j; const float e_ = __expf(fminf(gc - sgs[j], 0.f));
                ok[j] = (s_ < cc) ? bc * ak[j] * e_ : 0.f; oq[j] = (s_ <= cc) ? aq[j] * e_ : 0.f; }
            if (nt <= mt) { LAS float* ap = Akk + (16 * nt + 4 * fq) * 64 + cc;
                ap[0] = ok[0]; ap[64] = ok[1]; ap[128] = ok[2]; ap[192] = ok[3]; }
            u32x2 w; w.x = pk2(oq[0], oq[1]); w.y = pk2(oq[2], oq[3]); *(u32x2*)(Ag + (size_t)item * 4096 + cc * 64 + 16 * nt + 4 * fq) = w;
        }
    }
    __syncthreads();
    {
        int zoff = 0; asm volatile("" : "+v"(zoff));
        const LAS float* Akz = Akk + zoff;
        LAS float* Tl = (LAS float*)(base + 51200);
        LAS float* Xs = (LAS float*)(lds + 2 * PREP_SET + grp * 4096);
        LAS float* Dl = (LAS float*)(lds + 2 * PREP_SET + 8192 + grp * 4096);
        {   float Y[16];
#pragma unroll
            for (int r = 0; r < 16; ++r) Y[r] = (lane == r) ? 1.f : 0.f;
#pragma unroll
            for (int jj = 0; jj < 16; ++jj) {
                const float t = Y[jj]; if (lane < 16) Dl[(wl * 16 + jj) * 16 + lane] = t;
                if (jj < 15) { const LAS float* ar = Akz + (16 * wl + jj) * 64 + 16 * wl;
#pragma unroll
                    for (int r4 = (jj + 1) / 4; r4 < 4; ++r4) { const f32x4 av = *(const LAS f32x4*)(ar + 4 * r4);
#pragma unroll
                        for (int e = 0; e < 4; ++e) { if (4 * r4 + e > jj) fnma(Y[4 * r4 + e], av[e], t); } } }
            }
        }
        __syncthreads();
        const LAS float* Dz = Dl + zoff;
        for (int P = 0; P < 4; ++P) {
            float X[4];
#pragma unroll
            for (int e = 0; e < 4; ++e) X[e] = (lane == 16 * P + 4 * wl + e) ? 1.f : 0.f;
            const int nj = 16 * P;
            if (nj > 0) {
                float tj = Tl[lane]; f32x4 a0 = *(const LAS f32x4*)(Akz + 16 * P + 4 * wl);
                for (int j = 0; j < nj; ++j) {
                    const int jn = (j + 1 < nj) ? j + 1 : j;
                    const float tn = Tl[jn * 64 + lane]; const f32x4 n0 = *(const LAS f32x4*)(Akz + jn * 64 + 16 * P + 4 * wl);
#pragma unroll
                    for (int e = 0; e < 4; ++e) fnma(X[e], a0[e], tj);
                    tj = tn; a0 = n0;
                }
            }
#pragma unroll
            for (int e = 0; e < 4; ++e) Xs[(4 * wl + e) * 64 + lane] = X[e];
            __syncthreads();
            {   float Tn[4] = {0.f, 0.f, 0.f, 0.f}; float xk[16]; f32x4 dv[4][4];
#pragma unroll
                for (int k = 0; k < 16; ++k) xk[k] = Xs[k * 64 + lane];
#pragma unroll
                for (int e = 0; e < 4; ++e)
#pragma unroll
                    for (int k4 = 0; k4 < 4; ++k4) dv[e][k4] = *(const LAS f32x4*)(Dz + (P * 16 + 4 * wl + e) * 16 + 4 * k4);
#pragma unroll
                for (int k = 0; k < 16; ++k)
#pragma unroll
                    for (int e = 0; e < 4; ++e) fpma(Tn[e], dv[e][k >> 2][k & 3], xk[k]);
#pragma unroll
                for (int e = 0; e < 4; ++e) Tl[(16 * P + 4 * wl + e) * 64 + lane] = Tn[e];
            }
            __syncthreads();
        }
        const float c1 = sb[lane], c2 = -c1 * seg[lane];
        float Tc[16];
#pragma unroll
        for (int i = 0; i < 16; ++i) Tc[i] = Tl[(16 * wl + i) * 64 + lane];
        __syncthreads();
#pragma unroll
        for (int i = 0; i < 16; ++i) { const unsigned w = pk2(Tc[i] * c1, Tc[i] * c2); Tb1[(16 * wl + i) * 72 + lane] = (bf16_t)(w & 0xffffu); Tb2[(16 * wl + i) * 72 + lane] = (bf16_t)(w >> 16); }
    }
    __syncthreads();
    { int l2 = threadIdx.x; asm volatile("" : "+v"(l2)); lane = l2 & 63; }
    const int fr2 = lane & 15, fq2 = lane >> 4;
#define fr fr2
#define fq fq2
    for (int i2 = 0; i2 < 8; ++i2) {
        const int which = i2 >> 2, mt = i2 & 3;
        const LAS bf16_t* Tp = (which ? Tb2 : Tb1) + (16 * mt + fr) * 72 + 8 * fq;
        const LAS bf16_t* Xa = (which ? Ks : Vs) + (8 * fq + (fr >> 2)) * 136 + 16 * wl + 4 * (fr & 3); const LAS bf16_t* Xb = Xa + 64;
        const bf16x8 t0 = *(const LAS bf16x8*)Tp;
        f32x4 acca = mfma16(cat4(tr_read(Xa), tr_read(Xa + 4 * 136)), t0, (f32x4){0.f, 0.f, 0.f, 0.f});
        f32x4 accb = mfma16(cat4(tr_read(Xb), tr_read(Xb + 4 * 136)), t0, (f32x4){0.f, 0.f, 0.f, 0.f});
        if (mt >= 2) { const bf16x8 t1 = *(const LAS bf16x8*)(Tp + 32);
            acca = mfma16(cat4(tr_read(Xa + 32 * 136), tr_read(Xa + 36 * 136)), t1, acca);
            accb = mfma16(cat4(tr_read(Xb + 32 * 136), tr_read(Xb + 36 * 136)), t1, accb); }
        bf16_t* dst = (which ? Wg : Ug) + ((size_t)item * 64 + 16 * mt + fr) * 128 + 16 * wl + 4 * fq;
        u32x2 wa, wb; wa.x = pk2(acca[0], acca[1]); wa.y = pk2(acca[2], acca[3]); wb.x = pk2(accb[0], accb[1]); wb.y = pk2(accb[2], accb[3]);
        *(u32x2*)dst = wa; *(u32x2*)(dst + 64) = wb;
    }
#undef fr
#undef fq
}

constexpr int SC4_BUF = 71168;
DI void scan_item(const unsigned char* ws_c, unsigned char* ws, LAS unsigned char* lds, int dirbh, int half, int tid, int wave, int lane) {
    const bf16_t* Qc = (const bf16_t*)(ws_c + OFF_QC); const bf16_t* Kc = (const bf16_t*)(ws_c + OFF_KC);
    const bf16_t* Wg = (const bf16_t*)(ws_c + OFF_W); const bf16_t* Ug = (const bf16_t*)(ws_c + OFF_U); const bf16_t* Ag = (const bf16_t*)(ws_c + OFF_A);
    const f32x2* GC = (const f32x2*)(ws_c + OFF_GC);
    const int dir = dirbh >> 4, b = (dirbh >> 3) & 1, h = dirbh & 7, e0 = 64 * half + 16 * (wave & 3), el = 16 * (wave & 3), fr = lane & 15, fq = lane >> 4;
    bf16_t* Og = (bf16_t*)(ws + (dir ? OFF_OB : OFF_OF));
    struct Stg { u32x4 w0, w1, q0, q1, k0, k1, a, u; f32x2 g; };
#define SC_LOAD(R, vt, nn) do { const int row = (vt) >> 3, s8 = (vt) & 7, row2 = (vt) >> 1, hf = (vt) & 1; const size_t ci = (size_t)dirbh * 128 + (nn); \
        const bf16_t* wsrc = Wg + (ci * 64 + row) * 128 + s8 * 16; R.w0 = *(const u32x4*)wsrc; R.w1 = *(const u32x4*)(wsrc + 8); \
        const size_t tok = (size_t)b * L + (dir ? (L - 1 - 64 * (nn) - row) : (64 * (nn) + row)); const size_t go = tok * 1024 + h * 128 + s8 * 16; \
        R.q0 = *(const u32x4*)(Qc + go); R.q1 = *(const u32x4*)(Qc + go + 8); R.k0 = *(const u32x4*)(Kc + go); R.k1 = *(const u32x4*)(Kc + go + 8); \
        R.a = *(const u32x4*)(Ag + (ci * 64 + row) * 64 + s8 * 8); \
        R.u = *(const u32x4*)(Ug + (ci * 64 + row) * 128 + 64 * half + s8 * 8); \
        if ((vt) < 64) R.g = GC[(size_t)dirbh * 8192 + 64 * (nn) + (vt)]; } while (0)
#define SC_STORE(R, vt, bufp) do { const int row = (vt) >> 3, s8 = (vt) & 7, row2 = (vt) >> 1, hf = (vt) & 1; \
        LAS bf16_t* Wl_ = (LAS bf16_t*)(bufp); LAS bf16_t* Ql_ = Wl_ + 64 * 136; LAS bf16_t* Kl_ = Ql_ + 64 * 136; LAS bf16_t* Al_ = Kl_ + 64 * 136; LAS bf16_t* Ul_ = Al_ + 64 * 72; LAS float* EG_ = (LAS float*)(Ul_ + 64 * 72); \
        *(LAS u32x4*)(Wl_ + row * 136 + s8 * 16) = R.w0; *(LAS u32x4*)(Wl_ + row * 136 + s8 * 16 + 8) = R.w1; \
        *(LAS u32x4*)(Ql_ + row * 136 + s8 * 16) = R.q0; *(LAS u32x4*)(Ql_ + row * 136 + s8 * 16 + 8) = R.q1; \
        *(LAS u32x4*)(Kl_ + row * 136 + s8 * 16) = R.k0; *(LAS u32x4*)(Kl_ + row * 136 + s8 * 16 + 8) = R.k1; \
        *(LAS u32x4*)(Al_ + row * 72 + s8 * 8) = R.a; \
        *(LAS u32x4*)(Ul_ + row * 72 + s8 * 8) = R.u; \
        if ((vt) < 64) { EG_[(vt)] = R.g[0]; EG_[64 + (vt)] = R.g[1]; } } while (0)
    __syncthreads();
    { Stg R; R.u = (u32x4){0u, 0u, 0u, 0u}; R.g = (f32x2){0.f, 0.f}; SC_LOAD(R, tid, 0); SC_STORE(R, tid, lds); }
    __syncthreads();
    if (wave >= 4) {
        const int v0 = tid - 256, v1 = tid; const bool two = true;
        Stg R0, R1; R0.u = (u32x4){0u, 0u, 0u, 0u}; R0.g = (f32x2){0.f, 0.f}; R1 = R0;
        SC_LOAD(R0, v0, 1); if (two) SC_LOAD(R1, v1, 1);
        for (int n = 0; n < 128; ++n) {
            LAS unsigned char* nxt = lds + ((n + 1) & 1) * SC4_BUF;
            if (n + 1 < 128) { SC_STORE(R0, v0, nxt); if (two) SC_STORE(R1, v1, nxt); }
            if (n + 2 < 128) { SC_LOAD(R0, v0, n + 2); if (two) SC_LOAD(R1, v1, n + 2); }
            __syncthreads();
        }
    } else {
    f32x4 S[8];
#pragma unroll
    for (int i = 0; i < 8; ++i) S[i] = (f32x4){0.f, 0.f, 0.f, 0.f};
    for (int n = 0; n < 128; ++n) {
        LAS unsigned char* cur = lds + (n & 1) * SC4_BUF;
        {
            const LAS bf16_t* Wl = (const LAS bf16_t*)cur; const LAS bf16_t* Ql = Wl + 64 * 136; const LAS bf16_t* Kl = Ql + 64 * 136; const LAS bf16_t* Al = Kl + 64 * 136; const LAS bf16_t* Ul = Al + 64 * 72;
            const LAS float* EG = (const LAS float*)(Ul + 64 * 72); const LAS float* DG = EG + 64;
            bf16x8 Sb[4];
#pragma unroll
            for (int ks = 0; ks < 4; ++ks) Sb[ks] = pack8(S[2 * ks], S[2 * ks + 1]);
            f32x4 vn[4], oq[4], oa[4];
#pragma unroll
            for (int mt = 0; mt < 4; ++mt) {
#pragma unroll
                for (int j = 0; j < 4; ++j) vn[mt][j] = bf2f(Ul[(16 * mt + 4 * fq + j) * 72 + el + fr]);
                oq[mt] = (f32x4){0.f, 0.f, 0.f, 0.f}; oa[mt] = (f32x4){0.f, 0.f, 0.f, 0.f};
#pragma unroll
                for (int ks = 0; ks < 4; ++ks) { const LAS bf16_t* wp = Wl + (16 * mt + fr) * 136 + 32 * ks + 4 * fq; const LAS bf16_t* qp = Ql + (16 * mt + fr) * 136 + 32 * ks + 4 * fq;
                    vn[mt] = mfma16(cat4(*(const LAS s16x4*)wp, *(const LAS s16x4*)(wp + 16)), Sb[ks], vn[mt]);
                    oq[mt] = mfma16(Sb[ks], cat4(*(const LAS s16x4*)qp, *(const LAS s16x4*)(qp + 16)), oq[mt]); }
            }
            bf16x8 vb[2], vpb[2];
#pragma unroll
            for (int k2 = 0; k2 < 2; ++k2) { vb[k2] = pack8(vn[2 * k2], vn[2 * k2 + 1]);
                f32x4 a = vn[2 * k2], bb = vn[2 * k2 + 1];
#pragma unroll
                for (int j = 0; j < 4; ++j) { a[j] *= DG[32 * k2 + 4 * fq + j]; bb[j] *= DG[32 * k2 + 16 + 4 * fq + j]; }
                vpb[k2] = pack8(a, bb); }
#pragma unroll
            for (int mt = 0; mt < 4; ++mt)
#pragma unroll
                for (int k2 = 0; k2 < 2; ++k2) { if (k2 == 0 || mt >= 2) { const LAS bf16_t* ap = Al + (16 * mt + fr) * 72 + 32 * k2 + 4 * fq;
                    oa[mt] = mfma16(vb[k2], cat4(*(const LAS s16x4*)ap, *(const LAS s16x4*)(ap + 16)), oa[mt]); } }
#pragma unroll
            for (int mt = 0; mt < 4; ++mt) { const int cc = 16 * mt + fr; const size_t tok = (size_t)b * L + (dir ? (L - 1 - 64 * n - cc) : (64 * n + cc));
                const float eg = EG[cc]; u32x2 w; w.x = pk2(eg * oq[mt][0] + oa[mt][0], eg * oq[mt][1] + oa[mt][1]); w.y = pk2(eg * oq[mt][2] + oa[mt][2], eg * oq[mt][3] + oa[mt][3]);
                *(u32x2*)(Og + tok * 1024 + h * 128 + e0 + 4 * fq) = w; }
            const float egl = EG[63];
#pragma unroll
            for (int dt = 0; dt < 8; ++dt) { S[dt] *= egl;
#pragma unroll
                for (int k2 = 0; k2 < 2; ++k2) { const LAS bf16_t* kp = Kl + (32 * k2 + 4 * fq + (fr >> 2)) * 136 + 16 * dt + 4 * (fr & 3);
                    S[dt] = mfma16(cat4(tr_read(kp), tr_read(kp + 16 * 136)), vpb[k2], S[dt]); } }
        }
        __syncthreads();
    }
    }
#undef SC_LOAD
#undef SC_STORE
}

DI void phase_gated_norm(const bf16_t* OF, const bf16_t* OB, const bf16_t* Z, const float* nw, bf16_t* Y, int wave, int lane) {
    const int gw = blockIdx.x * 8 + wave, NGW = gridDim.x * 8;
    for (int tk = gw; tk < T; tk += NGW) {
        const size_t o = (size_t)tk * 1024 + lane * 16;
        const u32x4 f0 = *(const u32x4*)(OF + o), f1 = *(const u32x4*)(OF + o + 8), b0 = *(const u32x4*)(OB + o), b1 = *(const u32x4*)(OB + o + 8), z0 = *(const u32x4*)(Z + o), z1 = *(const u32x4*)(Z + o + 8);
        const unsigned fw[8] = {f0.x, f0.y, f0.z, f0.w, f1.x, f1.y, f1.z, f1.w}, bw[8] = {b0.x, b0.y, b0.z, b0.w, b1.x, b1.y, b1.z, b1.w}, zw[8] = {z0.x, z0.y, z0.z, z0.w, z1.x, z1.y, z1.z, z1.w};
        float v[16]; float ss = 0.f;
#pragma unroll
        for (int i = 0; i < 8; ++i) { v[2 * i] = bflo(fw[i]) + bflo(bw[i]); v[2 * i + 1] = bfhi(fw[i]) + bfhi(bw[i]); ss += v[2 * i] * v[2 * i] + v[2 * i + 1] * v[2 * i + 1]; }
        ss += __shfl_xor(ss, 1); ss += __shfl_xor(ss, 2); ss += __shfl_xor(ss, 4);
        const float rstd = rsqrtf(ss * (1.f / 128.f) + EPS);
        const float* wp = nw + (lane & 7) * 16;
        unsigned ow[8];
#pragma unroll
        for (int i = 0; i < 8; ++i) ow[i] = pk2(v[2 * i] * rstd * wp[2 * i] * bflo(zw[i]), v[2 * i + 1] * rstd * wp[2 * i + 1] * bfhi(zw[i]));
        u32x4 o0 = {ow[0], ow[1], ow[2], ow[3]}, o1 = {ow[4], ow[5], ow[6], ow[7]};
        *(u32x4*)(Y + o) = o0; *(u32x4*)(Y + o + 8) = o1;
    }
}

#define XB_TMO      128
#define XB_XCNT(j)  (256  + 64 * (j))
#define XB_XSUB(j)  (1280 + 64 * (j))
#define XB_XGEN(j)  (2304 + 64 * (j))
#define XB_TOP      3328
#define XB_TOPGEN   3392
#define XCD_BAR_WORDS 3456
#define XB_SPIN_CAP (1u << 18)

__device__ __forceinline__ unsigned xb_ld(unsigned* p)              { return __hip_atomic_load(p, __ATOMIC_RELAXED, __HIP_MEMORY_SCOPE_AGENT); }
__device__ __forceinline__ unsigned xb_add(unsigned* p, unsigned v) { return __hip_atomic_fetch_add(p, v, __ATOMIC_RELAXED, __HIP_MEMORY_SCOPE_AGENT); }
__device__ __forceinline__ unsigned xb_xcc_id() { return (unsigned)__builtin_amdgcn_s_getreg((3 << 11) | 20) & 0xFu; }
#define XB_SPIN(cond, bar) do { unsigned _sp = 0; while (cond) { __builtin_amdgcn_s_sleep(1); \
    if ((++_sp & 255u) == 0u) { if (xb_ld(&(bar)[XB_TMO])) break; if (_sp > XB_SPIN_CAP) { atomicAdd(&(bar)[XB_TMO], 1u); break; } } } } while (0)

struct XcdBarrier {
    unsigned* bar; unsigned x;
    volatile LAS unsigned* st;
};

__device__ __forceinline__ XcdBarrier xcd_barrier_post(unsigned* bar, volatile LAS unsigned* st) {
    XcdBarrier b; b.bar = bar; b.x = xb_xcc_id(); b.st = st;
    if (threadIdx.x == 0) (void)xb_add(&bar[XB_XCNT(b.x)], 1u);
    return b;
}
__device__ __forceinline__ void xcd_barrier_complete(unsigned* bar, unsigned x, unsigned& nloc, unsigned& nx) {
    const unsigned G = gridDim.x * gridDim.y * gridDim.z;
    unsigned sum, cnt, mine, sp = 0u;
    for (;;) {
        sum = 0u; cnt = 0u; mine = 0u;
#pragma unroll
        for (unsigned j = 0; j < 16; ++j) { const unsigned c = xb_ld(&bar[XB_XCNT(j)]); sum += c; cnt += (c > 0u) ? 1u : 0u; mine = (j == x) ? c : mine; }
        if (sum == G) break;
        __builtin_amdgcn_s_sleep(1);
        if ((++sp & 255u) == 0u) { if (xb_ld(&bar[XB_TMO])) break; if (sp > XB_SPIN_CAP) { atomicAdd(&bar[XB_TMO], 1u); break; } }
    }
    nloc = mine > 0u ? mine : 1u; nx = cnt > 0u ? cnt : 1u;
}

__device__ __forceinline__ void xcd_barrier(const XcdBarrier& b) {
    asm volatile("s_waitcnt vmcnt(0)" ::: "memory");
    __syncthreads();
    if (threadIdx.x == 0) {
        unsigned* bar = b.bar;
        __builtin_amdgcn_s_waitcnt(0);
        unsigned nloc = b.st[0], nx = b.st[1];
        if (nloc == 0u) { xcd_barrier_complete(bar, b.x, nloc, nx); b.st[0] = nloc; b.st[1] = nx; }
        const unsigned old = xb_add(&bar[XB_XSUB(b.x)], 1u);
        const unsigned gen = old / nloc;
        if (old + 1u == (gen + 1u) * nloc) {
            __builtin_amdgcn_fence(__ATOMIC_RELEASE, "agent");
            asm volatile("s_waitcnt vmcnt(0)" ::: "memory");
            const unsigned og = xb_add(&bar[XB_TOP], 1u);
            const unsigned tg = og / nx;
            if (og + 1u == (tg + 1u) * nx) xb_add(&bar[XB_TOPGEN], 1u);
            else XB_SPIN(xb_ld(&bar[XB_TOPGEN]) == tg, bar);
            __builtin_amdgcn_fence(__ATOMIC_ACQUIRE, "agent");
            xb_add(&bar[XB_XGEN(b.x)], 1u);
            asm volatile("s_waitcnt vmcnt(0)" ::: "memory");
        } else {
            XB_SPIN(xb_ld(&bar[XB_XGEN(b.x)]) == gen, bar);
            __builtin_amdgcn_fence(__ATOMIC_ACQUIRE, "agent");
            asm volatile("s_waitcnt vmcnt(0)" ::: "memory");
        }
    }
    __syncthreads();
}


struct SplitOrder {
    int nM, nN, G, c, lim;
    __device__ bool next(int i, pg8::Unit& u) const {
        const long Lx = (long)i * G + c; if (Lx >= lim) return false;
        const int wgid = (int)Lx; const int nig = pg8::WGM * nN, gid = wgid / nig, fm = gid * pg8::WGM, gsz = (nM - fm) < pg8::WGM ? (nM - fm) : pg8::WGM;
        u.pm = fm + ((wgid % nig) % gsz); u.pn = (wgid % nig) / gsz; return true;
    }
    __device__ __forceinline__ void a_ready(const pg8::Unit&) const {}
    __device__ __forceinline__ void done(const pg8::Unit&) const {}
};
struct EpiSig2 {
    static constexpr bool PERM = true, AFTER_DRAIN = false;
    bf16_t* O1; bf16_t* O2;
    DI void operator()(EPI_ARGS) const {
        bf16_t* O = (u.pn < 8 ? O1 : O2) + (u.pn & 7) * 256;
        EPI_BEGIN
#pragma unroll
            for (int i = 0; i < 4; ++i) { v0[i] = sigmoidf_(v0[i]); v1[i] = sigmoidf_(v1[i]); }
            *(u32x4*)(O + (size_t)r * 2048 + cl) = pack_row8(v0, v1);
        EPI_END
    }
};
constexpr bool GEMM_ALIGN = true, GEMM_SP2 = true;
template <class Epi> DI void run_gemm(LAS unsigned char* lds, const bf16_t* A, const bf16_t* Bt, int N, int K, const Epi& E) {
    pg8::Gemm g{A, Bt, T, N, K}; pg8::StaticOrder S; S.init(T, N, (int)gridDim.x, (int)blockIdx.x);
    pg8::gemm_phase<Epi, pg8::StaticOrder, GEMM_ALIGN, GEMM_SP2>(lds, g, S, E);
}

#define REP_P0 1
#define REP_P1 1
#define REP_P3 1
#define REP_P6 1
#define REP_P9 1
#define REP_ATT 1
#define REP_PREP 1
#define REP_SCAN 1
__global__ void __launch_bounds__(512, 2) hybrid_fwd(Params p) {
    extern __shared__ __attribute__((aligned(16))) unsigned char lds_raw[];
    LAS unsigned char* lds = (LAS unsigned char*)lds_raw;
    cg::grid_group grid = cg::this_grid();
    int tid, lane, wave;
#define FRESH_IDS() do { int t_ = threadIdx.x; asm volatile("" : "+v"(t_)); tid = t_; lane = t_ & 63; wave = __builtin_amdgcn_readfirstlane(t_ >> 6); } while (0)
    FRESH_IDS();
    unsigned char* ws = p.ws;
    const float* MOD = (const float*)(ws + OFF_MOD);

    volatile LAS unsigned* xst = (volatile LAS unsigned*)(lds + LDS_BYTES - 16);
    if (tid < 2) xst[tid] = 0u;
    __syncthreads();
    XcdBarrier xbar = xcd_barrier_post((unsigned*)ws, xst);
#define GRID_BAR() do { xcd_barrier(xbar); FRESH_IDS(); } while (0)
    if (p.ws == nullptr) grid.sync();
    for (int rep = 0; rep < REP_P0; ++rep) phase0(p, lds, tid, wave, lane);
    GRID_BAR();
    for (int rep = 0; rep < REP_P1; ++rep) phase_modnorm(p.x, p.norm1_w, MOD, 0, 2048, (bf16_t*)(ws + OFF_H), wave, lane);
    GRID_BAR();
    { EpiIn E{(bf16_t*)(ws + OFF_QKV), (bf16_t*)(ws + OFF_Z), (bf16_t*)(ws + OFF_QSW), (bf16_t*)(ws + OFF_KVSW), (float*)(ws + OFF_BA), p.a_log, p.dt_bias};
      run_gemm(lds, (const bf16_t*)(ws + OFF_H), (const bf16_t*)(ws + OFF_WIN) + (size_t)4096 * 2048, 5888, 2048, E); }
    GRID_BAR();
    for (int rep = 0; rep < REP_P3; ++rep) phase_conv((const bf16_t*)(ws + OFF_QKV), p.conv_w, (bf16_t*)(ws + OFF_QC), (bf16_t*)(ws + OFF_KC), (bf16_t*)(ws + OFF_VC), wave, lane);
    phase_swa_normrope((bf16_t*)(ws + OFF_QSW), (bf16_t*)(ws + OFF_KVSW), p.qn_w, p.kn_w, lds, wave, lane);
    GRID_BAR();
    for (int rep = 0; rep < REP_ATT; ++rep) swa_block((const bf16_t*)(ws + OFF_QSW), (const bf16_t*)(ws + OFF_KVSW), p.sink, (bf16_t*)(ws + OFF_YSW), lds, tid, wave, lane);
    { PrepStage R; R.beta = 0.f; R.g = 0.f;
      if (blockIdx.x < 2048) prep_load(R, ws, blockIdx.x, tid, wave, lane);
      for (int it = blockIdx.x; it < 2048; it += gridDim.x) { const int nit = it + (int)gridDim.x; dn_prep_pair(ws, ws, lds, it, nit < 2048 ? nit : -1, R, tid, wave, lane); } }
    GRID_BAR();
    bf16_t* TG1 = (bf16_t*)p.out; bf16_t* TG2 = TG1 + (size_t)T * 2048;
    if (gridDim.x == 256) {
        const int bid = blockIdx.x;
        pg8::Gemm g{(const bf16_t*)(ws + OFF_H), (const bf16_t*)(ws + OFF_WIN), T, 4096, 2048}; EpiSig2 Eg{TG1, TG2};
        if (((bid >> 3) & 3) == 0) {
            for (int rep = 0; rep < REP_SCAN; ++rep) scan_item(ws, ws, lds, (bid >> 6) * 8 + (bid & 7), (bid >> 5) & 1, tid, wave, lane);
        } else {
            const int cv = bid - 8 * ((bid >> 5) + 1);
            SplitOrder S{64, 16, 192, cv, 1024};
            pg8::gemm_phase<EpiSig2, SplitOrder, GEMM_ALIGN, GEMM_SP2>(lds, g, S, Eg);
            asm volatile("s_waitcnt vmcnt(0)" ::: "memory"); __syncthreads();
            if (threadIdx.x == 0) { unsigned* cnt = (unsigned*)ws + 3584;
                __builtin_amdgcn_fence(__ATOMIC_RELEASE, "agent"); asm volatile("s_waitcnt vmcnt(0)" ::: "memory");
                __hip_atomic_fetch_add(cnt, 1u, __ATOMIC_RELAXED, __HIP_MEMORY_SCOPE_AGENT);
                unsigned sp = 0; while (__hip_atomic_load(cnt, __ATOMIC_RELAXED, __HIP_MEMORY_SCOPE_AGENT) < 192u && ++sp < (1u << 24)) __builtin_amdgcn_s_sleep(2);
                __builtin_amdgcn_fence(__ATOMIC_ACQUIRE, "agent"); asm volatile("s_waitcnt vmcnt(0)" ::: "memory"); }
            __syncthreads(); FRESH_IDS();
            { pg8::Gemm gb{(const bf16_t*)(ws + OFF_YSW), (const bf16_t*)(ws + OFF_WSW), T, 2048, 1024}; const SplitOrder Sb = cv < 64 ? SplitOrder{64, 8, 64, 384 + cv, 512} : SplitOrder{64, 8, 128, cv - 64, 384};
              EpiMerge<false> Eb{TG2, nullptr, TG2}; pg8::gemm_phase<EpiMerge<false>, SplitOrder, GEMM_ALIGN, GEMM_SP2>(lds, gb, Sb, Eb); }
        }
    } else {
        for (int d = blockIdx.x; d < 64; d += gridDim.x) scan_item(ws, ws, lds, d >> 1, d & 1, tid, wave, lane);
        { EpiSig Eg{TG1, 2048}; run_gemm(lds, (const bf16_t*)(ws + OFF_H), (const bf16_t*)(ws + OFF_WIN), 2048, 2048, Eg); }
        { EpiSig Eg{TG2, 2048}; run_gemm(lds, (const bf16_t*)(ws + OFF_H), (const bf16_t*)(ws + OFF_WIN) + (size_t)2048 * 2048, 2048, 2048, Eg); }
        { EpiMerge<false> Eb{TG2, nullptr, TG2}; run_gemm(lds, (const bf16_t*)(ws + OFF_YSW), (const bf16_t*)(ws + OFF_WSW), 2048, 1024, Eb); }
    }
    GRID_BAR();
    for (int rep = 0; rep < REP_P6; ++rep) phase_gated_norm((const bf16_t*)(ws + OFF_OF), (const bf16_t*)(ws + OFF_OB), (const bf16_t*)(ws + OFF_Z), p.dn_norm_w, (bf16_t*)(ws + OFF_YDN), wave, lane);
    GRID_BAR();
    { EpiMerge<true> Ea{TG1, TG2, (bf16_t*)(ws + OFF_MRG)};
      run_gemm(lds, (const bf16_t*)(ws + OFF_YDN), (const bf16_t*)(ws + OFF_WDN), 2048, 1024, Ea); }
    GRID_BAR();
    { EpiRes E{p.x, MOD + 4096, p.out};
      run_gemm(lds, (const bf16_t*)(ws + OFF_MRG), (const bf16_t*)(ws + OFF_WOUT), 2048, 2048, E); }
    GRID_BAR();
    for (int rep = 0; rep < REP_P9; ++rep) { phase_modnorm(p.out, p.norm2_w, MOD, 6144, 8192, (bf16_t*)(ws + OFF_H), wave, lane);
    phase_mlp_weights(p, lds, wave, lane); }
    GRID_BAR();
    { EpiRelu2 E{(bf16_t*)(ws + OFF_UU), 8192};
      run_gemm(lds, (const bf16_t*)(ws + OFF_H), (const bf16_t*)(ws + OFF_WMI), 8192, 2048, E); }
    GRID_BAR();
    { EpiRes E{p.out, MOD + 10240, p.out};
      run_gemm(lds, (const bf16_t*)(ws + OFF_UU), (const bf16_t*)(ws + OFF_WMO), 2048, 8192, E); }
}

extern "C" void kernel_launch(void* const* d_in, const int* in_sizes, int n_in, void* d_out, int out_size, void* d_ws, size_t ws_size, hipStream_t stream) {
    static int grid_blocks = 0;
    if (grid_blocks == 0) {
        if (n_in != 19 || out_size != T * D || ws_size < WS_END) { fprintf(stderr, "kernel_launch: unexpected shapes (n_in %d out %d ws %zu)\n", n_in, out_size, ws_size); grid_blocks = -1; return; }
        int dev = 0, cus = 0, per_cu = 0;
        hipGetDevice(&dev); hipDeviceGetAttribute(&cus, hipDeviceAttributeMultiprocessorCount, dev);
        hipFuncSetAttribute((const void*)hybrid_fwd, hipFuncAttributeMaxDynamicSharedMemorySize, LDS_BYTES);
        hipOccupancyMaxActiveBlocksPerMultiprocessor(&per_cu, (const void*)hybrid_fwd, 512, LDS_BYTES);
        if (per_cu < 1) { fprintf(stderr, "kernel_launch: occupancy query says %d blocks/CU\n", per_cu); per_cu = 1; }
        (void)hipGetLastError();
        grid_blocks = cus * per_cu;
    }
    if (grid_blocks < 0) return;
    Params p{};
    p.x = (const float*)d_in[0]; p.c = (const float*)d_in[1]; p.w_ada = (const float*)d_in[2]; p.b_ada = (const float*)d_in[3]; p.norm1_w = (const float*)d_in[4];
    p.w_in = (const float*)d_in[5]; p.conv_w = (const float*)d_in[6]; p.a_log = (const float*)d_in[7]; p.dt_bias = (const float*)d_in[8]; p.dn_norm_w = (const float*)d_in[9];
    p.w_dn = (const float*)d_in[10]; p.qn_w = (const float*)d_in[11]; p.kn_w = (const float*)d_in[12]; p.sink = (const float*)d_in[13]; p.w_sw = (const float*)d_in[14];
    p.w_out = (const float*)d_in[15]; p.norm2_w = (const float*)d_in[16]; p.w_mi = (const float*)d_in[17]; p.w_mo = (const float*)d_in[18];
    p.out = (float*)d_out; p.ws = (unsigned char*)d_ws;
    if (hipMemsetAsync(d_ws, 0, 16384, stream) != hipSuccess) { fprintf(stderr, "kernel_launch: memset of the barrier words failed\n"); return; }
    void* args[] = {&p};
    hipError_t e = hipLaunchCooperativeKernel((const void*)hybrid_fwd, dim3(grid_blocks), dim3(512), args, LDS_BYTES, stream);
    if (e != hipSuccess) fprintf(stderr, "cooperative launch failed: %s (grid %d)\n", hipGetErrorString(e), grid_blocks);
}
```
